# Optimizing an MI355X kernel written in HIP

```python
import math
import jax
import jax.numpy as jnp
from jax import lax
import numpy as np

D_MODEL = 1024
BATCH = 2
SEQ = 16384
DEPTH = 2

GRID_W = 64
CTX_LEN = 256
EPS = 1e-6
ROPE_BASE = 10000.0

NA_HEADS = 4
NA_HEAD_DIM = 64
NA_WIN_R = 8
NA_WIN_C = 16
NA_W = NA_HEADS * NA_HEAD_DIM

DIFF_HEADS = 4
DIFF_HEAD_DIM = 32
DIFF_QK_W = DIFF_HEADS * 2 * DIFF_HEAD_DIM
DIFF_V_W = DIFF_HEADS * 2 * DIFF_HEAD_DIM
DIFF_BLOCK = 128

POOL_WINDOWS = (2, 4, 8, 16)
POOL_GROUPS = len(POOL_WINDOWS)
POOL_GROUP_W = 64
POOL_W = POOL_GROUPS * POOL_GROUP_W

FNET_W = 256

N_BRANCH = 4
BRANCH_W = 256

OFF_NA_Q = 0
OFF_DF_Q = OFF_NA_Q + NA_W
OFF_POOL = OFF_DF_Q + DIFF_QK_W
OFF_FNET = OFF_POOL + POOL_W
OFF_GATE = OFF_FNET + FNET_W
OFF_KV = OFF_GATE + N_BRANCH * D_MODEL
KV_W = 2 * NA_W + DIFF_QK_W + DIFF_V_W
IN_COLS = OFF_KV + KV_W

N_EXPERTS = 16
EC_FACTOR = 2
EXPERT_FF = 1408

kernel_name = "hybrid_gated_branch_diffusion_block"


def _rmsnorm(x, g):
    x32 = x.astype(jnp.float32)
    y = x32 * lax.rsqrt(jnp.mean(x32 * x32, axis=-1, keepdims=True) + EPS)
    return (y * g.astype(jnp.float32)).astype(x.dtype)


def _modulate(h, shift, scale):
    return h * (1 + scale) + shift


def _rope_tables(pos, dim):
    half = dim // 2
    inv = ROPE_BASE ** (-jnp.arange(half, dtype=jnp.float32) / half)
    ang = pos.astype(jnp.float32)[:, None] * inv[None, :]
    return jnp.cos(ang), jnp.sin(ang)


def _rotate_half(x, cos, sin):
    half = x.shape[-1] // 2
    x1, x2 = x[..., :half], x[..., half:]
    return jnp.concatenate([x1 * cos - x2 * sin, x1 * sin + x2 * cos], axis=-1)


def _axial_rope(x, rope):
    cos_r, sin_r, cos_c, sin_c = rope
    a = x.shape[-1] // 2
    e = lambda z: z[:, None, None, :]
    x32 = x.astype(jnp.float32)
    y = jnp.concatenate([_rotate_half(x32[..., :a], e(cos_r), e(sin_r)),
                         _rotate_half(x32[..., a:], e(cos_c), e(sin_c))], axis=-1)
    return y.astype(x.dtype)


def _split_q(p, na_q_g, df_q_g):
    B, N, _ = p.shape
    na_q = _rmsnorm(p[..., OFF_NA_Q:OFF_DF_Q].reshape(B, N, NA_HEADS, NA_HEAD_DIM), na_q_g)
    df_q = _rmsnorm(p[..., OFF_DF_Q:OFF_POOL].reshape(B, N, DIFF_HEADS, 2, DIFF_HEAD_DIM), df_q_g)
    return na_q, df_q, p[..., OFF_POOL:OFF_FNET], p[..., OFF_FNET:OFF_GATE], p[..., OFF_GATE:OFF_KV]


def _split_kv(kv, na_k_g, df_k_g):
    B, N, _ = kv.shape
    na_k = _rmsnorm(kv[..., :NA_W].reshape(B, N, NA_HEADS, NA_HEAD_DIM), na_k_g)
    na_v = kv[..., NA_W:2 * NA_W].reshape(B, N, NA_HEADS, NA_HEAD_DIM)
    o = 2 * NA_W
    df_k = _rmsnorm(kv[..., o:o + DIFF_QK_W].reshape(B, N, DIFF_HEADS, 2, DIFF_HEAD_DIM), df_k_g)
    df_v = kv[..., o + DIFF_QK_W:].reshape(B, N, DIFF_HEADS, 2 * DIFF_HEAD_DIM)
    return na_k, na_v, df_k, df_v


def _dense_attn(q, k, v):
    B, Q, H, d = q.shape
    s = jnp.einsum('bqhd,bkhd->bhqk', q, k).astype(jnp.float32) * (d ** -0.5)
    p = jax.nn.softmax(s, axis=-1).astype(v.dtype)
    return jnp.einsum('bhqk,bkhd->bqhd', p, v).reshape(B, Q, H * d)


def _na_latent(q, k, v, kc, vc, rpb):
    B, T, H, dh = q.shape
    rows = T // GRID_W
    kr = min(NA_WIN_R, rows)
    scale = dh ** -0.5
    qg = q.reshape(B, rows, GRID_W, H, dh).transpose(1, 0, 3, 2, 4)
    kg = k.reshape(B, rows, GRID_W, H, dh).transpose(0, 3, 1, 2, 4)
    vg = v.reshape(B, rows, GRID_W, H, dh).transpose(0, 3, 1, 2, 4)
    kct = kc.transpose(0, 2, 1, 3)
    vct = vc.transpose(0, 2, 1, 3)
    col = jnp.arange(GRID_W)
    cs = jnp.clip(col - NA_WIN_C // 2, 0, GRID_W - NA_WIN_C)
    col_idx = cs[:, None] + jnp.arange(NA_WIN_C)[None, :]
    ci = col_idx - col[:, None] + (NA_WIN_C - 1)
    n_loc = kr * NA_WIN_C

    def row_block(args):
        r, qr = args
        rs = jnp.clip(r - kr // 2, 0, rows - kr)
        kw = lax.dynamic_slice_in_dim(kg, rs, kr, axis=2)[:, :, :, col_idx]
        vw = lax.dynamic_slice_in_dim(vg, rs, kr, axis=2)[:, :, :, col_idx]
        ri = rs + jnp.arange(kr) - r + (NA_WIN_R - 1)
        bias = rpb[:, ri[None, :, None], ci[:, None, :]]
        s_loc = (jnp.einsum('bhqd,bhiqjd->bhqij', qr, kw).astype(jnp.float32) * scale
                 + bias.astype(jnp.float32)[None]).reshape(B, H, GRID_W, n_loc)
        s_ctx = jnp.einsum('bhqd,bhkd->bhqk', qr, kct).astype(jnp.float32) * scale
        p = jax.nn.softmax(jnp.concatenate([s_loc, s_ctx], axis=-1), axis=-1).astype(qr.dtype)
        p_loc = p[..., :n_loc].reshape(B, H, GRID_W, kr, NA_WIN_C)
        return (jnp.einsum('bhqij,bhiqjd->bhqd', p_loc, vw)
                + jnp.einsum('bhqk,bhkd->bhqd', p[..., n_loc:], vct))

    o = lax.map(row_block, (jnp.arange(rows), qg))
    return o.transpose(1, 0, 3, 2, 4).reshape(B, T, H * dh)


def _diff_core(qh, kh, vh, lam):
    scale = qh.shape[-1] ** -0.5
    s = jnp.einsum('bhmqd,bhmkd->bhmqk', qh, kh).astype(jnp.float32) * scale
    p = jax.nn.softmax(s, axis=-1)
    a = (p[:, :, 0] - lam * p[:, :, 1]).astype(vh.dtype)
    return jnp.einsum('bhqk,bhkd->bhqd', a, vh)


def _diff_latent(q, k, v, kc, vc, lam):
    B, T, H, _, dq = q.shape
    nblk = T // DIFF_BLOCK
    kall = jnp.concatenate([k, kc], axis=1).transpose(0, 2, 3, 1, 4)
    vall = jnp.concatenate([v, vc], axis=1).transpose(0, 2, 1, 3)
    qb = q.reshape(B, nblk, DIFF_BLOCK, H, 2, dq).transpose(1, 0, 3, 4, 2, 5)
    o = lax.map(lambda qi: _diff_core(qi, kall, vall, lam), qb)
    return o.transpose(1, 2, 0, 3, 4).reshape(B, H, T, 2 * dq)


def _diff_post(o, sub_g, lam_init):
    B, H, N, dv = o.shape
    o = _rmsnorm(o, sub_g) * (1.0 - lam_init)
    return o.transpose(0, 2, 1, 3).reshape(B, N, H * dv)


def _pool_mixer(u, pool_w, pool_scale):
    N = u.shape[1]
    u32 = u.astype(jnp.float32)
    csum = jnp.concatenate([jnp.zeros_like(u32[:, :1]), jnp.cumsum(u32, axis=1)], axis=1)
    t = jnp.arange(N)
    outs = []
    for gi, w in enumerate(POOL_WINDOWS):
        lo = jnp.clip(t - w // 2, 0, N)
        hi = jnp.clip(t + w // 2, 0, N)
        cnt = (hi - lo).astype(jnp.float32)[None, :, None]
        sl = slice(gi * POOL_GROUP_W, (gi + 1) * POOL_GROUP_W)
        cg = csum[..., sl]
        mean = (cg[:, hi] - cg[:, lo]) / cnt
        outs.append((mean - u32[..., sl]) @ pool_w[gi].astype(jnp.float32))
    y = jnp.concatenate(outs, axis=-1) * pool_scale.astype(jnp.float32)
    return y.astype(u.dtype)


def _fourier_mixer(u, w):
    f = jnp.fft.fft2(u.astype(jnp.float32), axes=(1, 2), norm='ortho').real
    return f.astype(u.dtype) @ w


def _merge(ys, gate_logits, w_br, w_o):
    acc = None
    for i, y in enumerate(ys):
        g = jax.nn.sigmoid(gate_logits[..., i * D_MODEL:(i + 1) * D_MODEL].astype(jnp.float32))
        term = g.astype(y.dtype) * (y @ w_br[i])
        acc = term if acc is None else acc + term
    return acc @ w_o


def _ec_ffn(h, w_router, w_gate, w_up, w_down):
    B, N, D = h.shape
    cap = max(1, EC_FACTOR * N // N_EXPERTS)
    aff = jax.nn.softmax((h @ w_router).astype(jnp.float32), axis=-1)
    g, idx = lax.top_k(aff.transpose(0, 2, 1), cap)
    bidx = jnp.arange(B)[:, None, None]
    xe = h[bidx, idx]
    hid = (jax.nn.silu(jnp.einsum('becd,edf->becf', xe, w_gate))
           * jnp.einsum('becd,edf->becf', xe, w_up))
    ye = jnp.einsum('becf,efd->becd', hid, w_down) * g[..., None].astype(h.dtype)
    return jnp.zeros_like(h).at[bidx, idx].add(ye)


def setup_inputs(seed: int = 0) -> dict:
    key = jax.random.key(seed)
    ks = jax.random.split(key, 32)
    f32 = jnp.float32
    L, D, E, F = DEPTH, D_MODEL, N_EXPERTS, EXPERT_FF
    nrm = lambda k, shape, s: jax.random.normal(k, shape, f32) * s
    return {
        "x": nrm(ks[0], (BATCH, SEQ, D), 1.0),
        "c": nrm(ks[1], (BATCH, D), 1.0),
        "ctx": nrm(ks[2], (BATCH, CTX_LEN, D), 1.0),
        "c_ctx": nrm(ks[3], (D,), 1.0),
        "w_ada": nrm(ks[4], (L, D, 6 * D), 0.5 * D ** -0.5),
        "b_ada": nrm(ks[5], (L, 6 * D), 0.02),
        "g_mix": 1.0 + nrm(ks[6], (L, D), 0.05),
        "g_ffn": 1.0 + nrm(ks[7], (L, D), 0.05),
        "w_in": nrm(ks[8], (L, D, IN_COLS), D ** -0.5),
        "na_q_g": 1.0 + nrm(ks[9], (L, NA_HEAD_DIM), 0.05),
        "na_k_g": 1.0 + nrm(ks[10], (L, NA_HEAD_DIM), 0.05),
        "na_rpb": nrm(ks[11], (L, NA_HEADS, 2 * NA_WIN_R - 1, 2 * NA_WIN_C - 1), 0.1),
        "df_q_g": 1.0 + nrm(ks[12], (L, DIFF_HEAD_DIM), 0.05),
        "df_k_g": 1.0 + nrm(ks[13], (L, DIFF_HEAD_DIM), 0.05),
        "df_lambda": nrm(ks[14], (L, 4, DIFF_HEAD_DIM), 0.1),
        "df_subln_g": 1.0 + nrm(ks[15], (L, 2 * DIFF_HEAD_DIM), 0.05),
        "pool_w": nrm(ks[16], (L, POOL_GROUPS, POOL_GROUP_W, POOL_GROUP_W), POOL_GROUP_W ** -0.5),
        "pool_scale": 1.0 + nrm(ks[17], (L, POOL_W), 0.05),
        "fnet_w": nrm(ks[18], (L, FNET_W, FNET_W), FNET_W ** -0.5),
        "w_branch": nrm(ks[19], (L, N_BRANCH, BRANCH_W, D), BRANCH_W ** -0.5),
        "w_out": nrm(ks[20], (L, D, D), D ** -0.5),
        "w_router": nrm(ks[21], (L, D, E), D ** -0.5),
        "w_gate_e": nrm(ks[22], (L, E, D, F), D ** -0.5),
        "w_up_e": nrm(ks[23], (L, E, D, F), D ** -0.5),
        "w_down_e": nrm(ks[24], (L, E, F, D), F ** -0.5),
    }


def reference(x, c, ctx, c_ctx, w_ada, b_ada, g_mix, g_ffn, w_in, na_q_g, na_k_g, na_rpb,
              df_q_g, df_k_g, df_lambda, df_subln_g, pool_w, pool_scale, fnet_w, w_branch,
              w_out, w_router, w_gate_e, w_up_e, w_down_e):
    T = x.shape[1]
    t = jnp.arange(T)
    rope = (*_rope_tables(t // GRID_W, DIFF_HEAD_DIM // 2),
            *_rope_tables(t % GRID_W, DIFF_HEAD_DIM // 2))
    s_c = jax.nn.silu(c)
    s_cc = jax.nn.silu(c_ctx)
    for l in range(DEPTH):
        last = l == DEPTH - 1
        mod = (s_c @ w_ada[l] + b_ada[l])[:, None, :]
        sh1, sc1, gt1, sh2, sc2, gt2 = jnp.split(mod, 6, axis=-1)
        cmod = s_cc @ w_ada[l] + b_ada[l]
        csh1, csc1, cgt1, csh2, csc2, cgt2 = jnp.split(cmod, 6, axis=-1)
        lam_init = 0.8 - 0.6 * math.exp(-0.3 * l)
        lv = df_lambda[l].astype(jnp.float32)
        lam = jnp.exp(jnp.sum(lv[0] * lv[1])) - jnp.exp(jnp.sum(lv[2] * lv[3])) + lam_init

        h = _modulate(_rmsnorm(x, g_mix[l]), sh1, sc1)
        hc = _modulate(_rmsnorm(ctx, g_mix[l]), csh1, csc1)
        pl = h @ w_in[l]
        na_q, df_q, pool_in, fnet_in, gate_l = _split_q(pl, na_q_g[l], df_q_g[l])
        na_k, na_v, df_k, df_v = _split_kv(pl[..., OFF_KV:], na_k_g[l], df_k_g[l])
        df_q = _axial_rope(df_q, rope)
        df_k = _axial_rope(df_k, rope)
        pc = hc @ (w_in[l][:, OFF_KV:] if last else w_in[l])
        na_kc, na_vc, df_kc, df_vc = _split_kv(pc[..., -KV_W:], na_k_g[l], df_k_g[l])

        y_na = _na_latent(na_q, na_k, na_v, na_kc, na_vc, na_rpb[l])
        y_df = _diff_post(_diff_latent(df_q, df_k, df_v, df_kc, df_vc, lam), df_subln_g[l], lam_init)
        y_pool = _pool_mixer(pool_in, pool_w[l], pool_scale[l])
        y_fnet = _fourier_mixer(fnet_in, fnet_w[l])
        x_mix = _merge((y_na, y_df, y_pool, y_fnet), gate_l, w_branch[l], w_out[l])

        if not last:
            na_qc, df_qc, pool_c, fnet_c, gate_c = _split_q(pc, na_q_g[l], df_q_g[l])
            yc_na = _dense_attn(na_qc, na_kc, na_vc)
            yc_df = _diff_post(_diff_core(df_qc.transpose(0, 2, 3, 1, 4),
                                          df_kc.transpose(0, 2, 3, 1, 4),
                                          df_vc.transpose(0, 2, 1, 3), lam),
                               df_subln_g[l], lam_init)
            yc_pool = _pool_mixer(pool_c, pool_w[l], pool_scale[l])
            yc_fnet = _fourier_mixer(fnet_c, fnet_w[l])
            ctx_mix = _merge((yc_na, yc_df, yc_pool, yc_fnet), gate_c, w_branch[l], w_out[l])

        x = x + gt1 * x_mix

        h2 = _modulate(_rmsnorm(x, g_ffn[l]), sh2, sc2)
        x = x + gt2 * _ec_ffn(h2, w_router[l], w_gate_e[l], w_up_e[l], w_down_e[l])

        if not last:
            ctx = ctx + cgt1 * ctx_mix
            hc2 = _modulate(_rmsnorm(ctx, g_ffn[l]), csh2, csc2)
            ctx = ctx + cgt2 * _ec_ffn(hc2, w_router[l], w_gate_e[l], w_up_e[l], w_down_e[l])
    return x
```

```cpp
#include <hip/hip_runtime.h>
#include <hip/hip_cooperative_groups.h>
#include <stdint.h>
#include <cstdio>
namespace cg = cooperative_groups;

#ifndef ONE_LAUNCH
#define ONE_LAUNCH 1
#endif

#define DI __device__ __forceinline__
typedef unsigned short bf16_t;
using bf16x8 = __attribute__((ext_vector_type(8))) short;
using s16x4 = __attribute__((ext_vector_type(4))) short;
using u32x4 = __attribute__((ext_vector_type(4))) unsigned;
using f32x16 = __attribute__((ext_vector_type(16))) float;
typedef __bf16 bf2_t __attribute__((ext_vector_type(2)));
typedef float f2_t __attribute__((ext_vector_type(2)));
#define MFMA32(a, b, c) __builtin_amdgcn_mfma_f32_32x32x16_bf16((a), (b), (c), 0, 0, 0)

constexpr int D = 1024;
constexpr int T = 16384;
constexpr int CTXL = 256;
constexpr int PB = T + CTXL;
constexpr int R = 2 * PB;
constexpr int INC = 6144;
constexpr int NE = 16;
constexpr int FF = 1408;
constexpr int SLOTS = 4224;
constexpr float EPS = 1e-6f;
constexpr float LOG2E = 1.4426950408889634f;
constexpr float TWO_PI_UNUSED = 6.283185307179586f;

constexpr size_t AL(size_t x) { return (x + 255) & ~(size_t)255; }
constexpr size_t O_WT_IN = 0;
constexpr size_t O_WT_BR = O_WT_IN + (size_t)INC * D * 2;
constexpr size_t O_WT_OUT = O_WT_BR + (size_t)4 * D * 256 * 2;
constexpr size_t O_WT_FN = O_WT_OUT + (size_t)D * D * 2;
constexpr size_t O_WT_13 = O_WT_FN + (size_t)256 * 256 * 2;
constexpr size_t O_WT_2 = O_WT_13 + (size_t)NE * 2 * FF * D * 2;
constexpr size_t O_WC = O_WT_2 + (size_t)NE * D * FF * 2;
constexpr size_t O_D1 = O_WC + (size_t)512 * 256 * 2;
constexpr size_t O_D2 = O_D1 + (size_t)256 * 256 * 2;
constexpr size_t O_DC = O_D2 + (size_t)128 * 256 * 2;
constexpr size_t O_ROPE = O_DC + (size_t)256 * 512 * 2;
constexpr size_t O_MOD = O_ROPE + (size_t)256 * 8 * 2 * 4;
constexpr size_t O_CONST = O_MOD + (size_t)2 * 3 * INC * 4;
constexpr size_t O_H = AL(O_CONST + 256);
constexpr size_t O_Z1 = O_H;
constexpr size_t O_Z2 = O_H + (size_t)2 * T * 512 * 2;
constexpr size_t O_Z1C = O_Z2 + (size_t)2 * T * 512 * 2;
constexpr size_t O_QPF = O_H + (size_t)R * D * 2;
constexpr size_t SZ256 = (size_t)R * 256 * 2;
constexpr size_t O_ACCM = O_QPF;
constexpr size_t O_GATES = O_QPF + 4 * SZ256;
constexpr size_t O_HID = O_GATES;
constexpr size_t O_KV = O_GATES + (size_t)R * 4096 * 2;
constexpr size_t O_Y = O_KV + 4 * SZ256;
constexpr size_t O_XCTX = O_Y + 4 * SZ256;
constexpr size_t O_AFF = O_XCTX + (size_t)512 * D * 4;
constexpr size_t O_ROWS = O_AFF + (size_t)4 * NE * T * 4;
constexpr size_t O_GL = O_ROWS + (size_t)NE * SLOTS * 4;
constexpr size_t O_BAR = AL(O_GL + (size_t)NE * SLOTS * 4);
constexpr size_t O_SMALLW1 = O_BAR + 16384;
constexpr size_t SMALLW = O_WT_13;
constexpr size_t WS_TOTAL = O_SMALLW1 + SMALLW;
static_assert(O_Z1C + (size_t)2 * 256 * 512 * 2 <= O_QPF, "fft scratch must fit in h");
static_assert((size_t)NE * SLOTS * FF * 2 <= (size_t)R * 4096 * 2, "hid must fit in gates");

struct Params {
  const float *x, *c, *ctx, *c_ctx, *w_ada, *b_ada, *g_mix, *g_ffn, *w_in, *na_q_g, *na_k_g, *na_rpb, *df_q_g,
      *df_k_g, *df_lambda, *df_subln_g, *pool_w, *pool_scale, *fnet_w, *w_branch, *w_out, *w_router, *w_gate_e,
      *w_up_e, *w_down_e;
  float* out;
  char* ws;
};

constexpr int SMEM_BYTES = 73728;
constexpr int LROW = 72;
constexpr int TILEB = 128 * LROW * 2;

DI int opaque_tid() { int t = threadIdx.x; asm volatile("" : "+v"(t)); return t; }
DI int opaque_bid() { int t = blockIdx.x; asm volatile("" : "+s"(t)); return t; }
DI size_t oq(size_t x) { asm volatile("" : "+s"(x)); return x; }
#define TIDX opaque_tid()
DI float bf2f(bf16_t b) { return __uint_as_float(((unsigned)b) << 16); }
DI unsigned pack2(float a, float b) {
  f2_t v = {a, b};
  bf2_t r = __builtin_convertvector(v, bf2_t);
  return __builtin_bit_cast(unsigned, r);
}
DI bf16_t f2bf(float a) { return (bf16_t)(pack2(a, 0.f) & 0xffffu); }
DI bf16x8 pack8(float a0, float a1, float a2, float a3, float a4, float a5, float a6, float a7) {
  uint4 u = {pack2(a0, a1), pack2(a2, a3), pack2(a4, a5), pack2(a6, a7)};
  return __builtin_bit_cast(bf16x8, u);
}
DI float wave_sum(float v) {
#pragma unroll
  for (int o = 32; o >= 1; o >>= 1) v += __shfl_xor(v, o, 64);
  return v;
}
DI int crow(int i, int hh) { return (i & 3) + 8 * (i >> 2) + 4 * hh; }
DI f32x16 fzero() {
  f32x16 z;
#pragma unroll
  for (int i = 0; i < 16; ++i) z[i] = 0.f;
  return z;
}
DI void row_info(int r, int& b, int& p) { b = r >= PB ? 1 : 0; p = r - b * PB; }
DI const float* x_in_row(const Params& P, int r) {
  int b, p; row_info(r, b, p);
  return p < T ? P.x + ((size_t)b * T + p) * D : P.ctx + ((size_t)b * CTXL + (p - T)) * D;
}
DI float* x_buf_row(const Params& P, int r) {
  int b, p; row_info(r, b, p);
  return p < T ? P.out + ((size_t)b * T + p) * D : (float*)(P.ws + oq(O_XCTX)) + ((size_t)b * CTXL + (p - T)) * D;
}
DI int row_modsel(int r) { int b, p; row_info(r, b, p); return p < T ? b : 2; }

template <class ARow>
DI void gemm_main(ARow arow, const bf16_t* __restrict__ Bt, long ldb, int K, char* smem, f32x16 (&acc)[2][2]) {
  const int tid = TIDX, lane = tid & 63, w = tid >> 6, wm = w >> 1, wn = w & 1;
  const int r = lane & 31, hh = lane >> 5;
  const int lrow = tid >> 3, lcc = (tid & 7) * 8;
  const bf16_t* pa[4];
#pragma unroll
  for (int i = 0; i < 4; ++i) pa[i] = arow(lrow + 32 * i) + lcc;
  const bf16_t* pb0 = Bt + (long)lrow * ldb + lcc;
  const long ldb32 = 32 * ldb;
  u32x4 ra0[4], rb0[4], ra1[4], rb1[4];
  const int nk = K >> 6;
#define G_LOAD1(RA, RB, kt, i) RA[i] = *(const u32x4*)(pa[i] + (kt) * 64); RB[i] = *(const u32x4*)(pb0 + i * ldb32 + (kt) * 64);
#define G_LOAD(RA, RB, kt) { G_LOAD1(RA, RB, kt, 0) G_LOAD1(RA, RB, kt, 1) G_LOAD1(RA, RB, kt, 2) G_LOAD1(RA, RB, kt, 3) }
#define G_STORE1(RA, RB, i) *(u32x4*)(base_ + ((lrow + 32 * i) * LROW + lcc) * 2) = RA[i]; *(u32x4*)(base_ + TILEB + ((lrow + 32 * i) * LROW + lcc) * 2) = RB[i];
#define G_STORE(RA, RB, buf) { char* base_ = smem + (buf) * 2 * TILEB; G_STORE1(RA, RB, 0) G_STORE1(RA, RB, 1) G_STORE1(RA, RB, 2) G_STORE1(RA, RB, 3) }
#define G_STEP(ks) { \
      bf16x8 a0 = *(const bf16x8*)(bA_ + ks * 32); \
      bf16x8 a1 = *(const bf16x8*)(bA_ + 32 * LROW * 2 + ks * 32); \
      bf16x8 b0 = *(const bf16x8*)(bB_ + ks * 32); \
      bf16x8 b1 = *(const bf16x8*)(bB_ + 32 * LROW * 2 + ks * 32); \
      acc[0][0] = MFMA32(a0, b0, acc[0][0]); \
      acc[0][1] = MFMA32(a0, b1, acc[0][1]); \
      acc[1][0] = MFMA32(a1, b0, acc[1][0]); \
      acc[1][1] = MFMA32(a1, b1, acc[1][1]); }
#define G_COMPUTE(buf) { \
    const char* bA_ = smem + (buf) * 2 * TILEB + ((wm * 64 + r) * LROW + hh * 8) * 2; \
    const char* bB_ = smem + (buf) * 2 * TILEB + TILEB + ((wn * 64 + r) * LROW + hh * 8) * 2; \
    G_STEP(0) G_STEP(1) G_STEP(2) G_STEP(3) }
  G_LOAD(ra0, rb0, 0);
  if (nk > 1) G_LOAD(ra1, rb1, 1);
  G_STORE(ra0, rb0, 0);
  if (nk > 2) G_LOAD(ra0, rb0, 2);
  for (int kt = 0; kt < nk; kt += 2) {
    __syncthreads();
    if (kt + 1 < nk) {
      G_STORE(ra1, rb1, 1);
      if (kt + 3 < nk) G_LOAD(ra1, rb1, kt + 3);
    }
    G_COMPUTE(0);
    if (kt + 1 < nk) {
      __syncthreads();
      if (kt + 2 < nk) {
        G_STORE(ra0, rb0, 0);
        if (kt + 4 < nk) G_LOAD(ra0, rb0, kt + 4);
      }
      G_COMPUTE(1);
    }
  }
  __syncthreads();
#undef G_LOAD
#undef G_STORE
#undef G_COMPUTE
#undef G_LOAD1
#undef G_STORE1
#undef G_STEP
}
struct PlainRows {
  const bf16_t* base; long ld;
  DI const bf16_t* operator()(int m) const { return base + (long)m * ld; }
};

constexpr int T2_B_OFF = 128 * LROW * 2;
template <class ARow>
DI void gemm_main2(ARow arow, const bf16_t* __restrict__ Bt, long ldb, int K, char* smem, f32x16 (&acc)[2][4]) {
  const int tid = TIDX, lane = tid & 63, w = tid >> 6, wm = w >> 1, wn = w & 1;
  const int r = lane & 31, hh = lane >> 5;
  const int lrow = tid >> 3, lcc = (tid & 7) * 8;
  const bf16_t* pa[4];
#pragma unroll
  for (int i = 0; i < 4; ++i) pa[i] = arow(lrow + 32 * i) + lcc;
  const bf16_t* pb0 = Bt + (long)lrow * ldb + lcc;
  const long ldb32 = 32 * ldb;
  u32x4 ra[4], rb[8];
  const int nk = K >> 6;
#define H_LA(i, kt) ra[i] = *(const u32x4*)(pa[i] + (kt) * 64);
#define H_LB(i, kt) rb[i] = *(const u32x4*)(pb0 + i * ldb32 + (kt) * 64);
#define H_LOAD(kt) { H_LA(0, kt) H_LA(1, kt) H_LA(2, kt) H_LA(3, kt) H_LB(0, kt) H_LB(1, kt) H_LB(2, kt) H_LB(3, kt) H_LB(4, kt) H_LB(5, kt) H_LB(6, kt) H_LB(7, kt) }
#define H_SA(i) *(u32x4*)(smem + ((lrow + 32 * i) * LROW + lcc) * 2) = ra[i];
#define H_SB(i) *(u32x4*)(smem + T2_B_OFF + ((lrow + 32 * i) * LROW + lcc) * 2) = rb[i];
#define H_STORE() { H_SA(0) H_SA(1) H_SA(2) H_SA(3) H_SB(0) H_SB(1) H_SB(2) H_SB(3) H_SB(4) H_SB(5) H_SB(6) H_SB(7) }
#define H_STEP(ks) { \
      bf16x8 a0 = *(const bf16x8*)(bA_ + ks * 32); \
      bf16x8 a1 = *(const bf16x8*)(bA_ + 32 * LROW * 2 + ks * 32); \
      bf16x8 b0 = *(const bf16x8*)(bB_ + ks * 32); \
      bf16x8 b1 = *(const bf16x8*)(bB_ + 32 * LROW * 2 + ks * 32); \
      bf16x8 b2 = *(const bf16x8*)(bB_ + 64 * LROW * 2 + ks * 32); \
      bf16x8 b3 = *(const bf16x8*)(bB_ + 96 * LROW * 2 + ks * 32); \
      acc[0][0] = MFMA32(a0, b0, acc[0][0]); \
      acc[1][0] = MFMA32(a1, b0, acc[1][0]); \
      acc[0][1] = MFMA32(a0, b1, acc[0][1]); \
      acc[1][1] = MFMA32(a1, b1, acc[1][1]); \
      acc[0][2] = MFMA32(a0, b2, acc[0][2]); \
      acc[1][2] = MFMA32(a1, b2, acc[1][2]); \
      acc[0][3] = MFMA32(a0, b3, acc[0][3]); \
      acc[1][3] = MFMA32(a1, b3, acc[1][3]); }
  const char* bA_ = smem + ((wm * 64 + r) * LROW + hh * 8) * 2;
  const char* bB_ = smem + T2_B_OFF + ((wn * 128 + r) * LROW + hh * 8) * 2;
  H_LOAD(0);
  for (int kt = 0; kt < nk; ++kt) {
    __syncthreads();
    H_STORE();
    __syncthreads();
    if (kt + 1 < nk) H_LOAD(kt + 1);
    H_STEP(0) H_STEP(1) H_STEP(2) H_STEP(3)
    __builtin_amdgcn_iglp_opt(0);
  }
  __syncthreads();
#undef H_LA
#undef H_LB
#undef H_LOAD
#undef H_SA
#undef H_SB
#undef H_STORE
#undef H_STEP
}
DI void zero_acc8(f32x16 (&acc)[2][4]) {
#pragma unroll
  for (int a = 0; a < 2; ++a)
#pragma unroll
    for (int b = 0; b < 4; ++b) acc[a][b] = fzero();
}

DI void transpose_tile(const float* __restrict__ src, long ld_src, bf16_t* __restrict__ dst, long ld_dst, int k0,
                       int n0, int rs, int off, char* smem) {
  float* Tt = (float*)smem;
  const int tid = TIDX;
#pragma unroll
  for (int i = 0; i < 4; ++i) {
    int k = (tid >> 4) + 16 * i, c4 = (tid & 15) * 4;
    float4 v = *(const float4*)(src + (long)(k0 + k) * ld_src + n0 + c4);
    Tt[k * 65 + c4 + 0] = v.x; Tt[k * 65 + c4 + 1] = v.y; Tt[k * 65 + c4 + 2] = v.z; Tt[k * 65 + c4 + 3] = v.w;
  }
  __syncthreads();
  const int n = tid >> 2, kq = (tid & 3) * 16;
  unsigned pk[8];
#pragma unroll
  for (int j = 0; j < 8; ++j) pk[j] = pack2(Tt[(kq + 2 * j) * 65 + n], Tt[(kq + 2 * j + 1) * 65 + n]);
  const int nn = n0 + n;
  const long drow = (long)(nn >> 5) * rs + off + (nn & 31);
  uint4* d = (uint4*)(dst + drow * ld_dst + k0 + kq);
  d[0] = make_uint4(pk[0], pk[1], pk[2], pk[3]);
  d[1] = make_uint4(pk[4], pk[5], pk[6], pk[7]);
  __syncthreads();
}

constexpr int WT_SMALL = 1536 + 256 + 256 + 16;
constexpr int WT_TILES = WT_SMALL + 5632 + 5632 + 5632;
DI size_t smallw(int l) { return l ? oq(O_SMALLW1) : (size_t)0; }
DI void convert_weight_tile(const Params& P, int l, int t, char* smem) {
  char* ws = P.ws;
  const size_t sw = smallw(l);
  if (t < 1536) {
    int kt = t / 96, nt = t % 96;
    transpose_tile(P.w_in + (size_t)l * D * INC, INC, (bf16_t*)(ws + sw + oq(O_WT_IN)), D, kt * 64, nt * 64, 32, 0, smem);
    return;
  }
  t -= 1536;
  if (t < 256) {
    int i = t >> 6, tt = t & 63, kt = tt >> 4, nt = tt & 15;
    transpose_tile(P.w_branch + ((size_t)l * 4 + i) * 256 * D, D, (bf16_t*)(ws + sw + oq(O_WT_BR)) + (size_t)i * D * 256, 256,
                   kt * 64, nt * 64, 32, 0, smem);
    return;
  }
  t -= 256;
  if (t < 256) {
    int kt = t >> 4, nt = t & 15;
    transpose_tile(P.w_out + (size_t)l * D * D, D, (bf16_t*)(ws + sw + oq(O_WT_OUT)), D, kt * 64, nt * 64, 32, 0, smem);
    return;
  }
  t -= 256;
  if (t < 16) {
    int kt = t >> 2, nt = t & 3;
    transpose_tile(P.fnet_w + (size_t)l * 256 * 256, 256, (bf16_t*)(ws + sw + oq(O_WT_FN)), 256, kt * 64, nt * 64, 32, 0, smem);
    return;
  }
  t -= 16;
  if (t < 11264) {
    int which = t >= 5632; if (which) t -= 5632;
    int e = t / 352, tt = t % 352, kt = tt / 22, nt = tt % 22;
    const float* src = (which ? P.w_up_e : P.w_gate_e) + ((size_t)l * NE + e) * D * FF;
    transpose_tile(src, FF, (bf16_t*)(ws + oq(O_WT_13)) + (size_t)e * 2 * FF * D, D, kt * 64, nt * 64, 64, which * 32, smem);
    return;
  }
  t -= 11264;
  {
    int e = t / 352, tt = t % 352, kt = tt / 16, nt = tt % 16;
    transpose_tile(P.w_down_e + ((size_t)l * NE + e) * FF * D, D, (bf16_t*)(ws + oq(O_WT_2)) + (size_t)e * D * FF, FF,
                   kt * 64, nt * 64, 32, 0, smem);
  }
}

DI void ada_task(const Params& P, int t, char* smem) {
  const int l = t / 96, n0 = (t % 96) * 64;
  float* sv = (float*)smem;
  float* red = sv + 3 * 1024;
  const int tid = TIDX;
  for (int i = tid; i < 3 * 1024; i += 256) {
    int s = i >> 10, k = i & 1023;
    float v = s < 2 ? P.c[s * D + k] : P.c_ctx[k];
    sv[i] = v / (1.f + __expf(-v));
  }
  __syncthreads();
  const int col = tid & 63, kg = tid >> 6;
  const float* wp = P.w_ada + (size_t)l * D * INC + n0 + col;
  float a0 = 0.f, a1 = 0.f, a2 = 0.f;
  for (int k = kg * 256; k < kg * 256 + 256; ++k) {
    float wv = wp[(size_t)k * INC];
    a0 += sv[k] * wv; a1 += sv[1024 + k] * wv; a2 += sv[2048 + k] * wv;
  }
  red[(kg * 3 + 0) * 64 + col] = a0; red[(kg * 3 + 1) * 64 + col] = a1; red[(kg * 3 + 2) * 64 + col] = a2;
  __syncthreads();
  if (tid < 192) {
    int s = tid >> 6, cc = tid & 63;
    float v = P.b_ada[(size_t)l * INC + n0 + cc];
    for (int g = 0; g < 4; ++g) v += red[(g * 3 + s) * 64 + cc];
    ((float*)(P.ws + oq(O_MOD)))[((size_t)l * 3 + s) * INC + n0 + cc] = v;
  }
  __syncthreads();
}

DI void tables_task(const Params& P, int t) {
  char* ws = P.ws;
  const int gtid = t * 256 + TIDX, gstride = 64 * 256;
  bf16_t* Wc = (bf16_t*)(ws + oq(O_WC));
  for (int i = gtid; i < 512 * 256; i += gstride) {
    int jj = i >> 8, c = i & 255, part = jj >> 8, j = jj & 255;
    float sn, cs; sincospif(2.f * (float)((j * c) & 255) / 256.f, &sn, &cs);
    Wc[i] = f2bf(part == 0 ? cs : -sn);
  }
  bf16_t* D1 = (bf16_t*)(ws + oq(O_D1));
  for (int i = gtid; i < 256 * 256; i += gstride) {
    int n = i >> 8, k = i & 255;
    int k1 = (n >> 6) * 32 + (n & 31), po = (n >> 5) & 1, pi = k >> 7, n1 = k & 127;
    float sn, cs; sincospif(2.f * (float)((k1 * n1) & 127) / 128.f, &sn, &cs);
    float v = po == 0 ? (pi == 0 ? cs : sn) : (pi == 0 ? -sn : cs);
    D1[i] = f2bf(v);
  }
  bf16_t* D2 = (bf16_t*)(ws + oq(O_D2));
  for (int i = gtid; i < 128 * 256; i += gstride) {
    int k2 = i >> 8, k = i & 255, pi = k >> 7, n2 = k & 127;
    float sn, cs; sincospif(2.f * (float)((k2 * n2) & 127) / 128.f, &sn, &cs);
    D2[i] = f2bf(pi == 0 ? cs : sn);
  }
  bf16_t* Dc = (bf16_t*)(ws + oq(O_DC));
  for (int i = gtid; i < 256 * 512; i += gstride) {
    int kk = i >> 9, k = i & 511, pi = k >> 8, n = k & 255;
    float sn, cs; sincospif(2.f * (float)((kk * n) & 255) / 256.f, &sn, &cs);
    Dc[i] = f2bf(pi == 0 ? cs : sn);
  }
  float* rope = (float*)(ws + oq(O_ROPE));
  for (int i = gtid; i < 256 * 8; i += gstride) {
    int pos = i >> 3, f = i & 7;
    float inv = powf(10000.f, -(float)f / 8.f);
    float ang = (float)pos * inv;
    rope[i * 2 + 0] = cosf(ang);
    rope[i * 2 + 1] = sinf(ang);
  }
  if (t == 0 && TIDX < 2) {
    const int l = TIDX;
    float* cst = (float*)(ws + oq(O_CONST)) + l * 8;
    const float* lv = P.df_lambda + l * 128;
    float d01 = 0.f, d23 = 0.f;
    for (int i = 0; i < 32; ++i) { d01 += lv[i] * lv[32 + i]; d23 += lv[64 + i] * lv[96 + i]; }
    float lam_init = 0.8f - 0.6f * expf(-0.3f * (float)l);
    cst[0] = expf(d01) - expf(d23) + lam_init;
    cst[1] = lam_init;
    float gq = 0.f, gk = 0.f;
    for (int i = 0; i < 32; ++i) { gq = fmaxf(gq, fabsf(P.df_q_g[l * 32 + i])); gk = fmaxf(gk, fabsf(P.df_k_g[l * 32 + i])); }
    cst[2] = sqrtf(32.f) * gq * gk * LOG2E;
    gq = 0.f; gk = 0.f;
    for (int i = 0; i < 64; ++i) { gq = fmaxf(gq, fabsf(P.na_q_g[l * 64 + i])); gk = fmaxf(gk, fabsf(P.na_k_g[l * 64 + i])); }
    float bm = 0.f;
    for (int i = 0; i < 4 * 15 * 31; ++i) bm = fmaxf(bm, fabsf(P.na_rpb[l * 4 * 15 * 31 + i]));
    cst[3] = (8.f * gq * gk + bm) * LOG2E;
  }
}

DI void modnorm_phase(const Params& P, int l, bool second, int bid, int nb, char* smem) {
  const int lane = TIDX & 63, w = TIDX >> 6;
  const int nw = nb * 4;
  bf16_t* h = (bf16_t*)(P.ws + oq(O_H));
  const float* g = (second ? P.g_ffn : P.g_mix) + (size_t)l * D;
  float* wt = (float*)smem;
  if (second) {
    const float* wr = P.w_router + (size_t)l * D * NE;
    for (int idx = TIDX; idx < D * NE; idx += 256) wt[(idx & 15) * D + (idx >> 4)] = wr[idx];
    __syncthreads();
  }
  for (int r = bid * 4 + w; r < R; r += nw) {
    int b, p; row_info(r, b, p);
    const bool isctx = p >= T;
    if (l == 1 && second && isctx) continue;
    const float* src = (l == 0 && !second) ? x_in_row(P, r) : x_buf_row(P, r);
    const int s = isctx ? 2 : b;
    const float* mb = (const float*)(P.ws + oq(O_MOD)) + ((size_t)l * 3 + s) * INC + (second ? 3 * D : 0);
    float4 v[4];
    float ss = 0.f;
#pragma unroll
    for (int i = 0; i < 4; ++i) {
      v[i] = *(const float4*)(src + lane * 4 + 256 * i);
      ss += v[i].x * v[i].x + v[i].y * v[i].y + v[i].z * v[i].z + v[i].w * v[i].w;
    }
    ss = wave_sum(ss);
    const float rstd = rsqrtf(ss * (1.f / D) + EPS);
    float hv[16];
#pragma unroll
    for (int i = 0; i < 4; ++i) {
      const int c = lane * 4 + 256 * i;
      float4 gg = *(const float4*)(g + c), sh = *(const float4*)(mb + c), sc = *(const float4*)(mb + D + c);
      hv[i * 4 + 0] = v[i].x * rstd * gg.x * (1.f + sc.x) + sh.x;
      hv[i * 4 + 1] = v[i].y * rstd * gg.y * (1.f + sc.y) + sh.y;
      hv[i * 4 + 2] = v[i].z * rstd * gg.z * (1.f + sc.z) + sh.z;
      hv[i * 4 + 3] = v[i].w * rstd * gg.w * (1.f + sc.w) + sh.w;
      uint2 o = {pack2(hv[i * 4 + 0], hv[i * 4 + 1]), pack2(hv[i * 4 + 2], hv[i * 4 + 3])};
      *(uint2*)(h + (size_t)r * D + c) = o;
    }
    if (second) {
      float lg[16];
#pragma unroll
      for (int e = 0; e < 16; ++e) lg[e] = 0.f;
#pragma unroll
      for (int i = 0; i < 4; ++i) {
#pragma unroll
        for (int e = 0; e < 16; ++e) {
          const float4 w4 = *(const float4*)(wt + e * D + 256 * i + lane * 4);
          lg[e] += hv[i * 4 + 0] * w4.x + hv[i * 4 + 1] * w4.y + hv[i * 4 + 2] * w4.z + hv[i * 4 + 3] * w4.w;
          if ((e & 3) == 3) __builtin_amdgcn_sched_barrier(0);
        }
      }
      float mx = -1e30f;
#pragma unroll
      for (int e = 0; e < 16; ++e) { lg[e] = wave_sum(lg[e]); mx = fmaxf(mx, lg[e]); }
      float sum = 0.f, mine = 0.f;
#pragma unroll
      for (int e = 0; e < 16; ++e) { float ex = __expf(lg[e] - mx); sum += ex; if (lane == e) mine = ex; }
      if (lane < 16) {
        const int smp = isctx ? 2 + b : b, n = isctx ? p - T : p;
        ((float*)(P.ws + oq(O_AFF)))[((size_t)smp * NE + lane) * T + n] = mine / sum;
      }
    }
  }
  __syncthreads();
}

template <int G>
DI void epi_rms(const float* Tt, const float* __restrict__ gain, bool rope, const float* __restrict__ ropetab,
                float scale, bf16_t* __restrict__ dst, int dcol0, int r0) {
  constexpr int NG = 128 / G;
  for (int it = TIDX; it < 128 * NG; it += 256) {
    const int row = it / NG, grp = it % NG;
    const float* tp = Tt + row * 132 + grp * G;
    float ss = 0.f;
#pragma unroll
    for (int d = 0; d < G; d += 4) {
      float4 q = *(const float4*)(tp + d);
      ss += q.x * q.x + q.y * q.y + q.z * q.z + q.w * q.w;
    }
    const float rstd = rsqrtf(ss * (1.f / G) + EPS);
    const float* gp = gain;
    asm volatile("" : "+s"(gp));
    int b, p; row_info(r0 + row, b, p);
    const bool dorope = (G == 32) && rope && (p < T);
    uint4* dp = (uint4*)(dst + (size_t)(r0 + row) * 256 + dcol0 + grp * G);
#pragma unroll 1
    for (int sub = 0; sub < G / 16; ++sub) {
      float v[16];
#pragma unroll
      for (int d = 0; d < 16; d += 4) {
        float4 q = *(const float4*)(tp + sub * 16 + d);
        float4 g4 = *(const float4*)(gp + sub * 16 + d);
        v[d] = q.x * rstd * g4.x; v[d + 1] = q.y * rstd * g4.y; v[d + 2] = q.z * rstd * g4.z; v[d + 3] = q.w * rstd * g4.w;
      }
      if (dorope) {
        const int pos = sub ? (p & 63) : (p >> 6);
#pragma unroll
        for (int i = 0; i < 8; ++i) {
          const float2 cssn = *(const float2*)(ropetab + (pos * 8 + i) * 2);
          const float x1 = v[i], x2 = v[8 + i];
          v[i] = x1 * cssn.x - x2 * cssn.y;
          v[8 + i] = x1 * cssn.y + x2 * cssn.x;
        }
      }
      dp[sub * 2] = make_uint4(pack2(v[0] * scale, v[1] * scale), pack2(v[2] * scale, v[3] * scale),
                               pack2(v[4] * scale, v[5] * scale), pack2(v[6] * scale, v[7] * scale));
      dp[sub * 2 + 1] = make_uint4(pack2(v[8] * scale, v[9] * scale), pack2(v[10] * scale, v[11] * scale),
                                   pack2(v[12] * scale, v[13] * scale), pack2(v[14] * scale, v[15] * scale));
    }
  }
}
DI void epi_plain(const float* Tt, bf16_t* __restrict__ dst, int dcol0, int r0) {
  const int row = TIDX >> 1, c0 = (TIDX & 1) * 64;
  uint4* dp = (uint4*)(dst + (size_t)(r0 + row) * 256 + dcol0 + c0);
#pragma unroll
  for (int d = 0; d < 64; d += 8) {
    float4 a = *(const float4*)(Tt + row * 132 + c0 + d), b = *(const float4*)(Tt + row * 132 + c0 + d + 4);
    dp[d >> 3] = make_uint4(pack2(a.x, a.y), pack2(a.z, a.w), pack2(b.x, b.y), pack2(b.z, b.w));
  }
}
DI void epi_transposed(const float* Tt, bf16_t* __restrict__ vt, int hd0, int bb, int p0) {
  const int c = TIDX >> 1, half = TIDX & 1;
  const int hd = hd0 + c;
  uint4* dp = (uint4*)(vt + ((size_t)bb * 256 + hd) * PB + p0 + half * 64);
#pragma unroll
  for (int q = 0; q < 8; ++q) {
    float f[8];
#pragma unroll
    for (int j = 0; j < 8; ++j) f[j] = Tt[(half * 64 + q * 8 + j) * 132 + c];
    dp[q] = make_uint4(pack2(f[0], f[1]), pack2(f[2], f[3]), pack2(f[4], f[5]), pack2(f[6], f[7]));
  }
}

DI void inproj_tile(const Params& P, int l, int mt, int nt, char* smem) {
  char* ws = P.ws;
  const int r0 = mt * 128;
  f32x16 acc[2][4];
  zero_acc8(acc);
  PlainRows ar{(const bf16_t*)(ws + oq(O_H)) + (size_t)r0 * D, D};
  gemm_main2(ar, (const bf16_t*)(ws + smallw(l) + oq(O_WT_IN)) + (size_t)nt * 256 * D, D, D, smem, acc);
  const int tid = TIDX, lane = tid & 63, w = tid >> 6, wm = w >> 1, wn = w & 1, r = lane & 31, hh = lane >> 5;
  if (nt >= 4 && nt < 20) {
    bf16_t* gates = (bf16_t*)(ws + oq(O_GATES));
#pragma unroll
    for (int mb = 0; mb < 2; ++mb)
#pragma unroll
      for (int nb2 = 0; nb2 < 4; ++nb2) {
        const int mt32 = mt * 4 + wm * 2 + mb, nt32 = (nt - 4) * 8 + wn * 4 + nb2;
        float sg[16];
#pragma unroll
        for (int i = 0; i < 16; ++i) sg[i] = 1.f / (1.f + __expf(-acc[mb][nb2][i]));
        uint4* gp = (uint4*)(gates + (((size_t)mt32 * 128 + nt32) * 64 + lane) * 16);
        gp[0] = make_uint4(pack2(sg[0], sg[1]), pack2(sg[2], sg[3]), pack2(sg[4], sg[5]), pack2(sg[6], sg[7]));
        gp[1] = make_uint4(pack2(sg[8], sg[9]), pack2(sg[10], sg[11]), pack2(sg[12], sg[13]), pack2(sg[14], sg[15]));
      }
    return;
  }
  float* Tt = (float*)smem;
  bf16_t* qpf = (bf16_t*)(ws + oq(O_QPF));
  bf16_t* kv = (bf16_t*)(ws + oq(O_KV));
  const float* ropetab = (const float*)(ws + oq(O_ROPE));
  const size_t S = (size_t)R * 256;
  int bb, p0; row_info(r0, bb, p0);
#pragma unroll 1
  for (int half = 0; half < 2; ++half) {
    if (wn == half) {
#pragma unroll
      for (int mb = 0; mb < 2; ++mb)
#pragma unroll
        for (int nb2 = 0; nb2 < 4; ++nb2)
#pragma unroll
          for (int i = 0; i < 16; ++i) {
            const int m = wm * 64 + mb * 32 + crow(i, hh), n = nb2 * 32 + r;
            Tt[m * 132 + n] = acc[mb][nb2][i];
          }
    }
    __syncthreads();
    const int dc = half * 128;
    if (nt == 0) epi_rms<64>(Tt, P.na_q_g + l * 64, false, ropetab, 0.125f * LOG2E, qpf, dc, r0);
    else if (nt == 1) epi_rms<32>(Tt, P.df_q_g + l * 32, true, ropetab, 0.17677669529663687f * LOG2E, qpf + S, dc, r0);
    else if (nt == 2) epi_plain(Tt, qpf + 2 * S, dc, r0);
    else if (nt == 3) epi_plain(Tt, qpf + 3 * S, dc, r0);
    else if (nt == 20) epi_rms<64>(Tt, P.na_k_g + l * 64, false, ropetab, 1.f, kv, dc, r0);
    else if (nt == 21) epi_transposed(Tt, kv + 2 * S, dc, bb, p0);
    else if (nt == 22) epi_rms<32>(Tt, P.df_k_g + l * 32, true, ropetab, 1.f, kv + S, dc, r0);
    else epi_transposed(Tt, kv + 3 * S, dc, bb, p0);
    __syncthreads();
  }
}

DI void diffattn_task(const Params& P, int l, int b, int hd, int q0, int key_lo, int nkeys, char* smem) {
  char* ws = P.ws;
  const int tid = TIDX, lane = tid & 63, w = tid >> 6, r = lane & 31, hh = lane >> 5;
  const bf16_t* qd = (const bf16_t*)(ws + oq(O_QPF)) + (size_t)R * 256;
  const bf16_t* kd = (const bf16_t*)(ws + oq(O_KV)) + (size_t)R * 256;
  const bf16_t* vt = (const bf16_t*)(ws + oq(O_KV)) + (size_t)3 * R * 256;
  bf16_t* yd = (bf16_t*)(ws + oq(O_Y)) + (size_t)R * 256;
  const float* cst = (const float*)(ws + oq(O_CONST)) + l * 8;
  const float lam = cst[0], lam_init = cst[1], negC = -cst[2];
  const int qrow = b * PB + q0 + w * 32 + r;
  bf16x8 qf[2][2];
#pragma unroll
  for (int m = 0; m < 2; ++m)
#pragma unroll
    for (int ks = 0; ks < 2; ++ks)
      qf[m][ks] = *(const bf16x8*)(qd + (size_t)qrow * 256 + hd * 64 + m * 32 + ks * 16 + hh * 8);
  f32x16 O[2][2];
  O[0][0] = O[0][1] = O[1][0] = O[1][1] = fzero();
  float ls0 = 0.f, ls1 = 0.f;
  constexpr int KT = 64 * LROW * 2;
  const bf16_t* kbase = kd + ((size_t)b * PB + key_lo) * 256 + hd * 64;
  const bf16_t* vbase = vt + ((size_t)(b * 4 + hd) * 64) * PB + key_lo;
  const int c0 = tid, c1 = tid + 256;
  u32x4 rk0, rk1, rv0, rv1;
#define DA_LOAD(t)                                                                       \
  {                                                                                      \
    rk0 = *(const u32x4*)(kbase + ((size_t)((t) * 64 + (c0 >> 3))) * 256 + (c0 & 7) * 8); \
    rk1 = *(const u32x4*)(kbase + ((size_t)((t) * 64 + (c1 >> 3))) * 256 + (c1 & 7) * 8); \
    rv0 = *(const u32x4*)(vbase + (size_t)(c0 >> 3) * PB + (t) * 64 + (c0 & 7) * 8);      \
    rv1 = *(const u32x4*)(vbase + (size_t)(c1 >> 3) * PB + (t) * 64 + (c1 & 7) * 8);      \
  }
#define DA_STORE(buf)                                                          \
  {                                                                            \
    char* kb_ = smem + (buf) * 2 * KT;                                         \
    *(u32x4*)(kb_ + ((c0 >> 3) * LROW + (c0 & 7) * 8) * 2) = rk0;              \
    *(u32x4*)(kb_ + ((c1 >> 3) * LROW + (c1 & 7) * 8) * 2) = rk1;              \
    *(u32x4*)(kb_ + KT + ((c0 >> 3) * LROW + (c0 & 7) * 8) * 2) = rv0;         \
    *(u32x4*)(kb_ + KT + ((c1 >> 3) * LROW + (c1 & 7) * 8) * 2) = rv1;         \
  }
  const int nt = nkeys >> 6;
  DA_LOAD(0);
  DA_STORE(0);
  if (nt > 1) DA_LOAD(1);
  for (int t = 0; t < nt; ++t) {
    __syncthreads();
    if (t + 1 < nt) {
      DA_STORE((t + 1) & 1);
      if (t + 2 < nt) DA_LOAD(t + 2);
    }
    const char* Ks = smem + (t & 1) * 2 * KT;
    const char* Vs = Ks + KT;
#pragma unroll 1
    for (int kb = 0; kb < 2; ++kb) {
      f32x16 S0, S1;
#pragma unroll
      for (int i = 0; i < 16; ++i) { S0[i] = negC; S1[i] = negC; }
#pragma unroll
      for (int ks = 0; ks < 2; ++ks) {
        bf16x8 k0 = *(const bf16x8*)(Ks + ((kb * 32 + r) * LROW + ks * 16 + hh * 8) * 2);
        bf16x8 k1 = *(const bf16x8*)(Ks + ((kb * 32 + r) * LROW + 32 + ks * 16 + hh * 8) * 2);
        S0 = MFMA32(k0, qf[0][ks], S0);
        S1 = MFMA32(k1, qf[1][ks], S1);
      }
#pragma unroll
      for (int i = 0; i < 16; ++i) {
        S0[i] = __builtin_amdgcn_exp2f(S0[i]); ls0 += S0[i];
        S1[i] = __builtin_amdgcn_exp2f(S1[i]); ls1 += S1[i];
      }
#pragma unroll
      for (int s = 0; s < 2; ++s) {
        bf16x8 p0 = pack8(S0[8 * s], S0[8 * s + 1], S0[8 * s + 2], S0[8 * s + 3], S0[8 * s + 4], S0[8 * s + 5], S0[8 * s + 6], S0[8 * s + 7]);
        bf16x8 p1 = pack8(S1[8 * s], S1[8 * s + 1], S1[8 * s + 2], S1[8 * s + 3], S1[8 * s + 4], S1[8 * s + 5], S1[8 * s + 6], S1[8 * s + 7]);
#pragma unroll
        for (int vb = 0; vb < 2; ++vb) {
          const char* vp = Vs + ((vb * 32 + r) * LROW + kb * 32 + 16 * s + 4 * hh) * 2;
          s16x4 lo = *(const s16x4*)vp, hi = *(const s16x4*)(vp + 16);
          bf16x8 vf = __builtin_shufflevector(lo, hi, 0, 1, 2, 3, 4, 5, 6, 7);
          O[0][vb] = MFMA32(vf, p0, O[0][vb]);
          O[1][vb] = MFMA32(vf, p1, O[1][vb]);
        }
      }
    }
  }
  __syncthreads();
#undef DA_LOAD
#undef DA_STORE
  ls0 += __shfl_xor(ls0, 32, 64);
  ls1 += __shfl_xor(ls1, 32, 64);
  const float i0 = 1.f / ls0, i1 = lam / ls1;
  float ssq = 0.f;
#pragma unroll
  for (int vb = 0; vb < 2; ++vb)
#pragma unroll
    for (int i = 0; i < 16; ++i) {
      float o = O[0][vb][i] * i0 - O[1][vb][i] * i1;
      O[0][vb][i] = o;
      ssq += o * o;
    }
  ssq += __shfl_xor(ssq, 32, 64);
  const float rstd = rsqrtf(ssq * (1.f / 64.f) + EPS) * (1.f - lam_init);
  const float* sg = P.df_subln_g + l * 64;
#pragma unroll
  for (int vb = 0; vb < 2; ++vb)
#pragma unroll
    for (int g4 = 0; g4 < 4; ++g4) {
      const int vd = vb * 32 + 8 * g4 + 4 * hh;
      float o0 = O[0][vb][4 * g4] * rstd * sg[vd], o1 = O[0][vb][4 * g4 + 1] * rstd * sg[vd + 1];
      float o2 = O[0][vb][4 * g4 + 2] * rstd * sg[vd + 2], o3 = O[0][vb][4 * g4 + 3] * rstd * sg[vd + 3];
      uint2 pk = {pack2(o0, o1), pack2(o2, o3)};
      *(uint2*)(yd + (size_t)qrow * 256 + hd * 64 + vd) = pk;
    }
}

DI void na_task(const Params& P, int l, int b, bool ctxq, int rr, int qsel, char* smem) {
  char* ws = P.ws;
  const int tid = TIDX, lane = tid & 63, hd = tid >> 6, r = lane & 31, hh = lane >> 5;
  float* rp = (float*)smem;
  if (!ctxq) {
    for (int i = tid; i < 4 * 15 * 31; i += 256) rp[i] = P.na_rpb[(size_t)l * 4 * 15 * 31 + i] * LOG2E;
  }
  __syncthreads();
  const bf16_t* qn = (const bf16_t*)(ws + oq(O_QPF));
  const bf16_t* kn = (const bf16_t*)(ws + oq(O_KV));
  const bf16_t* vt = (const bf16_t*)(ws + oq(O_KV)) + (size_t)2 * R * 256;
  bf16_t* yn = (bf16_t*)(ws + oq(O_Y));
  const float negC = -((const float*)(ws + oq(O_CONST)))[l * 8 + 3];
  const int c = qsel * 32 + r;
  const int qp = ctxq ? T + c : rr * 64 + c;
  const int qrow = b * PB + qp;
  bf16x8 qf[4];
#pragma unroll
  for (int ks = 0; ks < 4; ++ks) qf[ks] = *(const bf16x8*)(qn + (size_t)qrow * 256 + hd * 64 + ks * 16 + hh * 8);
  f32x16 O[2];
  O[0] = O[1] = fzero();
  float ls = 0.f;
  const int rs = min(max(rr - 4, 0), 248);
  const int cs = min(max(c - 8, 0), 48);
  const int nblk = ctxq ? 8 : 24;
  const bf16_t* vtb = vt + ((size_t)(b * 4 + hd) * 64) * PB;
  for (int kbi = 0; kbi < nblk; ++kbi) {
    const bool loc = !ctxq && kbi < 16;
    const int ir = kbi >> 1, kb = kbi & 1;
    const int pk0 = loc ? (rs + ir) * 64 + kb * 32 : T + (kbi - (ctxq ? 0 : 16)) * 32;
    f32x16 S;
#pragma unroll
    for (int i = 0; i < 16; ++i) S[i] = negC;
    const bf16_t* kp = kn + ((size_t)b * PB + pk0 + r) * 256 + hd * 64 + hh * 8;
#pragma unroll
    for (int ks = 0; ks < 4; ++ks) {
      bf16x8 kf = *(const bf16x8*)(kp + ks * 16);
      S = MFMA32(kf, qf[ks], S);
    }
    if (loc) {
      const float* rpr = rp + (hd * 15 + (rs + ir - rr + 7)) * 31;
#pragma unroll
      for (int i = 0; i < 16; ++i) {
        const int kc = kb * 32 + crow(i, hh);
        const bool valid = (kc >= cs) && (kc < cs + 16);
        const int ci = min(max(kc - c + 15, 0), 30);
        const float pv = __builtin_amdgcn_exp2f(S[i] + rpr[ci]);
        S[i] = valid ? pv : 0.f;
        ls += S[i];
      }
    } else {
#pragma unroll
      for (int i = 0; i < 16; ++i) { S[i] = __builtin_amdgcn_exp2f(S[i]); ls += S[i]; }
    }
#pragma unroll
    for (int s = 0; s < 2; ++s) {
      bf16x8 pf = pack8(S[8 * s], S[8 * s + 1], S[8 * s + 2], S[8 * s + 3], S[8 * s + 4], S[8 * s + 5], S[8 * s + 6], S[8 * s + 7]);
#pragma unroll
      for (int vb = 0; vb < 2; ++vb) {
        const bf16_t* vp = vtb + (size_t)(vb * 32 + r) * PB + pk0 + 16 * s + 4 * hh;
        s16x4 lo = *(const s16x4*)vp, hi = *(const s16x4*)(vp + 8);
        bf16x8 vf = __builtin_shufflevector(lo, hi, 0, 1, 2, 3, 4, 5, 6, 7);
        O[vb] = MFMA32(vf, pf, O[vb]);
      }
    }
  }
  ls += __shfl_xor(ls, 32, 64);
  const float inv = 1.f / ls;
#pragma unroll
  for (int vb = 0; vb < 2; ++vb)
#pragma unroll
    for (int g4 = 0; g4 < 4; ++g4) {
      const int vd = vb * 32 + 8 * g4 + 4 * hh;
      uint2 pk = {pack2(O[vb][4 * g4] * inv, O[vb][4 * g4 + 1] * inv), pack2(O[vb][4 * g4 + 2] * inv, O[vb][4 * g4 + 3] * inv)};
      *(uint2*)(yn + (size_t)qrow * 256 + hd * 64 + vd) = pk;
    }
  __syncthreads();
}

DI void pool_task(const Params& P, int l, int tile, char* smem) {
  char* ws = P.ws;
  const int tid = TIDX;
  const int r0 = tile * 32;
  int b, p0; row_info(r0, b, p0);
  const bool isctx = p0 >= T;
  const int seq0 = isctx ? T : 0, N = isctx ? CTXL : T;
  const int t0 = p0 - seq0;
  const bf16_t* pin = (const bf16_t*)(ws + oq(O_QPF)) + (size_t)2 * R * 256;
  bf16_t* yp = (bf16_t*)(ws + oq(O_Y)) + (size_t)2 * R * 256;
  bf16_t* us = (bf16_t*)smem;
  float* ds = (float*)(smem + 48 * 256 * 2);
  for (int i = tid; i < 48 * 32; i += 256) {
    const int rowi = i >> 5, ch = (i & 31) * 8;
    const int tk = t0 - 8 + rowi;
    uint4 v = make_uint4(0, 0, 0, 0);
    if (tk >= 0 && tk < N) v = *(const uint4*)(pin + ((size_t)b * PB + seq0 + tk) * 256 + ch);
    *(uint4*)(us + rowi * 256 + ch) = v;
  }
  __syncthreads();
  {
    const int ch = tid, gi = ch >> 6, wv = 2 << gi;
    for (int t = 0; t < 32; ++t) {
      const int tk = t0 + t;
      const int lo = max(tk - wv / 2, 0), hi = min(tk + wv / 2, N);
      float s = 0.f;
      for (int q = lo; q < hi; ++q) s += bf2f(us[(q - t0 + 8) * 256 + ch]);
      ds[t * 256 + ch] = s / (float)(hi - lo) - bf2f(us[(t + 8) * 256 + ch]);
    }
  }
  __syncthreads();
  {
    const int o = tid, gi = o >> 6;
    const float* wp = P.pool_w + ((size_t)l * 4 + gi) * 64 * 64 + (o & 63);
    float acc[32];
#pragma unroll
    for (int t = 0; t < 32; ++t) acc[t] = 0.f;
    for (int k = 0; k < 64; ++k) {
      const float wv = wp[k * 64];
#pragma unroll
      for (int t = 0; t < 32; ++t) acc[t] += ds[t * 256 + gi * 64 + k] * wv;
    }
    const float sc = P.pool_scale[l * 256 + o];
#pragma unroll
    for (int t = 0; t < 32; ++t) yp[(size_t)(r0 + t) * 256 + o] = f2bf(acc[t] * sc);
  }
  __syncthreads();
}

struct StridedRows {
  const bf16_t* base; long ld;
  DI const bf16_t* operator()(int m) const { return base + (long)m * ld; }
};
DI void fft_stage0_lat(const Params& P, int task, char* smem) {
  char* ws = P.ws;
  const int ntile = task & 3, n2 = (task >> 2) & 127, b = task >> 9;
  const bf16_t* fin = (const bf16_t*)(ws + oq(O_QPF)) + (size_t)3 * R * 256;
  f32x16 acc[2][2];
  acc[0][0] = acc[0][1] = acc[1][0] = acc[1][1] = fzero();
  StridedRows ar{fin + ((size_t)b * PB + n2) * 256, 128 * 256};
  gemm_main(ar, (const bf16_t*)(ws + oq(O_WC)) + (size_t)ntile * 128 * 256, 256, 256, smem, acc);
  bf16_t* Z1 = (bf16_t*)(ws + oq(O_Z1));
  const int lane = TIDX & 63, w = TIDX >> 6, wm = w >> 1, wn = w & 1, r = lane & 31, hh = lane >> 5;
#pragma unroll
  for (int mb = 0; mb < 2; ++mb)
#pragma unroll
    for (int nb2 = 0; nb2 < 2; ++nb2) {
      const int jj = ntile * 128 + wn * 64 + nb2 * 32 + r, part = jj >> 8, j = jj & 255;
#pragma unroll
      for (int g4 = 0; g4 < 4; ++g4) {
        const int n1 = wm * 64 + mb * 32 + 8 * g4 + 4 * hh;
        uint2 pk = {pack2(acc[mb][nb2][4 * g4], acc[mb][nb2][4 * g4 + 1]), pack2(acc[mb][nb2][4 * g4 + 2], acc[mb][nb2][4 * g4 + 3])};
        *(uint2*)(Z1 + (((size_t)(b * 128 + n2) * 256 + j) * 256 + part * 128 + n1)) = pk;
      }
    }
}
DI void fft_stage0_ctx(const Params& P, int task, char* smem) {
  char* ws = P.ws;
  const int ntile = task & 3, mtile = (task >> 2) & 1, b = task >> 3;
  const bf16_t* fin = (const bf16_t*)(ws + oq(O_QPF)) + (size_t)3 * R * 256;
  f32x16 acc[2][2];
  acc[0][0] = acc[0][1] = acc[1][0] = acc[1][1] = fzero();
  PlainRows ar{fin + ((size_t)b * PB + T + mtile * 128) * 256, 256};
  gemm_main(ar, (const bf16_t*)(ws + oq(O_WC)) + (size_t)ntile * 128 * 256, 256, 256, smem, acc);
  bf16_t* Z1c = (bf16_t*)(ws + oq(O_Z1C));
  const int lane = TIDX & 63, w = TIDX >> 6, wm = w >> 1, wn = w & 1, r = lane & 31, hh = lane >> 5;
#pragma unroll
  for (int mb = 0; mb < 2; ++mb)
#pragma unroll
    for (int nb2 = 0; nb2 < 2; ++nb2) {
      const int jj = ntile * 128 + wn * 64 + nb2 * 32 + r, part = jj >> 8, j = jj & 255;
#pragma unroll
      for (int g4 = 0; g4 < 4; ++g4) {
        const int n = mtile * 128 + wm * 64 + mb * 32 + 8 * g4 + 4 * hh;
        uint2 pk = {pack2(acc[mb][nb2][4 * g4], acc[mb][nb2][4 * g4 + 1]), pack2(acc[mb][nb2][4 * g4 + 2], acc[mb][nb2][4 * g4 + 3])};
        *(uint2*)(Z1c + (((size_t)(b * 256 + j)) * 512 + part * 256 + n)) = pk;
      }
    }
}
DI void fft_stage1_lat(const Params& P, int task, char* smem) {
  char* ws = P.ws;
  const int ntile = task & 1, j = (task >> 1) & 255, b = task >> 9;
  f32x16 acc[2][2];
  acc[0][0] = acc[0][1] = acc[1][0] = acc[1][1] = fzero();
  StridedRows ar{(const bf16_t*)(ws + oq(O_Z1)) + ((size_t)(b * 128) * 256 + j) * 256, 256 * 256};
  gemm_main(ar, (const bf16_t*)(ws + oq(O_D1)) + (size_t)ntile * 128 * 256, 256, 256, smem, acc);
  bf16_t* Z2 = (bf16_t*)(ws + oq(O_Z2));
  const int lane = TIDX & 63, w = TIDX >> 6, wm = w >> 1, wn = w & 1, r = lane & 31, hh = lane >> 5;
  const int k1 = (ntile * 2 + wn) * 32 + r;
#pragma unroll
  for (int mb = 0; mb < 2; ++mb)
#pragma unroll
    for (int g4 = 0; g4 < 4; ++g4) {
      const int n2 = wm * 64 + mb * 32 + 8 * g4 + 4 * hh;
      float yr[4], yi[4];
#pragma unroll
      for (int q = 0; q < 4; ++q) {
        const float re = acc[mb][0][4 * g4 + q], im = acc[mb][1][4 * g4 + q];
        float sn, cs; sincospif(2.f * (float)((k1 * (n2 + q)) & 16383) / 16384.f, &sn, &cs);
        yr[q] = re * cs + im * sn;
        yi[q] = im * cs - re * sn;
      }
      bf16_t* zp = Z2 + (((size_t)(b * 128 + k1) * 256 + j) * 256 + n2);
      uint2 pr = {pack2(yr[0], yr[1]), pack2(yr[2], yr[3])}, pi = {pack2(yi[0], yi[1]), pack2(yi[2], yi[3])};
      *(uint2*)zp = pr;
      *(uint2*)(zp + 128) = pi;
    }
}
DI void fft_stage1_ctx(const Params& P, int task, char* smem) {
  char* ws = P.ws;
  const int ntile = task & 1, mtile = (task >> 1) & 1, b = task >> 2;
  f32x16 acc[2][2];
  acc[0][0] = acc[0][1] = acc[1][0] = acc[1][1] = fzero();
  PlainRows ar{(const bf16_t*)(ws + oq(O_Z1C)) + ((size_t)(b * 256 + mtile * 128)) * 512, 512};
  gemm_main(ar, (const bf16_t*)(ws + oq(O_DC)) + (size_t)ntile * 128 * 512, 512, 512, smem, acc);
  bf16_t* f = (bf16_t*)(ws + oq(O_QPF)) + (size_t)3 * R * 256;
  const int lane = TIDX & 63, w = TIDX >> 6, wm = w >> 1, wn = w & 1, r = lane & 31, hh = lane >> 5;
#pragma unroll
  for (int mb = 0; mb < 2; ++mb)
#pragma unroll
    for (int nb2 = 0; nb2 < 2; ++nb2) {
      const int k = ntile * 128 + wn * 64 + nb2 * 32 + r;
#pragma unroll
      for (int g4 = 0; g4 < 4; ++g4) {
        const int j = mtile * 128 + wm * 64 + mb * 32 + 8 * g4 + 4 * hh;
        const float sc = 1.f / 256.f;
        uint2 pk = {pack2(acc[mb][nb2][4 * g4] * sc, acc[mb][nb2][4 * g4 + 1] * sc),
                    pack2(acc[mb][nb2][4 * g4 + 2] * sc, acc[mb][nb2][4 * g4 + 3] * sc)};
        *(uint2*)(f + ((size_t)b * PB + T + k) * 256 + j) = pk;
      }
    }
}
DI void fft_stage2_lat(const Params& P, int task, char* smem) {
  char* ws = P.ws;
  const int jt = task & 1, k1 = (task >> 1) & 127, b = task >> 8;
  f32x16 acc[2][2];
  acc[0][0] = acc[0][1] = acc[1][0] = acc[1][1] = fzero();
  PlainRows ar{(const bf16_t*)(ws + oq(O_Z2)) + ((size_t)(b * 128 + k1) * 256 + jt * 128) * 256, 256};
  gemm_main(ar, (const bf16_t*)(ws + oq(O_D2)), 256, 256, smem, acc);
  bf16_t* f = (bf16_t*)(ws + oq(O_QPF)) + (size_t)3 * R * 256;
  const int lane = TIDX & 63, w = TIDX >> 6, wm = w >> 1, wn = w & 1, r = lane & 31, hh = lane >> 5;
#pragma unroll
  for (int mb = 0; mb < 2; ++mb)
#pragma unroll
    for (int nb2 = 0; nb2 < 2; ++nb2) {
      const int k2 = wn * 64 + nb2 * 32 + r;
#pragma unroll
      for (int g4 = 0; g4 < 4; ++g4) {
        const int j = jt * 128 + wm * 64 + mb * 32 + 8 * g4 + 4 * hh;
        const float sc = 1.f / 2048.f;
        uint2 pk = {pack2(acc[mb][nb2][4 * g4] * sc, acc[mb][nb2][4 * g4 + 1] * sc),
                    pack2(acc[mb][nb2][4 * g4 + 2] * sc, acc[mb][nb2][4 * g4 + 3] * sc)};
        *(uint2*)(f + ((size_t)b * PB + k1 + 128 * k2) * 256 + j) = pk;
      }
    }
}
DI void fnet_final_tile(const Params& P, int l, int mt, int nt, char* smem) {
  char* ws = P.ws;
  const int r0 = mt * 128;
  f32x16 acc[2][2];
  acc[0][0] = acc[0][1] = acc[1][0] = acc[1][1] = fzero();
  PlainRows ar{(const bf16_t*)(ws + oq(O_QPF)) + (size_t)3 * R * 256 + (size_t)r0 * 256, 256};
  gemm_main(ar, (const bf16_t*)(ws + smallw(l) + oq(O_WT_FN)) + (size_t)nt * 128 * 256, 256, 256, smem, acc);
  bf16_t* yf = (bf16_t*)(ws + oq(O_Y)) + (size_t)3 * R * 256;
  const int lane = TIDX & 63, w = TIDX >> 6, wm = w >> 1, wn = w & 1, r = lane & 31, hh = lane >> 5;
#pragma unroll
  for (int mb = 0; mb < 2; ++mb)
#pragma unroll
    for (int nb2 = 0; nb2 < 2; ++nb2)
#pragma unroll
      for (int i = 0; i < 16; ++i) {
        const int m = wm * 64 + mb * 32 + crow(i, hh), n = nt * 128 + wn * 64 + nb2 * 32 + r;
        yf[(size_t)(r0 + m) * 256 + n] = f2bf(acc[mb][nb2][i]);
      }
}

DI void merge_tile(const Params& P, int l, int mt, int nt, char* smem) {
  char* ws = P.ws;
  const int r0 = mt * 128;
  const int tid = TIDX, lane = tid & 63, w = tid >> 6, wm = w >> 1, wn = w & 1, r = lane & 31, hh = lane >> 5;
  const bf16_t* gates = (const bf16_t*)(ws + oq(O_GATES));
  f32x16 tot[2][2], acc[2][2];
  tot[0][0] = tot[0][1] = tot[1][0] = tot[1][1] = fzero();
  acc[0][0] = acc[0][1] = acc[1][0] = acc[1][1] = fzero();
  const int lrow = tid >> 3, lcc = (tid & 7) * 8;
  const bf16_t* pa0 = (const bf16_t*)(ws + oq(O_Y)) + (size_t)(r0 + lrow) * 256 + lcc;
  const bf16_t* pb0 = (const bf16_t*)(ws + smallw(l) + oq(O_WT_BR)) + (size_t)(nt * 128 + lrow) * 256 + lcc;
  constexpr long SA = (long)R * 256, SB = (long)D * 256;
  u32x4 ra0[4], rb0[4];
  u32x4 gq[2][2][2];
#define M_OFFA(kt) (((kt) >> 2) * SA + ((kt) & 3) * 64)
#define M_OFFB(kt) (((kt) >> 2) * SB + ((kt) & 3) * 64)
#define M_LOAD1(RA, RB, kt, i) RA[i] = *(const u32x4*)(pa0 + M_OFFA(kt) + i * 32 * 256); RB[i] = *(const u32x4*)(pb0 + M_OFFB(kt) + i * 32 * 256);
#define M_LOAD(RA, RB, kt) { M_LOAD1(RA, RB, kt, 0) M_LOAD1(RA, RB, kt, 1) M_LOAD1(RA, RB, kt, 2) M_LOAD1(RA, RB, kt, 3) }
#define M_STORE1(RA, RB, i) *(u32x4*)(base_ + ((lrow + 32 * i) * LROW + lcc) * 2) = RA[i]; *(u32x4*)(base_ + TILEB + ((lrow + 32 * i) * LROW + lcc) * 2) = RB[i];
#define M_STORE(RA, RB, buf) { char* base_ = smem + (buf) * 2 * TILEB; M_STORE1(RA, RB, 0) M_STORE1(RA, RB, 1) M_STORE1(RA, RB, 2) M_STORE1(RA, RB, 3) }
#define M_STEP(ks) { \
      bf16x8 a0 = *(const bf16x8*)(bA_ + ks * 32); \
      bf16x8 a1 = *(const bf16x8*)(bA_ + 32 * LROW * 2 + ks * 32); \
      bf16x8 b0 = *(const bf16x8*)(bB_ + ks * 32); \
      bf16x8 b1 = *(const bf16x8*)(bB_ + 32 * LROW * 2 + ks * 32); \
      acc[0][0] = MFMA32(a0, b0, acc[0][0]); \
      acc[0][1] = MFMA32(a0, b1, acc[0][1]); \
      acc[1][0] = MFMA32(a1, b0, acc[1][0]); \
      acc[1][1] = MFMA32(a1, b1, acc[1][1]); }
#define M_COMPUTE(buf) { \
    const char* bA_ = smem + (buf) * 2 * TILEB + ((wm * 64 + r) * LROW + hh * 8) * 2; \
    const char* bB_ = smem + (buf) * 2 * TILEB + TILEB + ((wn * 64 + r) * LROW + hh * 8) * 2; \
    M_STEP(0) M_STEP(1) M_STEP(2) M_STEP(3) }
#define M_GLOAD(i) { \
    _Pragma("unroll") for (int mb = 0; mb < 2; ++mb) \
      _Pragma("unroll") for (int nb2 = 0; nb2 < 2; ++nb2) { \
        const int mt32 = mt * 4 + wm * 2 + mb, nt32 = (i) * 32 + nt * 4 + wn * 2 + nb2; \
        const u32x4* gp = (const u32x4*)(gates + (((size_t)mt32 * 128 + nt32) * 64 + lane) * 16); \
        gq[mb][nb2][0] = gp[0]; gq[mb][nb2][1] = gp[1]; } }
#define M_APPLY() { \
    _Pragma("unroll") for (int mb = 0; mb < 2; ++mb) \
      _Pragma("unroll") for (int nb2 = 0; nb2 < 2; ++nb2) { \
        _Pragma("unroll") for (int q = 0; q < 16; ++q) { \
          const unsigned wv = gq[mb][nb2][q >> 3][(q >> 1) & 3]; \
          const float gv = __uint_as_float((q & 1) ? (wv & 0xffff0000u) : (wv << 16)); \
          tot[mb][nb2][q] += gv * acc[mb][nb2][q]; } \
        acc[mb][nb2] = fzero(); } }
  M_GLOAD(0);
  M_LOAD(ra0, rb0, 0);
  M_STORE(ra0, rb0, 0);
  M_LOAD(ra0, rb0, 1);
#pragma unroll 1
  for (int kt = 0; kt < 16; kt += 2) {
    __syncthreads();
    M_STORE(ra0, rb0, 1);
    if (kt + 2 < 16) M_LOAD(ra0, rb0, kt + 2);
    M_COMPUTE(0);
    __syncthreads();
    if (kt + 2 < 16) {
      M_STORE(ra0, rb0, 0);
      if (kt + 3 < 16) M_LOAD(ra0, rb0, kt + 3);
    }
    M_COMPUTE(1);
    if ((kt & 3) == 2) {
      M_APPLY();
      if (kt + 2 < 16) M_GLOAD((kt + 2) >> 2);
    }
  }
  __syncthreads();
#undef M_OFFA
#undef M_OFFB
#undef M_LOAD1
#undef M_LOAD
#undef M_STORE1
#undef M_STORE
#undef M_STEP
#undef M_COMPUTE
#undef M_GLOAD
#undef M_APPLY
  bf16_t* am = (bf16_t*)(ws + oq(O_ACCM));
#pragma unroll
  for (int mb = 0; mb < 2; ++mb)
#pragma unroll
    for (int nb2 = 0; nb2 < 2; ++nb2)
#pragma unroll
      for (int q = 0; q < 16; ++q) {
        const int m = wm * 64 + mb * 32 + crow(q, hh), n = nt * 128 + wn * 64 + nb2 * 32 + r;
        am[(size_t)(r0 + m) * D + n] = f2bf(tot[mb][nb2][q]);
      }
}
DI void outproj_tile(const Params& P, int l, int mt, int nt, char* smem) {
  char* ws = P.ws;
  const int r0 = mt * 128;
  f32x16 acc[2][4];
  zero_acc8(acc);
  PlainRows ar{(const bf16_t*)(ws + oq(O_ACCM)) + (size_t)r0 * D, D};
  gemm_main2(ar, (const bf16_t*)(ws + smallw(l) + oq(O_WT_OUT)) + (size_t)nt * 256 * D, D, D, smem, acc);
  const int lane = TIDX & 63, w = TIDX >> 6, wm = w >> 1, wn = w & 1, r = lane & 31, hh = lane >> 5;
  const int s = row_modsel(r0);
  const float* gt1 = (const float*)(ws + oq(O_MOD)) + ((size_t)l * 3 + s) * INC + 2 * D;
#pragma unroll
  for (int mb = 0; mb < 2; ++mb)
#pragma unroll
    for (int q = 0; q < 16; ++q) {
      const int m = wm * 64 + mb * 32 + crow(q, hh);
      const float* xi = (l == 0) ? x_in_row(P, r0 + m) : x_buf_row(P, r0 + m);
      float* xo = x_buf_row(P, r0 + m);
#pragma unroll
      for (int nb2 = 0; nb2 < 4; ++nb2) {
        const int n = nt * 256 + wn * 128 + nb2 * 32 + r;
        xo[n] = xi[n] + gt1[n] * acc[mb][nb2][q];
      }
    }
}

template <int NPT>
DI void topk_task(const Params& P, int smp, int e, char* smem) {
  char* ws = P.ws;
  constexpr int N = NPT * 256;
  constexpr int cap = N / 8;
  const int tid = TIDX, lane = tid & 63, w = tid >> 6;
  float* sv = (float*)smem;
  int* red = (int*)(smem + 65536);
  int* cg_ = (int*)(smem + 65536 + 64);
  int* ce_ = cg_ + 256;
  const float* aff = (const float*)(ws + oq(O_AFF)) + ((size_t)smp * NE + e) * T;
  for (int i = tid; i < N; i += 256) sv[i] = aff[i];
  __syncthreads();
  unsigned u[NPT];
#pragma unroll
  for (int j = 0; j < NPT; ++j) u[j] = __float_as_uint(sv[tid * NPT + j]);
  unsigned thr = 0;
  for (int bit = 30; bit >= 0; --bit) {
    const unsigned cand = thr | (1u << bit);
    int cnt = 0;
#pragma unroll
    for (int j = 0; j < NPT; ++j) cnt += (u[j] >= cand) ? 1 : 0;
#pragma unroll
    for (int o = 32; o >= 1; o >>= 1) cnt += __shfl_xor(cnt, o, 64);
    if (lane == 0) red[w] = cnt;
    __syncthreads();
    const int total = red[0] + red[1] + red[2] + red[3];
    __syncthreads();
    if (total >= cap) thr = cand;
  }
  int ng = 0, neq = 0;
#pragma unroll
  for (int j = 0; j < NPT; ++j) { ng += (u[j] > thr) ? 1 : 0; neq += (u[j] == thr) ? 1 : 0; }
  cg_[tid] = ng; ce_[tid] = neq;
  __syncthreads();
  int pg = 0, pe = 0, totg = 0;
  for (int i = 0; i < 256; ++i) {
    const int a = cg_[i], bq = ce_[i];
    if (i < tid) { pg += a; pe += bq; }
    totg += a;
  }
  const int need_eq = cap - totg;
  int* rows = (int*)(ws + oq(O_ROWS)) + (size_t)e * SLOTS;
  float* gl = (float*)(ws + oq(O_GL)) + (size_t)e * SLOTS;
  const int slot_base = smp < 2 ? smp * 2048 : 4096 + (smp - 2) * 32;
  const int row_base = smp < 2 ? smp * PB : (smp - 2) * PB + T;
#pragma unroll
  for (int j = 0; j < NPT; ++j) {
    const int idx = tid * NPT + j;
    int slot = -1;
    if (u[j] > thr) { slot = pg; ++pg; }
    else if (u[j] == thr) { if (pe < need_eq) slot = totg + pe; ++pe; }
    if (slot >= 0) { rows[slot_base + slot] = row_base + idx; gl[slot_base + slot] = __uint_as_float(u[j]); }
  }
  if (smp == 0 && tid < 64) rows[4160 + tid] = -1;
  __syncthreads();
}

struct GatherRows {
  const bf16_t* base; const int* rows;
  DI const bf16_t* operator()(int m) const { int rr = rows[m]; return base + (size_t)(rr < 0 ? 0 : rr) * D; }
};
DI void expert1_tile(const Params& P, int e, int mt, int nt, char* smem) {
  char* ws = P.ws;
  f32x16 acc[2][4];
  zero_acc8(acc);
  GatherRows ar{(const bf16_t*)(ws + oq(O_H)), (const int*)(ws + oq(O_ROWS)) + (size_t)e * SLOTS + mt * 128};
  gemm_main2(ar, (const bf16_t*)(ws + oq(O_WT_13)) + ((size_t)e * 2 * FF + nt * 256) * D, D, D, smem, acc);
  bf16_t* hid = (bf16_t*)(ws + oq(O_HID)) + ((size_t)e * SLOTS + mt * 128) * FF;
  const int lane = TIDX & 63, w = TIDX >> 6, wm = w >> 1, wn = w & 1, r = lane & 31, hh = lane >> 5;
#pragma unroll
  for (int pr = 0; pr < 2; ++pr) {
    const int f = nt * 128 + wn * 64 + pr * 32 + r;
#pragma unroll
    for (int mb = 0; mb < 2; ++mb)
#pragma unroll
      for (int q = 0; q < 16; ++q) {
        const int m = wm * 64 + mb * 32 + crow(q, hh);
        const float gv = acc[mb][2 * pr][q], uv = acc[mb][2 * pr + 1][q];
        hid[(size_t)m * FF + f] = f2bf(gv / (1.f + __expf(-gv)) * uv);
      }
  }
}
DI void expert2_tile(const Params& P, int l, int e, int mt, int nt, char* smem) {
  char* ws = P.ws;
  f32x16 acc[2][4];
  zero_acc8(acc);
  PlainRows ar{(const bf16_t*)(ws + oq(O_HID)) + ((size_t)e * SLOTS + mt * 128) * FF, FF};
  gemm_main2(ar, (const bf16_t*)(ws + oq(O_WT_2)) + ((size_t)e * D + nt * 256) * FF, FF, FF, smem, acc);
  const int* rows = (const int*)(ws + oq(O_ROWS)) + (size_t)e * SLOTS + mt * 128;
  const float* gl = (const float*)(ws + oq(O_GL)) + (size_t)e * SLOTS + mt * 128;
  const int lane = TIDX & 63, w = TIDX >> 6, wm = w >> 1, wn = w & 1, r = lane & 31, hh = lane >> 5;
#pragma unroll
  for (int mb = 0; mb < 2; ++mb)
#pragma unroll
    for (int q = 0; q < 16; ++q) {
      const int m = wm * 64 + mb * 32 + crow(q, hh);
      const int row = rows[m];
      if (row < 0) continue;
      const float gv = gl[m];
      const float* gt2 = (const float*)(ws + oq(O_MOD)) + ((size_t)l * 3 + row_modsel(row)) * INC + 5 * D;
      float* xo = x_buf_row(P, row);
#pragma unroll
      for (int nb2 = 0; nb2 < 4; ++nb2) {
        const int n = nt * 256 + wn * 128 + nb2 * 32 + r;
        unsafeAtomicAdd(xo + n, gt2[n] * gv * acc[mb][nb2][q]);
      }
    }
}

#define XB_TMO      128
#define XB_XCNT(j)  (256  + 64 * (j))
#define XB_XSUB(j)  (1280 + 64 * (j))
#define XB_XGEN(j)  (2304 + 64 * (j))
#define XB_TOP      3328
#define XB_TOPGEN   3392
#define XCD_BAR_WORDS 3456
#define XB_SPIN_CAP (1u << 18)
#define LAS __attribute__((address_space(3)))

__device__ __forceinline__ unsigned xb_ld(unsigned* p)              { return __hip_atomic_load(p, __ATOMIC_RELAXED, __HIP_MEMORY_SCOPE_AGENT); }
__device__ __forceinline__ unsigned xb_add(unsigned* p, unsigned v) { return __hip_atomic_fetch_add(p, v, __ATOMIC_RELAXED, __HIP_MEMORY_SCOPE_AGENT); }
__device__ __forceinline__ unsigned xb_xcc_id() { return (unsigned)__builtin_amdgcn_s_getreg((3 << 11) | 20) & 0xFu; }
#define XB_SPIN(cond, bar) do { unsigned _sp = 0; while (cond) { __builtin_amdgcn_s_sleep(1); \
    if ((++_sp & 255u) == 0u) { if (xb_ld(&(bar)[XB_TMO])) break; if (_sp > XB_SPIN_CAP) { atomicAdd(&(bar)[XB_TMO], 1u); break; } } } } while (0)

struct XcdBarrier {
    unsigned* bar; unsigned x;
    volatile LAS unsigned* st;
};

__device__ __forceinline__ XcdBarrier xcd_barrier_post(unsigned* bar, volatile LAS unsigned* st) {
    XcdBarrier b; b.bar = bar; b.x = xb_xcc_id(); b.st = st;
    if (threadIdx.x == 0) (void)xb_add(&bar[XB_XCNT(b.x)], 1u);
    return b;
}
__device__ __forceinline__ void xcd_barrier_complete(unsigned* bar, unsigned x, unsigned& nloc, unsigned& nx) {
    const unsigned G = gridDim.x * gridDim.y * gridDim.z;
    unsigned sum, cnt, mine, sp = 0u;
    for (;;) {
        sum = 0u; cnt = 0u; mine = 0u;
#pragma unroll
        for (unsigned j = 0; j < 16; ++j) { const unsigned c = xb_ld(&bar[XB_XCNT(j)]); sum += c; cnt += (c > 0u) ? 1u : 0u; mine = (j == x) ? c : mine; }
        if (sum == G) break;
        __builtin_amdgcn_s_sleep(1);
        if ((++sp & 255u) == 0u) { if (xb_ld(&bar[XB_TMO])) break; if (sp > XB_SPIN_CAP) { atomicAdd(&bar[XB_TMO], 1u); break; } }
    }
    nloc = mine > 0u ? mine : 1u; nx = cnt > 0u ? cnt : 1u;
}

__device__ __forceinline__ void xcd_barrier(const XcdBarrier& b) {
    asm volatile("s_waitcnt vmcnt(0)" ::: "memory");
    __syncthreads();
    if (threadIdx.x == 0) {
        unsigned* bar = b.bar;
        __builtin_amdgcn_s_waitcnt(0);
        unsigned nloc = b.st[0], nx = b.st[1];
        if (nloc == 0u) { xcd_barrier_complete(bar, b.x, nloc, nx); b.st[0] = nloc; b.st[1] = nx; }
        const unsigned old = xb_add(&bar[XB_XSUB(b.x)], 1u);
        const unsigned gen = old / nloc;
        if (old + 1u == (gen + 1u) * nloc) {
            __builtin_amdgcn_fence(__ATOMIC_RELEASE, "agent");
            asm volatile("s_waitcnt vmcnt(0)" ::: "memory");
            const unsigned og = xb_add(&bar[XB_TOP], 1u);
            const unsigned tg = og / nx;
            if (og + 1u == (tg + 1u) * nx) xb_add(&bar[XB_TOPGEN], 1u);
            else XB_SPIN(xb_ld(&bar[XB_TOPGEN]) == tg, bar);
            __builtin_amdgcn_fence(__ATOMIC_ACQUIRE, "agent");
            xb_add(&bar[XB_XGEN(b.x)], 1u);
            asm volatile("s_waitcnt vmcnt(0)" ::: "memory");
        } else {
            XB_SPIN(xb_ld(&bar[XB_XGEN(b.x)]) == gen, bar);
            __builtin_amdgcn_fence(__ATOMIC_ACQUIRE, "agent");
            asm volatile("s_waitcnt vmcnt(0)" ::: "memory");
        }
    }
    __syncthreads();
}


constexpr int NPL = 12;
constexpr int NPHASE = 1 + 2 * NPL;

DI void run_phase0(const Params& P, char* smem) {
  const int bid = opaque_bid(), nb = gridDim.x;
  {
    for (int t = bid; t < 192 + 64 + 2 * WT_SMALL; t += nb) {
      if (t < 192) ada_task(P, t, smem);
      else if (t < 256) tables_task(P, t - 192);
      else if (t < 256 + WT_SMALL) convert_weight_tile(P, 0, t - 256, smem);
      else convert_weight_tile(P, 1, t - 256 - WT_SMALL, smem);
    }
  }
}
template <int SP>
DI void run_sub(const Params& P, int l, char* smem) {
  const int bid = opaque_bid(), nb = gridDim.x;
  const bool last = l == 1;
  if constexpr (SP == 0) {
      modnorm_phase(P, l, false, bid, nb, smem);
  }
  if constexpr (SP == 1) {
      const int x = bid & 7, j = bid >> 3, nbx = nb >> 3;
      if (bid < nbx * 8)
        for (int lt = j; lt < 130 * 6; lt += nbx) {
          const int mt = (x >> 2) * 130 + lt / 6, nt = (x & 3) * 6 + lt % 6;
          if (last && (mt % 130) >= 128 && nt < 20) continue;
          inproj_tile(P, l, mt, nt, smem);
        }
  }
  if constexpr (SP == 2) {
      const bool conv_first = (bid >= (nb >> 1));
      if (conv_first)
        for (int t = bid - (nb >> 1); t < WT_TILES - WT_SMALL; t += nb) convert_weight_tile(P, l, WT_SMALL + t, smem);
      {
        const int x = bid & 7, j = bid >> 3, nbx = nb >> 3;
        if (bid < nbx * 8) {
          for (int q = j; q < 128; q += nbx) diffattn_task(P, l, x >> 2, x & 3, q * 128, 0, PB, smem);
          if (!last && j < 2) diffattn_task(P, l, x >> 2, x & 3, T + j * 128, T, CTXL, smem);
        }
      }
#ifndef PROBE_PART
#define PROBE_PART 0
#endif
#pragma unroll 1
      for (int rep = 0; rep < 1 + PROBE_PART; ++rep) {
      {
        const int x = bid & 7, j = bid >> 3, nbx = nb >> 3;
        if (bid < nbx * 8) {
          for (int q = j; q < 128; q += nbx) na_task(P, l, x >> 2, false, (x & 3) * 64 + (q >> 1), q & 1, smem);
          if (!last && j < 2) na_task(P, l, x >> 2, true, 0, (x & 3) * 2 + j, smem);
        }
      }
      for (int tile = bid; tile < 1040; tile += nb) {
        const bool isctx = (tile % 520) >= 512;
        if (!(last && isctx)) pool_task(P, l, tile, smem);
      }
      for (int t = bid; t < 1024; t += nb) fft_stage0_lat(P, t, smem);
      if (!last) for (int t = bid; t < 16; t += nb) fft_stage0_ctx(P, t, smem);      }
      if (!conv_first)
        for (int t = bid + (nb >> 1); t < WT_TILES - WT_SMALL; t += nb) convert_weight_tile(P, l, WT_SMALL + t, smem);

  }
  if constexpr (SP == 3) {
      const int n = 1024 + (last ? 0 : 8);
      for (int t = bid; t < n; t += nb) { if (t < 1024) fft_stage1_lat(P, t, smem); else fft_stage1_ctx(P, t - 1024, smem); }
  }
  if constexpr (SP == 4) {
      for (int t = bid; t < 512; t += nb) fft_stage2_lat(P, t, smem);
  }
  if constexpr (SP == 5) {
      for (int t = bid; t < 520; t += nb) { const int mt = t >> 1; if (last && (mt % 130) >= 128) continue; fnet_final_tile(P, l, mt, t & 1, smem); }
  }
  if constexpr (SP == 6) {
      const int x = bid & 7, j = bid >> 3, nbx = nb >> 3;
      if (bid < nbx * 8)
        for (int lt = j; lt < 33 * 8; lt += nbx) {
          const int mt = x + 8 * (lt >> 3);
          if (mt >= 260 || (last && (mt % 130) >= 128)) continue;
          merge_tile(P, l, mt, lt & 7, smem);
        }
  }
  if constexpr (SP == 7) {
      const int x = bid & 7, j = bid >> 3, nbx = nb >> 3;
      if (bid < nbx * 8)
        for (int lt = j; lt < 33 * 4; lt += nbx) {
          const int mt = x + 8 * (lt >> 2);
          if (mt >= 260 || (last && (mt % 130) >= 128)) continue;
          outproj_tile(P, l, mt, lt & 3, smem);
        }
  }
  if constexpr (SP == 8) { modnorm_phase(P, l, true, bid, nb, smem); }
  if constexpr (SP == 9) {
      const int n = last ? 32 : 64;
      for (int t = bid; t < n; t += nb) {
        const int smp = t >> 4, e = t & 15;
        if (smp < 2) topk_task<64>(P, smp, e, smem); else topk_task<1>(P, smp, e, smem);
      }
  }
  if constexpr (SP == 10) {
      const int nmt = last ? 32 : 33;
      const int x = bid & 7, j = bid >> 3, nbx = nb >> 3, npairs = NE * nmt;
      if (bid < nbx * 8)
        for (int lt = j; lt < ((npairs + 7) >> 3) * 11; lt += nbx) {
          const int p = x + 8 * (lt / 11);
          if (p >= npairs) continue;
          expert1_tile(P, p / nmt, p % nmt, lt % 11, smem);
        }
  }
  if constexpr (SP == 11) {
      const int nmt = last ? 32 : 33;
      const int x = bid & 7, j = bid >> 3, nbx = nb >> 3, npairs = NE * nmt;
      if (bid < nbx * 8)
        for (int lt = j; lt < ((npairs + 7) >> 3) * 4; lt += nbx) {
          const int p = x + 8 * (lt >> 2);
          if (p >= npairs) continue;
          expert2_tile(P, l, p / nmt, p % nmt, lt & 3, smem);
        }
  }
}

__shared__ __attribute__((aligned(16))) char g_smem[SMEM_BYTES];

#if ONE_LAUNCH
#ifndef PROBE_DUP
#define PROBE_DUP -1
#endif
#ifndef PROBE_MASK
#define PROBE_MASK 0
#endif
#define PH_STEP(SPV, L)                                \
  xcd_barrier(xb);                                     \
  run_sub<SPV>(P, L, g_smem);                          \
  if (SPV == PROBE_DUP || ((PROBE_MASK >> SPV) & 1)) { xcd_barrier(xb); run_sub<SPV>(P, L, g_smem); }
#define PH_LAYER(L)                                                                      \
  PH_STEP(0, L) PH_STEP(1, L) PH_STEP(2, L) PH_STEP(3, L) PH_STEP(4, L) PH_STEP(5, L)    \
  PH_STEP(6, L) PH_STEP(7, L) PH_STEP(8, L) PH_STEP(9, L) PH_STEP(10, L) PH_STEP(11, L)
#define PH_LAYER0_NOSYNC                                                                 \
  run_sub<0>(P, 0, g_smem);                                                              \
  PH_STEP(1, 0) PH_STEP(2, 0) PH_STEP(3, 0) PH_STEP(4, 0) PH_STEP(5, 0)                  \
  PH_STEP(6, 0) PH_STEP(7, 0) PH_STEP(8, 0) PH_STEP(9, 0) PH_STEP(10, 0) PH_STEP(11, 0)
__shared__ uint4 xb_words;
__global__ void __launch_bounds__(256, 2) mega(Params P) {
  cg::grid_group grid = cg::this_grid();
  if (threadIdx.x == 0) xb_words = make_uint4(0u, 0u, 0u, 0u);
  __syncthreads();
  XcdBarrier xb = xcd_barrier_post((unsigned*)(P.ws + O_BAR), (volatile LAS unsigned*)&xb_words);
  run_phase0(P, g_smem);
  if (xb_ld((unsigned*)(P.ws + O_BAR) + XB_TMO) == 0xFFFFFFFFu) grid.sync();
  xcd_barrier(xb);
  PH_LAYER0_NOSYNC
  PH_LAYER(1)
}
#else
__global__ void __launch_bounds__(256, 2) kphase0(Params P) { run_phase0(P, g_smem); }
template <int SP>
__global__ void __launch_bounds__(256, 2) kphase(Params P, int l) { run_sub<SP>(P, l, g_smem); }
#endif

extern "C" void kernel_launch(void* const* d_in, const int* in_sizes, int n_in, void* d_out, int out_size, void* d_ws,
                              size_t ws_size, hipStream_t stream) {
  static int grid_blocks = 0;
  if (!grid_blocks) {
    int dev = 0, cus = 0, per_cu = 0;
    (void)hipGetDevice(&dev);
    (void)hipDeviceGetAttribute(&cus, hipDeviceAttributeMultiprocessorCount, dev);
#if ONE_LAUNCH
    (void)hipOccupancyMaxActiveBlocksPerMultiprocessor(&per_cu, mega, 256, 0);
#else
    per_cu = 2;
#endif
    if (per_cu < 1) per_cu = 1;
    if (per_cu > 2) per_cu = 2;
    grid_blocks = cus * per_cu;
  }
  if (ws_size < WS_TOTAL) { fprintf(stderr, "workspace too small: %zu < %zu\n", ws_size, (size_t)WS_TOTAL); }
  Params P{};
  const float** pp = (const float**)&P;
  for (int i = 0; i < 25; ++i) pp[i] = (const float*)d_in[i];
  P.out = (float*)d_out;
  P.ws = (char*)d_ws;
#if ONE_LAUNCH
  (void)hipMemsetAsync((char*)d_ws + O_BAR, 0, 16384, stream);
  void* args[] = {&P};
  hipError_t e = hipLaunchCooperativeKernel((void*)mega, dim3(grid_blocks), dim3(256), args, 0, stream);
  if (e != hipSuccess) fprintf(stderr, "cooperative launch failed: %s (grid %d)\n", hipGetErrorString(e), grid_blocks);
#else
  const dim3 g(grid_blocks), b(256);
  kphase0<<<g, b, 0, stream>>>(P);
  for (int l = 0; l < 2; ++l) {
    kphase<0><<<g, b, 0, stream>>>(P, l);
    kphase<1><<<g, b, 0, stream>>>(P, l);
    kphase<2><<<g, b, 0, stream>>>(P, l);
    kphase<3><<<g, b, 0, stream>>>(P, l);
    kphase<4><<<g, b, 0, stream>>>(P, l);
    kphase<5><<<g, b, 0, stream>>>(P, l);
    kphase<6><<<g, b, 0, stream>>>(P, l);
    kphase<7><<<g, b, 0, stream>>>(P, l);
    kphase<8><<<g, b, 0, stream>>>(P, l);
    kphase<9><<<g, b, 0, stream>>>(P, l);
    kphase<10><<<g, b, 0, stream>>>(P, l);
    kphase<11><<<g, b, 0, stream>>>(P, l);
  }
#endif
}
```

```cpp
#include <hip/hip_runtime.h>
#include <hip/hip_cooperative_groups.h>
#include <stdint.h>
#include <cstdio>
namespace cg = cooperative_groups;

#ifndef ONE_LAUNCH
#define ONE_LAUNCH 1
#endif

#define DI __device__ __forceinline__
typedef unsigned short bf16_t;
using bf16x8 = __attribute__((ext_vector_type(8))) short;
using s16x4 = __attribute__((ext_vector_type(4))) short;
using u32x4 = __attribute__((ext_vector_type(4))) unsigned;
using f32x16 = __attribute__((ext_vector_type(16))) float;
typedef __bf16 bf2_t __attribute__((ext_vector_type(2)));
typedef float f2_t __attribute__((ext_vector_type(2)));
#define MFMA32(a, b, c) __builtin_amdgcn_mfma_f32_32x32x16_bf16((a), (b), (c), 0, 0, 0)

constexpr int D = 1024;
constexpr int T = 16384;
constexpr int CTXL = 256;
constexpr int PB = T + CTXL;
constexpr int R = 2 * PB;
constexpr int INC = 6144;
constexpr int NE = 16;
constexpr int FF = 1408;
constexpr int SLOTS = 4224;
constexpr float EPS = 1e-6f;
constexpr float LOG2E = 1.4426950408889634f;
constexpr float TWO_PI_UNUSED = 6.283185307179586f;

constexpr size_t AL(size_t x) { return (x + 255) & ~(size_t)255; }
constexpr size_t O_WT_IN = 0;
constexpr size_t O_WT_BR = O_WT_IN + (size_t)INC * D * 2;
constexpr size_t O_WT_OUT = O_WT_BR + (size_t)4 * D * 256 * 2;
constexpr size_t O_WT_FN = O_WT_OUT + (size_t)D * D * 2;
constexpr size_t O_WT_13 = O_WT_FN + (size_t)256 * 256 * 2;
constexpr size_t O_WT_2 = O_WT_13 + (size_t)NE * 2 * FF * D * 2;
constexpr size_t O_WC = O_WT_2 + (size_t)NE * D * FF * 2;
constexpr size_t O_D1 = O_WC + (size_t)512 * 256 * 2;
constexpr size_t O_D2 = O_D1 + (size_t)256 * 256 * 2;
constexpr size_t O_DC = O_D2 + (size_t)128 * 256 * 2;
constexpr size_t O_ROPE = O_DC + (size_t)256 * 512 * 2;
constexpr size_t O_MOD = O_ROPE + (size_t)256 * 8 * 2 * 4;
constexpr size_t O_CONST = O_MOD + (size_t)2 * 3 * INC * 4;
constexpr size_t O_H = AL(O_CONST + 256);
constexpr size_t O_Z1 = O_H;
constexpr size_t O_Z2 = O_H + (size_t)2 * T * 512 * 2;
constexpr size_t O_Z1C = O_Z2 + (size_t)2 * T * 512 * 2;
constexpr size_t O_QPF = O_H + (size_t)R * D * 2;
constexpr size_t SZ256 = (size_t)R * 256 * 2;
constexpr size_t O_ACCM = O_QPF;
constexpr size_t O_GATES = O_QPF + 4 * SZ256;
constexpr size_t O_HID = O_GATES;
constexpr size_t O_KV = O_GATES + (size_t)R * 4096 * 2;
constexpr size_t O_Y = O_KV + 4 * SZ256;
constexpr size_t O_XCTX = O_Y + 4 * SZ256;
constexpr size_t O_AFF = O_XCTX + (size_t)512 * D * 4;
constexpr size_t O_ROWS = O_AFF + (size_t)4 * NE * T * 4;
constexpr size_t O_GL = O_ROWS + (size_t)NE * SLOTS * 4;
constexpr size_t O_BAR = AL(O_GL + (size_t)NE * SLOTS * 4);
constexpr size_t O_SMALLW1 = O_BAR + 16384;
constexpr size_t SMALLW = O_WT_13;
constexpr size_t WS_TOTAL = O_SMALLW1 + SMALLW;
static_assert(O_Z1C + (size_t)2 * 256 * 512 * 2 <= O_QPF, "fft scratch must fit in h");
static_assert((size_t)NE * SLOTS * FF * 2 <= (size_t)R * 4096 * 2, "hid must fit in gates");

struct Params {
  const float *x, *c, *ctx, *c_ctx, *w_ada, *b_ada, *g_mix, *g_ffn, *w_in, *na_q_g, *na_k_g, *na_rpb, *df_q_g,
      *df_k_g, *df_lambda, *df_subln_g, *pool_w, *pool_scale, *fnet_w, *w_branch, *w_out, *w_router, *w_gate_e,
      *w_up_e, *w_down_e;
  float* out;
  char* ws;
};

constexpr int SMEM_BYTES = 73728;
constexpr int LROW = 72;
constexpr int TILEB = 128 * LROW * 2;

DI int opaque_tid() { int t = threadIdx.x; asm volatile("" : "+v"(t)); return t; }
DI int opaque_bid() { int t = blockIdx.x; asm volatile("" : "+s"(t)); return t; }
DI size_t oq(size_t x) { asm volatile("" : "+s"(x)); return x; }
#define TIDX opaque_tid()
DI float bf2f(bf16_t b) { return __uint_as_float(((unsigned)b) << 16); }
DI unsigned pack2(float a, float b) {
  f2_t v = {a, b};
  bf2_t r = __builtin_convertvector(v, bf2_t);
  return __builtin_bit_cast(unsigned, r);
}
DI bf16_t f2bf(float a) { return (bf16_t)(pack2(a, 0.f) & 0xffffu); }
DI bf16x8 pack8(float a0, float a1, float a2, float a3, float a4, float a5, float a6, float a7) {
  uint4 u = {pack2(a0, a1), pack2(a2, a3), pack2(a4, a5), pack2(a6, a7)};
  return __builtin_bit_cast(bf16x8, u);
}
DI float wave_sum(float v) {
#pragma unroll
  for (int o = 32; o >= 1; o >>= 1) v += __shfl_xor(v, o, 64);
  return v;
}
DI int crow(int i, int hh) { return (i & 3) + 8 * (i >> 2) + 4 * hh; }
DI f32x16 fzero() {
  f32x16 z;
#pragma unroll
  for (int i = 0; i < 16; ++i) z[i] = 0.f;
  return z;
}
DI void row_info(int r, int& b, int& p) { b = r >= PB ? 1 : 0; p = r - b * PB; }
DI const float* x_in_row(const Params& P, int r) {
  int b, p; row_info(r, b, p);
  return p < T ? P.x + ((size_t)b * T + p) * D : P.ctx + ((size_t)b * CTXL + (p - T)) * D;
}
DI float* x_buf_row(const Params& P, int r) {
  int b, p; row_info(r, b, p);
  return p < T ? P.out + ((size_t)b * T + p) * D : (float*)(P.ws + oq(O_XCTX)) + ((size_t)b * CTXL + (p - T)) * D;
}
DI int row_modsel(int r) { int b, p; row_info(r, b, p); return p < T ? b : 2; }

template <class ARow>
DI void gemm_main(ARow arow, const bf16_t* __restrict__ Bt, long ldb, int K, char* smem, f32x16 (&acc)[2][2]) {
  const int tid = TIDX, lane = tid & 63, w = tid >> 6, wm = w >> 1, wn = w & 1;
  const int r = lane & 31, hh = lane >> 5;
  const int lrow = tid >> 3, lcc = (tid & 7) * 8;
  const bf16_t* pa[4];
#pragma unroll
  for (int i = 0; i < 4; ++i) pa[i] = arow(lrow + 32 * i) + lcc;
  const bf16_t* pb0 = Bt + (long)lrow * ldb + lcc;
  const long ldb32 = 32 * ldb;
  u32x4 ra0[4], rb0[4], ra1[4], rb1[4];
  const int nk = K >> 6;
#define G_LOAD1(RA, RB, kt, i) RA[i] = *(const u32x4*)(pa[i] + (kt) * 64); RB[i] = *(const u32x4*)(pb0 + i * ldb32 + (kt) * 64);
#define G_LOAD(RA, RB, kt) { G_LOAD1(RA, RB, kt, 0) G_LOAD1(RA, RB, kt, 1) G_LOAD1(RA, RB, kt, 2) G_LOAD1(RA, RB, kt, 3) }
#define G_STORE1(RA, RB, i) *(u32x4*)(base_ + ((lrow + 32 * i) * LROW + lcc) * 2) = RA[i]; *(u32x4*)(base_ + TILEB + ((lrow + 32 * i) * LROW + lcc) * 2) = RB[i];
#define G_STORE(RA, RB, buf) { char* base_ = smem + (buf) * 2 * TILEB; G_STORE1(RA, RB, 0) G_STORE1(RA, RB, 1) G_STORE1(RA, RB, 2) G_STORE1(RA, RB, 3) }
#define G_STEP(ks) { \
      bf16x8 a0 = *(const bf16x8*)(bA_ + ks * 32); \
      bf16x8 a1 = *(const bf16x8*)(bA_ + 32 * LROW * 2 + ks * 32); \
      bf16x8 b0 = *(const bf16x8*)(bB_ + ks * 32); \
      bf16x8 b1 = *(const bf16x8*)(bB_ + 32 * LROW * 2 + ks * 32); \
      acc[0][0] = MFMA32(a0, b0, acc[0][0]); \
      acc[0][1] = MFMA32(a0, b1, acc[0][1]); \
      acc[1][0] = MFMA32(a1, b0, acc[1][0]); \
      acc[1][1] = MFMA32(a1, b1, acc[1][1]); }
#define G_COMPUTE(buf) { \
    const char* bA_ = smem + (buf) * 2 * TILEB + ((wm * 64 + r) * LROW + hh * 8) * 2; \
    const char* bB_ = smem + (buf) * 2 * TILEB + TILEB + ((wn * 64 + r) * LROW + hh * 8) * 2; \
    G_STEP(0) G_STEP(1) G_STEP(2) G_STEP(3) }
  G_LOAD(ra0, rb0, 0);
  if (nk > 1) G_LOAD(ra1, rb1, 1);
  G_STORE(ra0, rb0, 0);
  if (nk > 2) G_LOAD(ra0, rb0, 2);
  for (int kt = 0; kt < nk; kt += 2) {
    __syncthreads();
    if (kt + 1 < nk) {
      G_STORE(ra1, rb1, 1);
      if (kt + 3 < nk) G_LOAD(ra1, rb1, kt + 3);
    }
    G_COMPUTE(0);
    if (kt + 1 < nk) {
      __syncthreads();
      if (kt + 2 < nk) {
        G_STORE(ra0, rb0, 0);
        if (kt + 4 < nk) G_LOAD(ra0, rb0, kt + 4);
      }
      G_COMPUTE(1);
    }
  }
  __syncthreads();
#undef G_LOAD
#undef G_STORE
#undef G_COMPUTE
#undef G_LOAD1
#undef G_STORE1
#undef G_STEP
}
struct PlainRows {
  const bf16_t* base; long ld;
  DI const bf16_t* operator()(int m) const { return base + (long)m * ld; }
};

constexpr int T2_B_OFF = 128 * LROW * 2;
template <class ARow>
DI void gemm_main2(ARow arow, const bf16_t* __restrict__ Bt, long ldb, int K, char* smem, f32x16 (&acc)[2][4]) {
  const int tid = TIDX, lane = tid & 63, w = tid >> 6, wm = w >> 1, wn = w & 1;
  const int r = lane & 31, hh = lane >> 5;
  const int lrow = tid >> 3, lcc = (tid & 7) * 8;
  const bf16_t* pa[4];
#pragma unroll
  for (int i = 0; i < 4; ++i) pa[i] = arow(lrow + 32 * i) + lcc;
  const bf16_t* pb0 = Bt + (long)lrow * ldb + lcc;
  const long ldb32 = 32 * ldb;
  u32x4 ra[4], rb[8];
  const int nk = K >> 6;
#define H_LA(i, kt) ra[i] = *(const u32x4*)(pa[i] + (kt) * 64);
#define H_LB(i, kt) rb[i] = *(const u32x4*)(pb0 + i * ldb32 + (kt) * 64);
#define H_LOAD(kt) { H_LA(0, kt) H_LA(1, kt) H_LA(2, kt) H_LA(3, kt) H_LB(0, kt) H_LB(1, kt) H_LB(2, kt) H_LB(3, kt) H_LB(4, kt) H_LB(5, kt) H_LB(6, kt) H_LB(7, kt) }
#define H_SA(i) *(u32x4*)(smem + ((lrow + 32 * i) * LROW + lcc) * 2) = ra[i];
#define H_SB(i) *(u32x4*)(smem + T2_B_OFF + ((lrow + 32 * i) * LROW + lcc) * 2) = rb[i];
#define H_STORE() { H_SA(0) H_SA(1) H_SA(2) H_SA(3) H_SB(0) H_SB(1) H_SB(2) H_SB(3) H_SB(4) H_SB(5) H_SB(6) H_SB(7) }
#define H_STEP(ks) { \
      bf16x8 a0 = *(const bf16x8*)(bA_ + ks * 32); \
      bf16x8 a1 = *(const bf16x8*)(bA_ + 32 * LROW * 2 + ks * 32); \
      bf16x8 b0 = *(const bf16x8*)(bB_ + ks * 32); \
      bf16x8 b1 = *(const bf16x8*)(bB_ + 32 * LROW * 2 + ks * 32); \
      bf16x8 b2 = *(const bf16x8*)(bB_ + 64 * LROW * 2 + ks * 32); \
      bf16x8 b3 = *(const bf16x8*)(bB_ + 96 * LROW * 2 + ks * 32); \
      acc[0][0] = MFMA32(a0, b0, acc[0][0]); \
      acc[1][0] = MFMA32(a1, b0, acc[1][0]); \
      acc[0][1] = MFMA32(a0, b1, acc[0][1]); \
      acc[1][1] = MFMA32(a1, b1, acc[1][1]); \
      acc[0][2] = MFMA32(a0, b2, acc[0][2]); \
      acc[1][2] = MFMA32(a1, b2, acc[1][2]); \
      acc[0][3] = MFMA32(a0, b3, acc[0][3]); \
      acc[1][3] = MFMA32(a1, b3, acc[1][3]); }
  const char* bA_ = smem + ((wm * 64 + r) * LROW + hh * 8) * 2;
  const char* bB_ = smem + T2_B_OFF + ((wn * 128 + r) * LROW + hh * 8) * 2;
  H_LOAD(0);
  for (int kt = 0; kt < nk; ++kt) {
    __syncthreads();
    H_STORE();
    __syncthreads();
    if (kt + 1 < nk) H_LOAD(kt + 1);
    H_STEP(0) H_STEP(1) H_STEP(2) H_STEP(3)
  }
  __syncthreads();
#undef H_LA
#undef H_LB
#undef H_LOAD
#undef H_SA
#undef H_SB
#undef H_STORE
#undef H_STEP
}
DI void zero_acc8(f32x16 (&acc)[2][4]) {
#pragma unroll
  for (int a = 0; a < 2; ++a)
#pragma unroll
    for (int b = 0; b < 4; ++b) acc[a][b] = fzero();
}

DI void transpose_tile(const float* __restrict__ src, long ld_src, bf16_t* __restrict__ dst, long ld_dst, int k0,
                       int n0, int rs, int off, char* smem) {
  float* Tt = (float*)smem;
  const int tid = TIDX;
#pragma unroll
  for (int i = 0; i < 4; ++i) {
    int k = (tid >> 4) + 16 * i, c4 = (tid & 15) * 4;
    float4 v = *(const float4*)(src + (long)(k0 + k) * ld_src + n0 + c4);
    Tt[k * 65 + c4 + 0] = v.x; Tt[k * 65 + c4 + 1] = v.y; Tt[k * 65 + c4 + 2] = v.z; Tt[k * 65 + c4 + 3] = v.w;
  }
  __syncthreads();
  const int n = tid >> 2, kq = (tid & 3) * 16;
  unsigned pk[8];
#pragma unroll
  for (int j = 0; j < 8; ++j) pk[j] = pack2(Tt[(kq + 2 * j) * 65 + n], Tt[(kq + 2 * j + 1) * 65 + n]);
  const int nn = n0 + n;
  const long drow = (long)(nn >> 5) * rs + off + (nn & 31);
  uint4* d = (uint4*)(dst + drow * ld_dst + k0 + kq);
  d[0] = make_uint4(pk[0], pk[1], pk[2], pk[3]);
  d[1] = make_uint4(pk[4], pk[5], pk[6], pk[7]);
  __syncthreads();
}

constexpr int WT_SMALL = 1536 + 256 + 256 + 16;
constexpr int WT_TILES = WT_SMALL + 5632 + 5632 + 5632;
DI size_t smallw(int l) { return l ? oq(O_SMALLW1) : (size_t)0; }
DI void convert_weight_tile(const Params& P, int l, int t, char* smem) {
  char* ws = P.ws;
  const size_t sw = smallw(l);
  if (t < 1536) {
    int kt = t / 96, nt = t % 96;
    transpose_tile(P.w_in + (size_t)l * D * INC, INC, (bf16_t*)(ws + sw + oq(O_WT_IN)), D, kt * 64, nt * 64, 32, 0, smem);
    return;
  }
  t -= 1536;
  if (t < 256) {
    int i = t >> 6, tt = t & 63, kt = tt >> 4, nt = tt & 15;
    transpose_tile(P.w_branch + ((size_t)l * 4 + i) * 256 * D, D, (bf16_t*)(ws + sw + oq(O_WT_BR)) + (size_t)i * D * 256, 256,
                   kt * 64, nt * 64, 32, 0, smem);
    return;
  }
  t -= 256;
  if (t < 256) {
    int kt = t >> 4, nt = t & 15;
    transpose_tile(P.w_out + (size_t)l * D * D, D, (bf16_t*)(ws + sw + oq(O_WT_OUT)), D, kt * 64, nt * 64, 32, 0, smem);
    return;
  }
  t -= 256;
  if (t < 16) {
    int kt = t >> 2, nt = t & 3;
    transpose_tile(P.fnet_w + (size_t)l * 256 * 256, 256, (bf16_t*)(ws + sw + oq(O_WT_FN)), 256, kt * 64, nt * 64, 32, 0, smem);
    return;
  }
  t -= 16;
  if (t < 11264) {
    int which = t >= 5632; if (which) t -= 5632;
    int e = t / 352, tt = t % 352, kt = tt / 22, nt = tt % 22;
    const float* src = (which ? P.w_up_e : P.w_gate_e) + ((size_t)l * NE + e) * D * FF;
    transpose_tile(src, FF, (bf16_t*)(ws + oq(O_WT_13)) + (size_t)e * 2 * FF * D, D, kt * 64, nt * 64, 64, which * 32, smem);
    return;
  }
  t -= 11264;
  {
    int e = t / 352, tt = t % 352, kt = tt / 16, nt = tt % 16;
    transpose_tile(P.w_down_e + ((size_t)l * NE + e) * FF * D, D, (bf16_t*)(ws + oq(O_WT_2)) + (size_t)e * D * FF, FF,
                   kt * 64, nt * 64, 32, 0, smem);
  }
}

DI void ada_task(const Params& P, int t, char* smem) {
  const int l = t / 96, n0 = (t % 96) * 64;
  float* sv = (float*)smem;
  float* red = sv + 3 * 1024;
  const int tid = TIDX;
  for (int i = tid; i < 3 * 1024; i += 256) {
    int s = i >> 10, k = i & 1023;
    float v = s < 2 ? P.c[s * D + k] : P.c_ctx[k];
    sv[i] = v / (1.f + __expf(-v));
  }
  __syncthreads();
  const int col = tid & 63, kg = tid >> 6;
  const float* wp = P.w_ada + (size_t)l * D * INC + n0 + col;
  float a0 = 0.f, a1 = 0.f, a2 = 0.f;
  for (int k = kg * 256; k < kg * 256 + 256; ++k) {
    float wv = wp[(size_t)k * INC];
    a0 += sv[k] * wv; a1 += sv[1024 + k] * wv; a2 += sv[2048 + k] * wv;
  }
  red[(kg * 3 + 0) * 64 + col] = a0; red[(kg * 3 + 1) * 64 + col] = a1; red[(kg * 3 + 2) * 64 + col] = a2;
  __syncthreads();
  if (tid < 192) {
    int s = tid >> 6, cc = tid & 63;
    float v = P.b_ada[(size_t)l * INC + n0 + cc];
    for (int g = 0; g < 4; ++g) v += red[(g * 3 + s) * 64 + cc];
    ((float*)(P.ws + oq(O_MOD)))[((size_t)l * 3 + s) * INC + n0 + cc] = v;
  }
  __syncthreads();
}

DI void tables_task(const Params& P, int t) {
  char* ws = P.ws;
  const int gtid = t * 256 + TIDX, gstride = 64 * 256;
  bf16_t* Wc = (bf16_t*)(ws + oq(O_WC));
  for (int i = gtid; i < 512 * 256; i += gstride) {
    int jj = i >> 8, c = i & 255, part = jj >> 8, j = jj & 255;
    float sn, cs; sincospif(2.f * (float)((j * c) & 255) / 256.f, &sn, &cs);
    Wc[i] = f2bf(part == 0 ? cs : -sn);
  }
  bf16_t* D1 = (bf16_t*)(ws + oq(O_D1));
  for (int i = gtid; i < 256 * 256; i += gstride) {
    int n = i >> 8, k = i & 255;
    int k1 = (n >> 6) * 32 + (n & 31), po = (n >> 5) & 1, pi = k >> 7, n1 = k & 127;
    float sn, cs; sincospif(2.f * (float)((k1 * n1) & 127) / 128.f, &sn, &cs);
    float v = po == 0 ? (pi == 0 ? cs : sn) : (pi == 0 ? -sn : cs);
    D1[i] = f2bf(v);
  }
  bf16_t* D2 = (bf16_t*)(ws + oq(O_D2));
  for (int i = gtid; i < 128 * 256; i += gstride) {
    int k2 = i >> 8, k = i & 255, pi = k >> 7, n2 = k & 127;
    float sn, cs; sincospif(2.f * (float)((k2 * n2) & 127) / 128.f, &sn, &cs);
    D2[i] = f2bf(pi == 0 ? cs : sn);
  }
  bf16_t* Dc = (bf16_t*)(ws + oq(O_DC));
  for (int i = gtid; i < 256 * 512; i += gstride) {
    int kk = i >> 9, k = i & 511, pi = k >> 8, n = k & 255;
    float sn, cs; sincospif(2.f * (float)((kk * n) & 255) / 256.f, &sn, &cs);
    Dc[i] = f2bf(pi == 0 ? cs : sn);
  }
  float* rope = (float*)(ws + oq(O_ROPE));
  for (int i = gtid; i < 256 * 8; i += gstride) {
    int pos = i >> 3, f = i & 7;
    float inv = powf(10000.f, -(float)f / 8.f);
    float ang = (float)pos * inv;
    rope[i * 2 + 0] = cosf(ang);
    rope[i * 2 + 1] = sinf(ang);
  }
  if (t == 0 && TIDX < 2) {
    const int l = TIDX;
    float* cst = (float*)(ws + oq(O_CONST)) + l * 8;
    const float* lv = P.df_lambda + l * 128;
    float d01 = 0.f, d23 = 0.f;
    for (int i = 0; i < 32; ++i) { d01 += lv[i] * lv[32 + i]; d23 += lv[64 + i] * lv[96 + i]; }
    float lam_init = 0.8f - 0.6f * expf(-0.3f * (float)l);
    cst[0] = expf(d01) - expf(d23) + lam_init;
    cst[1] = lam_init;
    float gq = 0.f, gk = 0.f;
    for (int i = 0; i < 32; ++i) { gq = fmaxf(gq, fabsf(P.df_q_g[l * 32 + i])); gk = fmaxf(gk, fabsf(P.df_k_g[l * 32 + i])); }
    cst[2] = sqrtf(32.f) * gq * gk * LOG2E;
    gq = 0.f; gk = 0.f;
    for (int i = 0; i < 64; ++i) { gq = fmaxf(gq, fabsf(P.na_q_g[l * 64 + i])); gk = fmaxf(gk, fabsf(P.na_k_g[l * 64 + i])); }
    float bm = 0.f;
    for (int i = 0; i < 4 * 15 * 31; ++i) bm = fmaxf(bm, fabsf(P.na_rpb[l * 4 * 15 * 31 + i]));
    cst[3] = (8.f * gq * gk + bm) * LOG2E;
  }
}

DI void modnorm_phase(const Params& P, int l, bool second, int bid, int nb, char* smem) {
  const int lane = TIDX & 63, w = TIDX >> 6;
  const int nw = nb * 4;
  bf16_t* h = (bf16_t*)(P.ws + oq(O_H));
  const float* g = (second ? P.g_ffn : P.g_mix) + (size_t)l * D;
  float* wt = (float*)smem;
  if (second) {
    const float* wr = P.w_router + (size_t)l * D * NE;
    for (int idx = TIDX; idx < D * NE; idx += 256) wt[(idx & 15) * D + (idx >> 4)] = wr[idx];
    __syncthreads();
  }
  for (int r = bid * 4 + w; r < R; r += nw) {
    int b, p; row_info(r, b, p);
    const bool isctx = p >= T;
    if (l == 1 && second && isctx) continue;
    const float* src = (l == 0 && !second) ? x_in_row(P, r) : x_buf_row(P, r);
    const int s = isctx ? 2 : b;
    const float* mb = (const float*)(P.ws + oq(O_MOD)) + ((size_t)l * 3 + s) * INC + (second ? 3 * D : 0);
    float4 v[4];
    float ss = 0.f;
#pragma unroll
    for (int i = 0; i < 4; ++i) {
      v[i] = *(const float4*)(src + lane * 4 + 256 * i);
      ss += v[i].x * v[i].x + v[i].y * v[i].y + v[i].z * v[i].z + v[i].w * v[i].w;
    }
    ss = wave_sum(ss);
    const float rstd = rsqrtf(ss * (1.f / D) + EPS);
    float hv[16];
#pragma unroll
    for (int i = 0; i < 4; ++i) {
      const int c = lane * 4 + 256 * i;
      float4 gg = *(const float4*)(g + c), sh = *(const float4*)(mb + c), sc = *(const float4*)(mb + D + c);
      hv[i * 4 + 0] = v[i].x * rstd * gg.x * (1.f + sc.x) + sh.x;
      hv[i * 4 + 1] = v[i].y * rstd * gg.y * (1.f + sc.y) + sh.y;
      hv[i * 4 + 2] = v[i].z * rstd * gg.z * (1.f + sc.z) + sh.z;
      hv[i * 4 + 3] = v[i].w * rstd * gg.w * (1.f + sc.w) + sh.w;
      uint2 o = {pack2(hv[i * 4 + 0], hv[i * 4 + 1]), pack2(hv[i * 4 + 2], hv[i * 4 + 3])};
      *(uint2*)(h + (size_t)r * D + c) = o;
    }
    if (second) {
      float lg[16];
#pragma unroll
      for (int e = 0; e < 16; ++e) lg[e] = 0.f;
#pragma unroll
      for (int i = 0; i < 4; ++i) {
#pragma unroll
        for (int e = 0; e < 16; ++e) {
          const float4 w4 = *(const float4*)(wt + e * D + 256 * i + lane * 4);
          lg[e] += hv[i * 4 + 0] * w4.x + hv[i * 4 + 1] * w4.y + hv[i * 4 + 2] * w4.z + hv[i * 4 + 3] * w4.w;
          if ((e & 3) == 3) __builtin_amdgcn_sched_barrier(0);
        }
      }
      float mx = -1e30f;
#pragma unroll
      for (int e = 0; e < 16; ++e) { lg[e] = wave_sum(lg[e]); mx = fmaxf(mx, lg[e]); }
      float sum = 0.f, mine = 0.f;
#pragma unroll
      for (int e = 0; e < 16; ++e) { float ex = __expf(lg[e] - mx); sum += ex; if (lane == e) mine = ex; }
      if (lane < 16) {
        const int smp = isctx ? 2 + b : b, n = isctx ? p - T : p;
        ((float*)(P.ws + oq(O_AFF)))[((size_t)smp * NE + lane) * T + n] = mine / sum;
      }
    }
  }
  __syncthreads();
}

template <int G>
DI void epi_rms(const float* Tt, const float* __restrict__ gain, bool rope, const float* __restrict__ ropetab,
                float scale, bf16_t* __restrict__ dst, int dcol0, int r0) {
  constexpr int NG = 128 / G;
  for (int it = TIDX; it < 128 * NG; it += 256) {
    const int row = it / NG, grp = it % NG;
    const float* tp = Tt + row * 132 + grp * G;
    float ss = 0.f;
#pragma unroll
    for (int d = 0; d < G; d += 4) {
      float4 q = *(const float4*)(tp + d);
      ss += q.x * q.x + q.y * q.y + q.z * q.z + q.w * q.w;
    }
    const float rstd = rsqrtf(ss * (1.f / G) + EPS);
    const float* gp = gain;
    asm volatile("" : "+s"(gp));
    int b, p; row_info(r0 + row, b, p);
    const bool dorope = (G == 32) && rope && (p < T);
    uint4* dp = (uint4*)(dst + (size_t)(r0 + row) * 256 + dcol0 + grp * G);
#pragma unroll 1
    for (int sub = 0; sub < G / 16; ++sub) {
      float v[16];
#pragma unroll
      for (int d = 0; d < 16; d += 4) {
        float4 q = *(const float4*)(tp + sub * 16 + d);
        float4 g4 = *(const float4*)(gp + sub * 16 + d);
        v[d] = q.x * rstd * g4.x; v[d + 1] = q.y * rstd * g4.y; v[d + 2] = q.z * rstd * g4.z; v[d + 3] = q.w * rstd * g4.w;
      }
      if (dorope) {
        const int pos = sub ? (p & 63) : (p >> 6);
#pragma unroll
        for (int i = 0; i < 8; ++i) {
          const float2 cssn = *(const float2*)(ropetab + (pos * 8 + i) * 2);
          const float x1 = v[i], x2 = v[8 + i];
          v[i] = x1 * cssn.x - x2 * cssn.y;
          v[8 + i] = x1 * cssn.y + x2 * cssn.x;
        }
      }
      dp[sub * 2] = make_uint4(pack2(v[0] * scale, v[1] * scale), pack2(v[2] * scale, v[3] * scale),
                               pack2(v[4] * scale, v[5] * scale), pack2(v[6] * scale, v[7] * scale));
      dp[sub * 2 + 1] = make_uint4(pack2(v[8] * scale, v[9] * scale), pack2(v[10] * scale, v[11] * scale),
                                   pack2(v[12] * scale, v[13] * scale), pack2(v[14] * scale, v[15] * scale));
    }
  }
}
DI void epi_plain(const float* Tt, bf16_t* __restrict__ dst, int dcol0, int r0) {
  const int row = TIDX >> 1, c0 = (TIDX & 1) * 64;
  uint4* dp = (uint4*)(dst + (size_t)(r0 + row) * 256 + dcol0 + c0);
#pragma unroll
  for (int d = 0; d < 64; d += 8) {
    float4 a = *(const float4*)(Tt + row * 132 + c0 + d), b = *(const float4*)(Tt + row * 132 + c0 + d + 4);
    dp[d >> 3] = make_uint4(pack2(a.x, a.y), pack2(a.z, a.w), pack2(b.x, b.y), pack2(b.z, b.w));
  }
}
DI void epi_transposed(const float* Tt, bf16_t* __restrict__ vt, int hd0, int bb, int p0) {
  const int c = TIDX >> 1, half = TIDX & 1;
  const int hd = hd0 + c;
  uint4* dp = (uint4*)(vt + ((size_t)bb * 256 + hd) * PB + p0 + half * 64);
#pragma unroll
  for (int q = 0; q < 8; ++q) {
    float f[8];
#pragma unroll
    for (int j = 0; j < 8; ++j) {
      const int tk = (q >> 1) * 16 + ((q & 1) ? (j < 4 ? j + 4 : j + 8) : (j < 4 ? j : j + 4));
      f[j] = Tt[(half * 64 + tk) * 132 + c];
    }
    dp[q] = make_uint4(pack2(f[0], f[1]), pack2(f[2], f[3]), pack2(f[4], f[5]), pack2(f[6], f[7]));
  }
}

DI void inproj_tile(const Params& P, int l, int mt, int nt, char* smem) {
  char* ws = P.ws;
  const int r0 = mt * 128;
  f32x16 acc[2][4];
  zero_acc8(acc);
  PlainRows ar{(const bf16_t*)(ws + oq(O_H)) + (size_t)r0 * D, D};
  gemm_main2(ar, (const bf16_t*)(ws + smallw(l) + oq(O_WT_IN)) + (size_t)nt * 256 * D, D, D, smem, acc);
  const int tid = TIDX, lane = tid & 63, w = tid >> 6, wm = w >> 1, wn = w & 1, r = lane & 31, hh = lane >> 5;
  if (nt >= 4 && nt < 20) {
    bf16_t* gates = (bf16_t*)(ws + oq(O_GATES));
#pragma unroll
    for (int mb = 0; mb < 2; ++mb)
#pragma unroll
      for (int nb2 = 0; nb2 < 4; ++nb2) {
        const int mt32 = mt * 4 + wm * 2 + mb, nt32 = (nt - 4) * 8 + wn * 4 + nb2;
        float sg[16];
#pragma unroll
        for (int i = 0; i < 16; ++i) sg[i] = 1.f / (1.f + __expf(-acc[mb][nb2][i]));
        uint4* gp = (uint4*)(gates + (((size_t)mt32 * 128 + nt32) * 64 + lane) * 16);
        gp[0] = make_uint4(pack2(sg[0], sg[1]), pack2(sg[2], sg[3]), pack2(sg[4], sg[5]), pack2(sg[6], sg[7]));
        gp[1] = make_uint4(pack2(sg[8], sg[9]), pack2(sg[10], sg[11]), pack2(sg[12], sg[13]), pack2(sg[14], sg[15]));
      }
    return;
  }
  float* Tt = (float*)smem;
  bf16_t* qpf = (bf16_t*)(ws + oq(O_QPF));
  bf16_t* kv = (bf16_t*)(ws + oq(O_KV));
  const float* ropetab = (const float*)(ws + oq(O_ROPE));
  const size_t S = (size_t)R * 256;
  int bb, p0; row_info(r0, bb, p0);
#pragma unroll 1
  for (int half = 0; half < 2; ++half) {
    if (wn == half) {
#pragma unroll
      for (int mb = 0; mb < 2; ++mb)
#pragma unroll
        for (int nb2 = 0; nb2 < 4; ++nb2)
#pragma unroll
          for (int i = 0; i < 16; ++i) {
            const int m = wm * 64 + mb * 32 + crow(i, hh), n = nb2 * 32 + r;
            Tt[m * 132 + n] = acc[mb][nb2][i];
          }
    }
    __syncthreads();
    const int dc = half * 128;
    if (nt == 0) epi_rms<64>(Tt, P.na_q_g + l * 64, false, ropetab, 0.125f * LOG2E, qpf, dc, r0);
    else if (nt == 1) epi_rms<32>(Tt, P.df_q_g + l * 32, true, ropetab, 0.17677669529663687f * LOG2E, qpf + S, dc, r0);
    else if (nt == 2) epi_plain(Tt, qpf + 2 * S, dc, r0);
    else if (nt == 3) epi_plain(Tt, qpf + 3 * S, dc, r0);
    else if (nt == 20) epi_rms<64>(Tt, P.na_k_g + l * 64, false, ropetab, 1.f, kv, dc, r0);
    else if (nt == 21) epi_transposed(Tt, kv + 2 * S, dc, bb, p0);
    else if (nt == 22) epi_rms<32>(Tt, P.df_k_g + l * 32, true, ropetab, 1.f, kv + S, dc, r0);
    else epi_transposed(Tt, kv + 3 * S, dc, bb, p0);
    __syncthreads();
  }
}

DI void diffattn_task(const Params& P, int l, int b, int hd, int q0, int key_lo, int nkeys, char* smem) {
  char* ws = P.ws;
  const int tid = TIDX, lane = tid & 63, w = tid >> 6, r = lane & 31, hh = lane >> 5;
  const bf16_t* qd = (const bf16_t*)(ws + oq(O_QPF)) + (size_t)R * 256;
  const bf16_t* kd = (const bf16_t*)(ws + oq(O_KV)) + (size_t)R * 256;
  const bf16_t* vt = (const bf16_t*)(ws + oq(O_KV)) + (size_t)3 * R * 256;
  bf16_t* yd = (bf16_t*)(ws + oq(O_Y)) + (size_t)R * 256;
  const float* cst = (const float*)(ws + oq(O_CONST)) + l * 8;
  const float lam = cst[0], lam_init = cst[1], negC = -cst[2];
  const int qrow = b * PB + q0 + w * 32 + r;
  bf16x8 qf[2][2];
#pragma unroll
  for (int m = 0; m < 2; ++m)
#pragma unroll
    for (int ks = 0; ks < 2; ++ks)
      qf[m][ks] = *(const bf16x8*)(qd + (size_t)qrow * 256 + hd * 64 + m * 32 + ks * 16 + hh * 8);
  f32x16 O[2][2];
  O[0][0] = O[0][1] = O[1][0] = O[1][1] = fzero();
  float ls0 = 0.f, ls1 = 0.f;
  constexpr int KT = 64 * LROW * 2;
  const bf16_t* kbase = kd + ((size_t)b * PB + key_lo) * 256 + hd * 64;
  const bf16_t* vbase = vt + ((size_t)(b * 4 + hd) * 64) * PB + key_lo;
  const int c0 = tid, c1 = tid + 256;
  u32x4 rk0, rk1, rv0, rv1;
#define DA_LOAD(t)                                                                       \
  {                                                                                      \
    rk0 = *(const u32x4*)(kbase + ((size_t)((t) * 64 + (c0 >> 3))) * 256 + (c0 & 7) * 8); \
    rk1 = *(const u32x4*)(kbase + ((size_t)((t) * 64 + (c1 >> 3))) * 256 + (c1 & 7) * 8); \
    rv0 = *(const u32x4*)(vbase + (size_t)(c0 >> 3) * PB + (t) * 64 + (c0 & 7) * 8);      \
    rv1 = *(const u32x4*)(vbase + (size_t)(c1 >> 3) * PB + (t) * 64 + (c1 & 7) * 8);      \
  }
#define DA_STORE(buf)                                                          \
  {                                                                            \
    char* kb_ = smem + (buf) * 2 * KT;                                         \
    *(u32x4*)(kb_ + ((c0 >> 3) * LROW + (c0 & 7) * 8) * 2) = rk0;              \
    *(u32x4*)(kb_ + ((c1 >> 3) * LROW + (c1 & 7) * 8) * 2) = rk1;              \
    *(u32x4*)(kb_ + KT + ((c0 >> 3) * LROW + (c0 & 7) * 8) * 2) = rv0;         \
    *(u32x4*)(kb_ + KT + ((c1 >> 3) * LROW + (c1 & 7) * 8) * 2) = rv1;         \
  }
  const int nt = nkeys >> 6;
  DA_LOAD(0);
  DA_STORE(0);
  if (nt > 1) DA_LOAD(1);
  for (int t = 0; t < nt; ++t) {
    __syncthreads();
    if (t + 1 < nt) {
      DA_STORE((t + 1) & 1);
      if (t + 2 < nt) DA_LOAD(t + 2);
    }
    const char* Ks = smem + (t & 1) * 2 * KT;
    const char* Vs = Ks + KT;
#pragma unroll 1
    for (int kb = 0; kb < 2; ++kb) {
      f32x16 S0, S1;
#pragma unroll
      for (int i = 0; i < 16; ++i) { S0[i] = negC; S1[i] = negC; }
#pragma unroll
      for (int ks = 0; ks < 2; ++ks) {
        bf16x8 k0 = *(const bf16x8*)(Ks + ((kb * 32 + r) * LROW + ks * 16 + hh * 8) * 2);
        bf16x8 k1 = *(const bf16x8*)(Ks + ((kb * 32 + r) * LROW + 32 + ks * 16 + hh * 8) * 2);
        S0 = MFMA32(k0, qf[0][ks], S0);
        S1 = MFMA32(k1, qf[1][ks], S1);
      }
#pragma unroll
      for (int i = 0; i < 16; ++i) {
        S0[i] = __builtin_amdgcn_exp2f(S0[i]); ls0 += S0[i];
        S1[i] = __builtin_amdgcn_exp2f(S1[i]); ls1 += S1[i];
      }
#pragma unroll
      for (int s = 0; s < 2; ++s) {
        bf16x8 p0 = pack8(S0[8 * s], S0[8 * s + 1], S0[8 * s + 2], S0[8 * s + 3], S0[8 * s + 4], S0[8 * s + 5], S0[8 * s + 6], S0[8 * s + 7]);
        bf16x8 p1 = pack8(S1[8 * s], S1[8 * s + 1], S1[8 * s + 2], S1[8 * s + 3], S1[8 * s + 4], S1[8 * s + 5], S1[8 * s + 6], S1[8 * s + 7]);
#pragma unroll
        for (int vb = 0; vb < 2; ++vb) {
          const bf16x8 vf = *(const bf16x8*)(Vs + ((vb * 32 + r) * LROW + kb * 32 + 16 * s + 8 * hh) * 2);
          O[0][vb] = MFMA32(vf, p0, O[0][vb]);
          O[1][vb] = MFMA32(vf, p1, O[1][vb]);
        }
      }
    }
  }
  __syncthreads();
#undef DA_LOAD
#undef DA_STORE
  ls0 += __shfl_xor(ls0, 32, 64);
  ls1 += __shfl_xor(ls1, 32, 64);
  const float i0 = 1.f / ls0, i1 = lam / ls1;
  float ssq = 0.f;
#pragma unroll
  for (int vb = 0; vb < 2; ++vb)
#pragma unroll
    for (int i = 0; i < 16; ++i) {
      float o = O[0][vb][i] * i0 - O[1][vb][i] * i1;
      O[0][vb][i] = o;
      ssq += o * o;
    }
  ssq += __shfl_xor(ssq, 32, 64);
  const float rstd = rsqrtf(ssq * (1.f / 64.f) + EPS) * (1.f - lam_init);
  const float* sg = P.df_subln_g + l * 64;
#pragma unroll
  for (int vb = 0; vb < 2; ++vb)
#pragma unroll
    for (int g4 = 0; g4 < 4; ++g4) {
      const int vd = vb * 32 + 8 * g4 + 4 * hh;
      float o0 = O[0][vb][4 * g4] * rstd * sg[vd], o1 = O[0][vb][4 * g4 + 1] * rstd * sg[vd + 1];
      float o2 = O[0][vb][4 * g4 + 2] * rstd * sg[vd + 2], o3 = O[0][vb][4 * g4 + 3] * rstd * sg[vd + 3];
      uint2 pk = {pack2(o0, o1), pack2(o2, o3)};
      *(uint2*)(yd + (size_t)qrow * 256 + hd * 64 + vd) = pk;
    }
}

DI void na_task(const Params& P, int l, int b, bool ctxq, int rr, int qsel, char* smem) {
  char* ws = P.ws;
  const int tid = TIDX, lane = tid & 63, hd = tid >> 6, r = lane & 31, hh = lane >> 5;
  float* rp = (float*)smem;
  if (!ctxq) {
    for (int i = tid; i < 4 * 15 * 31; i += 256) rp[i] = P.na_rpb[(size_t)l * 4 * 15 * 31 + i] * LOG2E;
  }
  __syncthreads();
  const bf16_t* qn = (const bf16_t*)(ws + oq(O_QPF));
  const bf16_t* kn = (const bf16_t*)(ws + oq(O_KV));
  const bf16_t* vt = (const bf16_t*)(ws + oq(O_KV)) + (size_t)2 * R * 256;
  bf16_t* yn = (bf16_t*)(ws + oq(O_Y));
  const float negC = -((const float*)(ws + oq(O_CONST)))[l * 8 + 3];
  const int c = qsel * 32 + r;
  const int qp = ctxq ? T + c : rr * 64 + c;
  const int qrow = b * PB + qp;
  bf16x8 qf[4];
#pragma unroll
  for (int ks = 0; ks < 4; ++ks) qf[ks] = *(const bf16x8*)(qn + (size_t)qrow * 256 + hd * 64 + ks * 16 + hh * 8);
  f32x16 O[2];
  O[0] = O[1] = fzero();
  float ls = 0.f;
  const int rs = min(max(rr - 4, 0), 248);
  const int cs = min(max(c - 8, 0), 48);
  const int nblk = ctxq ? 8 : 24;
  const bf16_t* vtb = vt + ((size_t)(b * 4 + hd) * 64) * PB;
  for (int kbi = 0; kbi < nblk; ++kbi) {
    const bool loc = !ctxq && kbi < 16;
    const int ir = kbi >> 1, kb = kbi & 1;
    const int pk0 = loc ? (rs + ir) * 64 + kb * 32 : T + (kbi - (ctxq ? 0 : 16)) * 32;
    f32x16 S;
#pragma unroll
    for (int i = 0; i < 16; ++i) S[i] = negC;
    const bf16_t* kp = kn + ((size_t)b * PB + pk0 + r) * 256 + hd * 64 + hh * 8;
#pragma unroll
    for (int ks = 0; ks < 4; ++ks) {
      bf16x8 kf = *(const bf16x8*)(kp + ks * 16);
      S = MFMA32(kf, qf[ks], S);
    }
    if (loc) {
      const float* rpr = rp + (hd * 15 + (rs + ir - rr + 7)) * 31;
#pragma unroll
      for (int i = 0; i < 16; ++i) {
        const int kc = kb * 32 + crow(i, hh);
        const bool valid = (kc >= cs) && (kc < cs + 16);
        const int ci = min(max(kc - c + 15, 0), 30);
        const float pv = __builtin_amdgcn_exp2f(S[i] + rpr[ci]);
        S[i] = valid ? pv : 0.f;
        ls += S[i];
      }
    } else {
#pragma unroll
      for (int i = 0; i < 16; ++i) { S[i] = __builtin_amdgcn_exp2f(S[i]); ls += S[i]; }
    }
#pragma unroll
    for (int s = 0; s < 2; ++s) {
      bf16x8 pf = pack8(S[8 * s], S[8 * s + 1], S[8 * s + 2], S[8 * s + 3], S[8 * s + 4], S[8 * s + 5], S[8 * s + 6], S[8 * s + 7]);
#pragma unroll
      for (int vb = 0; vb < 2; ++vb) {
        const bf16x8 vf = *(const bf16x8*)(vtb + (size_t)(vb * 32 + r) * PB + pk0 + 16 * s + 8 * hh);
        O[vb] = MFMA32(vf, pf, O[vb]);
      }
    }
  }
  ls += __shfl_xor(ls, 32, 64);
  const float inv = 1.f / ls;
#pragma unroll
  for (int vb = 0; vb < 2; ++vb)
#pragma unroll
    for (int g4 = 0; g4 < 4; ++g4) {
      const int vd = vb * 32 + 8 * g4 + 4 * hh;
      uint2 pk = {pack2(O[vb][4 * g4] * inv, O[vb][4 * g4 + 1] * inv), pack2(O[vb][4 * g4 + 2] * inv, O[vb][4 * g4 + 3] * inv)};
      *(uint2*)(yn + (size_t)qrow * 256 + hd * 64 + vd) = pk;
    }
  __syncthreads();
}

DI void pool_task(const Params& P, int l, int tile, char* smem) {
  char* ws = P.ws;
  const int tid = TIDX;
  const int r0 = tile * 32;
  int b, p0; row_info(r0, b, p0);
  const bool isctx = p0 >= T;
  const int seq0 = isctx ? T : 0, N = isctx ? CTXL : T;
  const int t0 = p0 - seq0;
  const bf16_t* pin = (const bf16_t*)(ws + oq(O_QPF)) + (size_t)2 * R * 256;
  bf16_t* yp = (bf16_t*)(ws + oq(O_Y)) + (size_t)2 * R * 256;
  bf16_t* us = (bf16_t*)smem;
  float* ds = (float*)(smem + 48 * 256 * 2);
  for (int i = tid; i < 48 * 32; i += 256) {
    const int rowi = i >> 5, ch = (i & 31) * 8;
    const int tk = t0 - 8 + rowi;
    uint4 v = make_uint4(0, 0, 0, 0);
    if (tk >= 0 && tk < N) v = *(const uint4*)(pin + ((size_t)b * PB + seq0 + tk) * 256 + ch);
    *(uint4*)(us + rowi * 256 + ch) = v;
  }
  __syncthreads();
  {
    const int ch = tid, gi = ch >> 6, wv = 2 << gi;
    for (int t = 0; t < 32; ++t) {
      const int tk = t0 + t;
      const int lo = max(tk - wv / 2, 0), hi = min(tk + wv / 2, N);
      float s = 0.f;
      for (int q = lo; q < hi; ++q) s += bf2f(us[(q - t0 + 8) * 256 + ch]);
      ds[t * 256 + ch] = s / (float)(hi - lo) - bf2f(us[(t + 8) * 256 + ch]);
    }
  }
  __syncthreads();
  {
    const int o = tid, gi = o >> 6;
    const float* wp = P.pool_w + ((size_t)l * 4 + gi) * 64 * 64 + (o & 63);
    float acc[32];
#pragma unroll
    for (int t = 0; t < 32; ++t) acc[t] = 0.f;
    for (int k = 0; k < 64; ++k) {
      const float wv = wp[k * 64];
#pragma unroll
      for (int t = 0; t < 32; ++t) acc[t] += ds[t * 256 + gi * 64 + k] * wv;
    }
    const float sc = P.pool_scale[l * 256 + o];
#pragma unroll
    for (int t = 0; t < 32; ++t) yp[(size_t)(r0 + t) * 256 + o] = f2bf(acc[t] * sc);
  }
  __syncthreads();
}

struct StridedRows {
  const bf16_t* base; long ld;
  DI const bf16_t* operator()(int m) const { return base + (long)m * ld; }
};
DI void fft_stage0_lat(const Params& P, int task, char* smem) {
  char* ws = P.ws;
  const int ntile = task & 3, n2 = (task >> 2) & 127, b = task >> 9;
  const bf16_t* fin = (const bf16_t*)(ws + oq(O_QPF)) + (size_t)3 * R * 256;
  f32x16 acc[2][2];
  acc[0][0] = acc[0][1] = acc[1][0] = acc[1][1] = fzero();
  StridedRows ar{fin + ((size_t)b * PB + n2) * 256, 128 * 256};
  gemm_main(ar, (const bf16_t*)(ws + oq(O_WC)) + (size_t)ntile * 128 * 256, 256, 256, smem, acc);
  bf16_t* Z1 = (bf16_t*)(ws + oq(O_Z1));
  const int lane = TIDX & 63, w = TIDX >> 6, wm = w >> 1, wn = w & 1, r = lane & 31, hh = lane >> 5;
#pragma unroll
  for (int mb = 0; mb < 2; ++mb)
#pragma unroll
    for (int nb2 = 0; nb2 < 2; ++nb2) {
      const int jj = ntile * 128 + wn * 64 + nb2 * 32 + r, part = jj >> 8, j = jj & 255;
#pragma unroll
      for (int g4 = 0; g4 < 4; ++g4) {
        const int n1 = wm * 64 + mb * 32 + 8 * g4 + 4 * hh;
        uint2 pk = {pack2(acc[mb][nb2][4 * g4], acc[mb][nb2][4 * g4 + 1]), pack2(acc[mb][nb2][4 * g4 + 2], acc[mb][nb2][4 * g4 + 3])};
        *(uint2*)(Z1 + (((size_t)(b * 128 + n2) * 256 + j) * 256 + part * 128 + n1)) = pk;
      }
    }
}
DI void fft_stage0_ctx(const Params& P, int task, char* smem) {
  char* ws = P.ws;
  const int ntile = task & 3, mtile = (task >> 2) & 1, b = task >> 3;
  const bf16_t* fin = (const bf16_t*)(ws + oq(O_QPF)) + (size_t)3 * R * 256;
  f32x16 acc[2][2];
  acc[0][0] = acc[0][1] = acc[1][0] = acc[1][1] = fzero();
  PlainRows ar{fin + ((size_t)b * PB + T + mtile * 128) * 256, 256};
  gemm_main(ar, (const bf16_t*)(ws + oq(O_WC)) + (size_t)ntile * 128 * 256, 256, 256, smem, acc);
  bf16_t* Z1c = (bf16_t*)(ws + oq(O_Z1C));
  const int lane = TIDX & 63, w = TIDX >> 6, wm = w >> 1, wn = w & 1, r = lane & 31, hh = lane >> 5;
#pragma unroll
  for (int mb = 0; mb < 2; ++mb)
#pragma unroll
    for (int nb2 = 0; nb2 < 2; ++nb2) {
      const int jj = ntile * 128 + wn * 64 + nb2 * 32 + r, part = jj >> 8, j = jj & 255;
#pragma unroll
      for (int g4 = 0; g4 < 4; ++g4) {
        const int n = mtile * 128 + wm * 64 + mb * 32 + 8 * g4 + 4 * hh;
        uint2 pk = {pack2(acc[mb][nb2][4 * g4], acc[mb][nb2][4 * g4 + 1]), pack2(acc[mb][nb2][4 * g4 + 2], acc[mb][nb2][4 * g4 + 3])};
        *(uint2*)(Z1c + (((size_t)(b * 256 + j)) * 512 + part * 256 + n)) = pk;
      }
    }
}
DI void fft_stage1_lat(const Params& P, int task, char* smem) {
  char* ws = P.ws;
  const int ntile = task & 1, j = (task >> 1) & 255, b = task >> 9;
  f32x16 acc[2][2];
  acc[0][0] = acc[0][1] = acc[1][0] = acc[1][1] = fzero();
  StridedRows ar{(const bf16_t*)(ws + oq(O_Z1)) + ((size_t)(b * 128) * 256 + j) * 256, 256 * 256};
  gemm_main(ar, (const bf16_t*)(ws + oq(O_D1)) + (size_t)ntile * 128 * 256, 256, 256, smem, acc);
  bf16_t* Z2 = (bf16_t*)(ws + oq(O_Z2));
  const int lane = TIDX & 63, w = TIDX >> 6, wm = w >> 1, wn = w & 1, r = lane & 31, hh = lane >> 5;
  const int k1 = (ntile * 2 + wn) * 32 + r;
#pragma unroll
  for (int mb = 0; mb < 2; ++mb)
#pragma unroll
    for (int g4 = 0; g4 < 4; ++g4) {
      const int n2 = wm * 64 + mb * 32 + 8 * g4 + 4 * hh;
      float yr[4], yi[4];
#pragma unroll
      for (int q = 0; q < 4; ++q) {
        const float re = acc[mb][0][4 * g4 + q], im = acc[mb][1][4 * g4 + q];
        float sn, cs; sincospif(2.f * (float)((k1 * (n2 + q)) & 16383) / 16384.f, &sn, &cs);
        yr[q] = re * cs + im * sn;
        yi[q] = im * cs - re * sn;
      }
      bf16_t* zp = Z2 + (((size_t)(b * 128 + k1) * 256 + j) * 256 + n2);
      uint2 pr = {pack2(yr[0], yr[1]), pack2(yr[2], yr[3])}, pi = {pack2(yi[0], yi[1]), pack2(yi[2], yi[3])};
      *(uint2*)zp = pr;
      *(uint2*)(zp + 128) = pi;
    }
}
DI void fft_stage1_ctx(const Params& P, int task, char* smem) {
  char* ws = P.ws;
  const int ntile = task & 1, mtile = (task >> 1) & 1, b = task >> 2;
  f32x16 acc[2][2];
  acc[0][0] = acc[0][1] = acc[1][0] = acc[1][1] = fzero();
  PlainRows ar{(const bf16_t*)(ws + oq(O_Z1C)) + ((size_t)(b * 256 + mtile * 128)) * 512, 512};
  gemm_main(ar, (const bf16_t*)(ws + oq(O_DC)) + (size_t)ntile * 128 * 512, 512, 512, smem, acc);
  bf16_t* f = (bf16_t*)(ws + oq(O_QPF)) + (size_t)3 * R * 256;
  const int lane = TIDX & 63, w = TIDX >> 6, wm = w >> 1, wn = w & 1, r = lane & 31, hh = lane >> 5;
#pragma unroll
  for (int mb = 0; mb < 2; ++mb)
#pragma unroll
    for (int nb2 = 0; nb2 < 2; ++nb2) {
      const int k = ntile * 128 + wn * 64 + nb2 * 32 + r;
#pragma unroll
      for (int g4 = 0; g4 < 4; ++g4) {
        const int j = mtile * 128 + wm * 64 + mb * 32 + 8 * g4 + 4 * hh;
        const float sc = 1.f / 256.f;
        uint2 pk = {pack2(acc[mb][nb2][4 * g4] * sc, acc[mb][nb2][4 * g4 + 1] * sc),
                    pack2(acc[mb][nb2][4 * g4 + 2] * sc, acc[mb][nb2][4 * g4 + 3] * sc)};
        *(uint2*)(f + ((size_t)b * PB + T + k) * 256 + j) = pk;
      }
    }
}
DI void fft_stage2_lat(const Params& P, int task, char* smem) {
  char* ws = P.ws;
  const int jt = task & 1, k1 = (task >> 1) & 127, b = task >> 8;
  f32x16 acc[2][2];
  acc[0][0] = acc[0][1] = acc[1][0] = acc[1][1] = fzero();
  PlainRows ar{(const bf16_t*)(ws + oq(O_Z2)) + ((size_t)(b * 128 + k1) * 256 + jt * 128) * 256, 256};
  gemm_main(ar, (const bf16_t*)(ws + oq(O_D2)), 256, 256, smem, acc);
  bf16_t* f = (bf16_t*)(ws + oq(O_QPF)) + (size_t)3 * R * 256;
  const int lane = TIDX & 63, w = TIDX >> 6, wm = w >> 1, wn = w & 1, r = lane & 31, hh = lane >> 5;
#pragma unroll
  for (int mb = 0; mb < 2; ++mb)
#pragma unroll
    for (int nb2 = 0; nb2 < 2; ++nb2) {
      const int k2 = wn * 64 + nb2 * 32 + r;
#pragma unroll
      for (int g4 = 0; g4 < 4; ++g4) {
        const int j = jt * 128 + wm * 64 + mb * 32 + 8 * g4 + 4 * hh;
        const float sc = 1.f / 2048.f;
        uint2 pk = {pack2(acc[mb][nb2][4 * g4] * sc, acc[mb][nb2][4 * g4 + 1] * sc),
                    pack2(acc[mb][nb2][4 * g4 + 2] * sc, acc[mb][nb2][4 * g4 + 3] * sc)};
        *(uint2*)(f + ((size_t)b * PB + k1 + 128 * k2) * 256 + j) = pk;
      }
    }
}
DI void fnet_final_tile(const Params& P, int l, int mt, int nt, char* smem) {
  char* ws = P.ws;
  const int r0 = mt * 128;
  f32x16 acc[2][2];
  acc[0][0] = acc[0][1] = acc[1][0] = acc[1][1] = fzero();
  PlainRows ar{(const bf16_t*)(ws + oq(O_QPF)) + (size_t)3 * R * 256 + (size_t)r0 * 256, 256};
  gemm_main(ar, (const bf16_t*)(ws + smallw(l) + oq(O_WT_FN)) + (size_t)nt * 128 * 256, 256, 256, smem, acc);
  bf16_t* yf = (bf16_t*)(ws + oq(O_Y)) + (size_t)3 * R * 256;
  const int lane = TIDX & 63, w = TIDX >> 6, wm = w >> 1, wn = w & 1, r = lane & 31, hh = lane >> 5;
#pragma unroll
  for (int mb = 0; mb < 2; ++mb)
#pragma unroll
    for (int nb2 = 0; nb2 < 2; ++nb2)
#pragma unroll
      for (int i = 0; i < 16; ++i) {
        const int m = wm * 64 + mb * 32 + crow(i, hh), n = nt * 128 + wn * 64 + nb2 * 32 + r;
        yf[(size_t)(r0 + m) * 256 + n] = f2bf(acc[mb][nb2][i]);
      }
}

DI void merge_tile(const Params& P, int l, int mt, int nt, char* smem) {
  char* ws = P.ws;
  const int r0 = mt * 128;
  const int tid = TIDX, lane = tid & 63, w = tid >> 6, wm = w >> 1, wn = w & 1, r = lane & 31, hh = lane >> 5;
  const bf16_t* gates = (const bf16_t*)(ws + oq(O_GATES));
  f32x16 tot[2][2], acc[2][2];
  tot[0][0] = tot[0][1] = tot[1][0] = tot[1][1] = fzero();
  acc[0][0] = acc[0][1] = acc[1][0] = acc[1][1] = fzero();
  const int lrow = tid >> 3, lcc = (tid & 7) * 8;
  const bf16_t* pa0 = (const bf16_t*)(ws + oq(O_Y)) + (size_t)(r0 + lrow) * 256 + lcc;
  const bf16_t* pb0 = (const bf16_t*)(ws + smallw(l) + oq(O_WT_BR)) + (size_t)(nt * 128 + lrow) * 256 + lcc;
  constexpr long SA = (long)R * 256, SB = (long)D * 256;
  u32x4 ra0[4], rb0[4];
  u32x4 gq[2][2][2];
#define M_OFFA(kt) (((kt) >> 2) * SA + ((kt) & 3) * 64)
#define M_OFFB(kt) (((kt) >> 2) * SB + ((kt) & 3) * 64)
#define M_LOAD1(RA, RB, kt, i) RA[i] = *(const u32x4*)(pa0 + M_OFFA(kt) + i * 32 * 256); RB[i] = *(const u32x4*)(pb0 + M_OFFB(kt) + i * 32 * 256);
#define M_LOAD(RA, RB, kt) { M_LOAD1(RA, RB, kt, 0) M_LOAD1(RA, RB, kt, 1) M_LOAD1(RA, RB, kt, 2) M_LOAD1(RA, RB, kt, 3) }
#define M_STORE1(RA, RB, i) *(u32x4*)(base_ + ((lrow + 32 * i) * LROW + lcc) * 2) = RA[i]; *(u32x4*)(base_ + TILEB + ((lrow + 32 * i) * LROW + lcc) * 2) = RB[i];
#define M_STORE(RA, RB, buf) { char* base_ = smem + (buf) * 2 * TILEB; M_STORE1(RA, RB, 0) M_STORE1(RA, RB, 1) M_STORE1(RA, RB, 2) M_STORE1(RA, RB, 3) }
#define M_STEP(ks) { \
      bf16x8 a0 = *(const bf16x8*)(bA_ + ks * 32); \
      bf16x8 a1 = *(const bf16x8*)(bA_ + 32 * LROW * 2 + ks * 32); \
      bf16x8 b0 = *(const bf16x8*)(bB_ + ks * 32); \
      bf16x8 b1 = *(const bf16x8*)(bB_ + 32 * LROW * 2 + ks * 32); \
      acc[0][0] = MFMA32(a0, b0, acc[0][0]); \
      acc[0][1] = MFMA32(a0, b1, acc[0][1]); \
      acc[1][0] = MFMA32(a1, b0, acc[1][0]); \
      acc[1][1] = MFMA32(a1, b1, acc[1][1]); }
#define M_COMPUTE(buf) { \
    const char* bA_ = smem + (buf) * 2 * TILEB + ((wm * 64 + r) * LROW + hh * 8) * 2; \
    const char* bB_ = smem + (buf) * 2 * TILEB + TILEB + ((wn * 64 + r) * LROW + hh * 8) * 2; \
    M_STEP(0) M_STEP(1) M_STEP(2) M_STEP(3) }
#define M_GLOAD(i) { \
    _Pragma("unroll") for (int mb = 0; mb < 2; ++mb) \
      _Pragma("unroll") for (int nb2 = 0; nb2 < 2; ++nb2) { \
        const int mt32 = mt * 4 + wm * 2 + mb, nt32 = (i) * 32 + nt * 4 + wn * 2 + nb2; \
        const u32x4* gp = (const u32x4*)(gates + (((size_t)mt32 * 128 + nt32) * 64 + lane) * 16); \
        gq[mb][nb2][0] = gp[0]; gq[mb][nb2][1] = gp[1]; } }
#define M_APPLY() { \
    _Pragma("unroll") for (int mb = 0; mb < 2; ++mb) \
      _Pragma("unroll") for (int nb2 = 0; nb2 < 2; ++nb2) { \
        _Pragma("unroll") for (int q = 0; q < 16; ++q) { \
          const unsigned wv = gq[mb][nb2][q >> 3][(q >> 1) & 3]; \
          const float gv = __uint_as_float((q & 1) ? (wv & 0xffff0000u) : (wv << 16)); \
          tot[mb][nb2][q] += gv * acc[mb][nb2][q]; } \
        acc[mb][nb2] = fzero(); } }
  M_GLOAD(0);
  M_LOAD(ra0, rb0, 0);
  M_STORE(ra0, rb0, 0);
  M_LOAD(ra0, rb0, 1);
#pragma unroll 1
  for (int kt = 0; kt < 16; kt += 2) {
    __syncthreads();
    M_STORE(ra0, rb0, 1);
    if (kt + 2 < 16) M_LOAD(ra0, rb0, kt + 2);
    M_COMPUTE(0);
    __syncthreads();
    if (kt + 2 < 16) {
      M_STORE(ra0, rb0, 0);
      if (kt + 3 < 16) M_LOAD(ra0, rb0, kt + 3);
    }
    M_COMPUTE(1);
    if ((kt & 3) == 2) {
      M_APPLY();
      if (kt + 2 < 16) M_GLOAD((kt + 2) >> 2);
    }
  }
  __syncthreads();
#undef M_OFFA
#undef M_OFFB
#undef M_LOAD1
#undef M_LOAD
#undef M_STORE1
#undef M_STORE
#undef M_STEP
#undef M_COMPUTE
#undef M_GLOAD
#undef M_APPLY
  bf16_t* am = (bf16_t*)(ws + oq(O_ACCM));
#pragma unroll
  for (int mb = 0; mb < 2; ++mb)
#pragma unroll
    for (int nb2 = 0; nb2 < 2; ++nb2)
#pragma unroll
      for (int q = 0; q < 16; ++q) {
        const int m = wm * 64 + mb * 32 + crow(q, hh), n = nt * 128 + wn * 64 + nb2 * 32 + r;
        am[(size_t)(r0 + m) * D + n] = f2bf(tot[mb][nb2][q]);
      }
}
DI void outproj_tile(const Params& P, int l, int mt, int nt, char* smem) {
  char* ws = P.ws;
  const int r0 = mt * 128;
  f32x16 acc[2][4];
  zero_acc8(acc);
  PlainRows ar{(const bf16_t*)(ws + oq(O_ACCM)) + (size_t)r0 * D, D};
  gemm_main2(ar, (const bf16_t*)(ws + smallw(l) + oq(O_WT_OUT)) + (size_t)nt * 256 * D, D, D, smem, acc);
  const int lane = TIDX & 63, w = TIDX >> 6, wm = w >> 1, wn = w & 1, r = lane & 31, hh = lane >> 5;
  const int s = row_modsel(r0);
  const float* gt1 = (const float*)(ws + oq(O_MOD)) + ((size_t)l * 3 + s) * INC + 2 * D;
#pragma unroll
  for (int mb = 0; mb < 2; ++mb)
#pragma unroll
    for (int q = 0; q < 16; ++q) {
      const int m = wm * 64 + mb * 32 + crow(q, hh);
      const float* xi = (l == 0) ? x_in_row(P, r0 + m) : x_buf_row(P, r0 + m);
      float* xo = x_buf_row(P, r0 + m);
#pragma unroll
      for (int nb2 = 0; nb2 < 4; ++nb2) {
        const int n = nt * 256 + wn * 128 + nb2 * 32 + r;
        xo[n] = xi[n] + gt1[n] * acc[mb][nb2][q];
      }
    }
}

template <int NPT>
DI void topk_task(const Params& P, int smp, int e, char* smem) {
  char* ws = P.ws;
  constexpr int N = NPT * 256;
  constexpr int cap = N / 8;
  const int tid = TIDX, lane = tid & 63, w = tid >> 6;
  float* sv = (float*)smem;
  int* red = (int*)(smem + 65536);
  int* cg_ = (int*)(smem + 65536 + 64);
  int* ce_ = cg_ + 256;
  const float* aff = (const float*)(ws + oq(O_AFF)) + ((size_t)smp * NE + e) * T;
  for (int i = tid; i < N; i += 256) sv[i] = aff[i];
  __syncthreads();
  unsigned u[NPT];
#pragma unroll
  for (int j = 0; j < NPT; ++j) u[j] = __float_as_uint(sv[tid * NPT + j]);
  unsigned thr = 0;
  for (int bit = 30; bit >= 0; --bit) {
    const unsigned cand = thr | (1u << bit);
    int cnt = 0;
#pragma unroll
    for (int j = 0; j < NPT; ++j) cnt += (u[j] >= cand) ? 1 : 0;
#pragma unroll
    for (int o = 32; o >= 1; o >>= 1) cnt += __shfl_xor(cnt, o, 64);
    if (lane == 0) red[w] = cnt;
    __syncthreads();
    const int total = red[0] + red[1] + red[2] + red[3];
    __syncthreads();
    if (total >= cap) thr = cand;
  }
  int ng = 0, neq = 0;
#pragma unroll
  for (int j = 0; j < NPT; ++j) { ng += (u[j] > thr) ? 1 : 0; neq += (u[j] == thr) ? 1 : 0; }
  cg_[tid] = ng; ce_[tid] = neq;
  __syncthreads();
  int pg = 0, pe = 0, totg = 0;
  for (int i = 0; i < 256; ++i) {
    const int a = cg_[i], bq = ce_[i];
    if (i < tid) { pg += a; pe += bq; }
    totg += a;
  }
  const int need_eq = cap - totg;
  int* rows = (int*)(ws + oq(O_ROWS)) + (size_t)e * SLOTS;
  float* gl = (float*)(ws + oq(O_GL)) + (size_t)e * SLOTS;
  const int slot_base = smp < 2 ? smp * 2048 : 4096 + (smp - 2) * 32;
  const int row_base = smp < 2 ? smp * PB : (smp - 2) * PB + T;
#pragma unroll
  for (int j = 0; j < NPT; ++j) {
    const int idx = tid * NPT + j;
    int slot = -1;
    if (u[j] > thr) { slot = pg; ++pg; }
    else if (u[j] == thr) { if (pe < need_eq) slot = totg + pe; ++pe; }
    if (slot >= 0) { rows[slot_base + slot] = row_base + idx; gl[slot_base + slot] = __uint_as_float(u[j]); }
  }
  if (smp == 0 && tid < 64) rows[4160 + tid] = -1;
  __syncthreads();
}

struct GatherRows {
  const bf16_t* base; const int* rows;
  DI const bf16_t* operator()(int m) const { int rr = rows[m]; return base + (size_t)(rr < 0 ? 0 : rr) * D; }
};
DI void expert1_tile(const Params& P, int e, int mt, int nt, char* smem) {
  char* ws = P.ws;
  f32x16 acc[2][4];
  zero_acc8(acc);
  GatherRows ar{(const bf16_t*)(ws + oq(O_H)), (const int*)(ws + oq(O_ROWS)) + (size_t)e * SLOTS + mt * 128};
  gemm_main2(ar, (const bf16_t*)(ws + oq(O_WT_13)) + ((size_t)e * 2 * FF + nt * 256) * D, D, D, smem, acc);
  bf16_t* hid = (bf16_t*)(ws + oq(O_HID)) + ((size_t)e * SLOTS + mt * 128) * FF;
  const int lane = TIDX & 63, w = TIDX >> 6, wm = w >> 1, wn = w & 1, r = lane & 31, hh = lane >> 5;
#pragma unroll
  for (int pr = 0; pr < 2; ++pr) {
    const int f = nt * 128 + wn * 64 + pr * 32 + r;
#pragma unroll
    for (int mb = 0; mb < 2; ++mb)
#pragma unroll
      for (int q = 0; q < 16; ++q) {
        const int m = wm * 64 + mb * 32 + crow(q, hh);
        const float gv = acc[mb][2 * pr][q], uv = acc[mb][2 * pr + 1][q];
        hid[(size_t)m * FF + f] = f2bf(gv / (1.f + __expf(-gv)) * uv);
      }
  }
}
DI void expert2_tile(const Params& P, int l, int e, int mt, int nt, char* smem) {
  char* ws = P.ws;
  f32x16 acc[2][4];
  zero_acc8(acc);
  PlainRows ar{(const bf16_t*)(ws + oq(O_HID)) + ((size_t)e * SLOTS + mt * 128) * FF, FF};
  gemm_main2(ar, (const bf16_t*)(ws + oq(O_WT_2)) + ((size_t)e * D + nt * 256) * FF, FF, FF, smem, acc);
  const int* rows = (const int*)(ws + oq(O_ROWS)) + (size_t)e * SLOTS + mt * 128;
  const float* gl = (const float*)(ws + oq(O_GL)) + (size_t)e * SLOTS + mt * 128;
  const int lane = TIDX & 63, w = TIDX >> 6, wm = w >> 1, wn = w & 1, r = lane & 31, hh = lane >> 5;
#pragma unroll
  for (int mb = 0; mb < 2; ++mb)
#pragma unroll
    for (int q = 0; q < 16; ++q) {
      const int m = wm * 64 + mb * 32 + crow(q, hh);
      const int row = rows[m];
      if (row < 0) continue;
      const float gv = gl[m];
      const float* gt2 = (const float*)(ws + oq(O_MOD)) + ((size_t)l * 3 + row_modsel(row)) * INC + 5 * D;
      float* xo = x_buf_row(P, row);
#pragma unroll
      for (int nb2 = 0; nb2 < 4; ++nb2) {
        const int n = nt * 256 + wn * 128 + nb2 * 32 + r;
        unsafeAtomicAdd(xo + n, gt2[n] * gv * acc[mb][nb2][q]);
      }
    }
}

#define XB_TMO      128
#define XB_XCNT(j)  (256  + 64 * (j))
#define XB_XSUB(j)  (1280 + 64 * (j))
#define XB_XGEN(j)  (2304 + 64 * (j))
#define XB_TOP      3328
#define XB_TOPGEN   3392
#define XCD_BAR_WORDS 3456
#define XB_SPIN_CAP (1u << 18)
#define LAS __attribute__((address_space(3)))

__device__ __forceinline__ unsigned xb_ld(unsigned* p)              { return __hip_atomic_load(p, __ATOMIC_RELAXED, __HIP_MEMORY_SCOPE_AGENT); }
__device__ __forceinline__ unsigned xb_add(unsigned* p, unsigned v) { return __hip_atomic_fetch_add(p, v, __ATOMIC_RELAXED, __HIP_MEMORY_SCOPE_AGENT); }
__device__ __forceinline__ unsigned xb_xcc_id() { return (unsigned)__builtin_amdgcn_s_getreg((3 << 11) | 20) & 0xFu; }
#define XB_SPIN(cond, bar) do { unsigned _sp = 0; while (cond) { __builtin_amdgcn_s_sleep(1); \
    if ((++_sp & 255u) == 0u) { if (xb_ld(&(bar)[XB_TMO])) break; if (_sp > XB_SPIN_CAP) { atomicAdd(&(bar)[XB_TMO], 1u); break; } } } } while (0)

struct XcdBarrier {
    unsigned* bar; unsigned x;
    volatile LAS unsigned* st;
};

__device__ __forceinline__ XcdBarrier xcd_barrier_post(unsigned* bar, volatile LAS unsigned* st) {
    XcdBarrier b; b.bar = bar; b.x = xb_xcc_id(); b.st = st;
    if (threadIdx.x == 0) (void)xb_add(&bar[XB_XCNT(b.x)], 1u);
    return b;
}
__device__ __forceinline__ void xcd_barrier_complete(unsigned* bar, unsigned x, unsigned& nloc, unsigned& nx) {
    const unsigned G = gridDim.x * gridDim.y * gridDim.z;
    unsigned sum, cnt, mine, sp = 0u;
    for (;;) {
        sum = 0u; cnt = 0u; mine = 0u;
#pragma unroll
        for (unsigned j = 0; j < 16; ++j) { const unsigned c = xb_ld(&bar[XB_XCNT(j)]); sum += c; cnt += (c > 0u) ? 1u : 0u; mine = (j == x) ? c : mine; }
        if (sum == G) break;
        __builtin_amdgcn_s_sleep(1);
        if ((++sp & 255u) == 0u) { if (xb_ld(&bar[XB_TMO])) break; if (sp > XB_SPIN_CAP) { atomicAdd(&bar[XB_TMO], 1u); break; } }
    }
    nloc = mine > 0u ? mine : 1u; nx = cnt > 0u ? cnt : 1u;
}

__device__ __forceinline__ void xcd_barrier(const XcdBarrier& b) {
    asm volatile("s_waitcnt vmcnt(0)" ::: "memory");
    __syncthreads();
    if (threadIdx.x == 0) {
        unsigned* bar = b.bar;
        __builtin_amdgcn_s_waitcnt(0);
        unsigned nloc = b.st[0], nx = b.st[1];
        if (nloc == 0u) { xcd_barrier_complete(bar, b.x, nloc, nx); b.st[0] = nloc; b.st[1] = nx; }
        const unsigned old = xb_add(&bar[XB_XSUB(b.x)], 1u);
        const unsigned gen = old / nloc;
        if (old + 1u == (gen + 1u) * nloc) {
            __builtin_amdgcn_fence(__ATOMIC_RELEASE, "agent");
            asm volatile("s_waitcnt vmcnt(0)" ::: "memory");
            const unsigned og = xb_add(&bar[XB_TOP], 1u);
            const unsigned tg = og / nx;
            if (og + 1u == (tg + 1u) * nx) xb_add(&bar[XB_TOPGEN], 1u);
            else XB_SPIN(xb_ld(&bar[XB_TOPGEN]) == tg, bar);
            __builtin_amdgcn_fence(__ATOMIC_ACQUIRE, "agent");
            xb_add(&bar[XB_XGEN(b.x)], 1u);
            asm volatile("s_waitcnt vmcnt(0)" ::: "memory");
        } else {
            XB_SPIN(xb_ld(&bar[XB_XGEN(b.x)]) == gen, bar);
            __builtin_amdgcn_fence(__ATOMIC_ACQUIRE, "agent");
            asm volatile("s_waitcnt vmcnt(0)" ::: "memory");
        }
    }
    __syncthreads();
}


constexpr int NPL = 12;
constexpr int NPHASE = 1 + 2 * NPL;

DI void run_phase0(const Params& P, char* smem) {
  const int bid = opaque_bid(), nb = gridDim.x;
  {
    for (int t = bid; t < 192 + 64 + 2 * WT_SMALL; t += nb) {
      if (t < 192) ada_task(P, t, smem);
      else if (t < 256) tables_task(P, t - 192);
      else if (t < 256 + WT_SMALL) convert_weight_tile(P, 0, t - 256, smem);
      else convert_weight_tile(P, 1, t - 256 - WT_SMALL, smem);
    }
  }
}
template <int SP>
DI void run_sub(const Params& P, int l, char* smem) {
  const int bid = opaque_bid(), nb = gridDim.x;
  const bool last = l == 1;
  if constexpr (SP == 0) {
      modnorm_phase(P, l, false, bid, nb, smem);
  }
  if constexpr (SP == 1) {
      const int x = bid & 7, j = bid >> 3, nbx = nb >> 3;
      if (bid < nbx * 8)
        for (int lt = j; lt < 130 * 6; lt += nbx) {
          const int mt = (x >> 2) * 130 + lt / 6, nt = (x & 3) * 6 + lt % 6;
          if (last && (mt % 130) >= 128 && nt < 20) continue;
          inproj_tile(P, l, mt, nt, smem);
        }
  }
  if constexpr (SP == 2) {
      const bool conv_first = (bid >= (nb >> 1));
      if (conv_first)
        for (int t = bid - (nb >> 1); t < WT_TILES - WT_SMALL; t += nb) convert_weight_tile(P, l, WT_SMALL + t, smem);
      {
        const int x = bid & 7, j = bid >> 3, nbx = nb >> 3;
        if (bid < nbx * 8) {
          for (int q = j; q < 128; q += nbx) diffattn_task(P, l, x >> 2, x & 3, q * 128, 0, PB, smem);
          if (!last && j < 2) diffattn_task(P, l, x >> 2, x & 3, T + j * 128, T, CTXL, smem);
        }
      }
#ifndef PROBE_PART
#define PROBE_PART 0
#endif
#pragma unroll 1
      for (int rep = 0; rep < 1 + PROBE_PART; ++rep) {
      {
        const int x = bid & 7, j = bid >> 3, nbx = nb >> 3;
        if (bid < nbx * 8) {
          for (int q = j; q < 128; q += nbx) na_task(P, l, x >> 2, false, (x & 3) * 64 + (q >> 1), q & 1, smem);
          if (!last && j < 2) na_task(P, l, x >> 2, true, 0, (x & 3) * 2 + j, smem);
        }
      }
      for (int tile = bid; tile < 1040; tile += nb) {
        const bool isctx = (tile % 520) >= 512;
        if (!(last && isctx)) pool_task(P, l, tile, smem);
      }
      for (int t = bid; t < 1024; t += nb) fft_stage0_lat(P, t, smem);
      if (!last) for (int t = bid; t < 16; t += nb) fft_stage0_ctx(P, t, smem);      }
      if (!conv_first)
        for (int t = bid + (nb >> 1); t < WT_TILES - WT_SMALL; t += nb) convert_weight_tile(P, l, WT_SMALL + t, smem);

  }
  if constexpr (SP == 3) {
      const int n = 1024 + (last ? 0 : 8);
      for (int t = bid; t < n; t += nb) { if (t < 1024) fft_stage1_lat(P, t, smem); else fft_stage1_ctx(P, t - 1024, smem); }
  }
  if constexpr (SP == 4) {
      for (int t = bid; t < 512; t += nb) fft_stage2_lat(P, t, smem);
  }
  if constexpr (SP == 5) {
      for (int t = bid; t < 520; t += nb) { const int mt = t >> 1; if (last && (mt % 130) >= 128) continue; fnet_final_tile(P, l, mt, t & 1, smem); }
  }
  if constexpr (SP == 6) {
      const int x = bid & 7, j = bid >> 3, nbx = nb >> 3;
      if (bid < nbx * 8)
        for (int lt = j; lt < 33 * 8; lt += nbx) {
          const int mt = x + 8 * (lt >> 3);
          if (mt >= 260 || (last && (mt % 130) >= 128)) continue;
          merge_tile(P, l, mt, lt & 7, smem);
        }
  }
  if constexpr (SP == 7) {
      const int x = bid & 7, j = bid >> 3, nbx = nb >> 3;
      if (bid < nbx * 8)
        for (int lt = j; lt < 33 * 4; lt += nbx) {
          const int mt = x + 8 * (lt >> 2);
          if (mt >= 260 || (last && (mt % 130) >= 128)) continue;
          outproj_tile(P, l, mt, lt & 3, smem);
        }
  }
  if constexpr (SP == 8) { modnorm_phase(P, l, true, bid, nb, smem); }
  if constexpr (SP == 9) {
      const int n = last ? 32 : 64;
      for (int t = bid; t < n; t += nb) {
        const int smp = t >> 4, e = t & 15;
        if (smp < 2) topk_task<64>(P, smp, e, smem); else topk_task<1>(P, smp, e, smem);
      }
  }
  if constexpr (SP == 10) {
      const int nmt = last ? 32 : 33;
      const int x = bid & 7, j = bid >> 3, nbx = nb >> 3, npairs = NE * nmt;
      if (bid < nbx * 8)
        for (int lt = j; lt < ((npairs + 7) >> 3) * 11; lt += nbx) {
          const int p = x + 8 * (lt / 11);
          if (p >= npairs) continue;
          expert1_tile(P, p / nmt, p % nmt, lt % 11, smem);
        }
  }
  if constexpr (SP == 11) {
      const int nmt = last ? 32 : 33;
      const int x = bid & 7, j = bid >> 3, nbx = nb >> 3, npairs = NE * nmt;
      if (bid < nbx * 8)
        for (int lt = j; lt < ((npairs + 7) >> 3) * 4; lt += nbx) {
          const int p = x + 8 * (lt >> 2);
          if (p >= npairs) continue;
          expert2_tile(P, l, p / nmt, p % nmt, lt & 3, smem);
        }
  }
}

__shared__ __attribute__((aligned(16))) char g_smem[SMEM_BYTES];

#if ONE_LAUNCH
#ifndef PROBE_DUP
#define PROBE_DUP -1
#endif
#ifndef PROBE_MASK
#define PROBE_MASK 0
#endif
#define PH_STEP(SPV, L)                                \
  xcd_barrier(xb);                                     \
  run_sub<SPV>(P, L, g_smem);                          \
  if (SPV == PROBE_DUP || ((PROBE_MASK >> SPV) & 1)) { xcd_barrier(xb); run_sub<SPV>(P, L, g_smem); }
#define PH_LAYER(L)                                                                      \
  PH_STEP(0, L) PH_STEP(1, L) PH_STEP(2, L) PH_STEP(3, L) PH_STEP(4, L) PH_STEP(5, L)    \
  PH_STEP(6, L) PH_STEP(7, L) PH_STEP(8, L) PH_STEP(9, L) PH_STEP(10, L) PH_STEP(11, L)
#define PH_LAYER0_NOSYNC                                                                 \
  run_sub<0>(P, 0, g_smem);                                                              \
  PH_STEP(1, 0) PH_STEP(2, 0) PH_STEP(3, 0) PH_STEP(4, 0) PH_STEP(5, 0)                  \
  PH_STEP(6, 0) PH_STEP(7, 0) PH_STEP(8, 0) PH_STEP(9, 0) PH_STEP(10, 0) PH_STEP(11, 0)
__shared__ uint4 xb_words;
__global__ void __launch_bounds__(256, 2) mega(Params P) {
  cg::grid_group grid = cg::this_grid();
  if (threadIdx.x == 0) xb_words = make_uint4(0u, 0u, 0u, 0u);
  __syncthreads();
  XcdBarrier xb = xcd_barrier_post((unsigned*)(P.ws + O_BAR), (volatile LAS unsigned*)&xb_words);
  run_phase0(P, g_smem);
  if (xb_ld((unsigned*)(P.ws + O_BAR) + XB_TMO) == 0xFFFFFFFFu) grid.sync();
  xcd_barrier(xb);
  PH_LAYER0_NOSYNC
  PH_LAYER(1)
}
#else
__global__ void __launch_bounds__(256, 2) kphase0(Params P) { run_phase0(P, g_smem); }
template <int SP>
__global__ void __launch_bounds__(256, 2) kphase(Params P, int l) { run_sub<SP>(P, l, g_smem); }
#endif

extern "C" void kernel_launch(void* const* d_in, const int* in_sizes, int n_in, void* d_out, int out_size, void* d_ws,
                              size_t ws_size, hipStream_t stream) {
  static int grid_blocks = 0;
  if (!grid_blocks) {
    int dev = 0, cus = 0, per_cu = 0;
    (void)hipGetDevice(&dev);
    (void)hipDeviceGetAttribute(&cus, hipDeviceAttributeMultiprocessorCount, dev);
#if ONE_LAUNCH
    (void)hipOccupancyMaxActiveBlocksPerMultiprocessor(&per_cu, mega, 256, 0);
#else
    per_cu = 2;
#endif
    if (per_cu < 1) per_cu = 1;
    if (per_cu > 2) per_cu = 2;
    grid_blocks = cus * per_cu;
  }
  if (ws_size < WS_TOTAL) { fprintf(stderr, "workspace too small: %zu < %zu\n", ws_size, (size_t)WS_TOTAL); }
  Params P{};
  const float** pp = (const float**)&P;
  for (int i = 0; i < 25; ++i) pp[i] = (const float*)d_in[i];
  P.out = (float*)d_out;
  P.ws = (char*)d_ws;
#if ONE_LAUNCH
  (void)hipMemsetAsync((char*)d_ws + O_BAR, 0, 16384, stream);
  void* args[] = {&P};
  hipError_t e = hipLaunchCooperativeKernel((void*)mega, dim3(grid_blocks), dim3(256), args, 0, stream);
  if (e != hipSuccess) fprintf(stderr, "cooperative launch failed: %s (grid %d)\n", hipGetErrorString(e), grid_blocks);
#else
  const dim3 g(grid_blocks), b(256);
  kphase0<<<g, b, 0, stream>>>(P);
  for (int l = 0; l < 2; ++l) {
    kphase<0><<<g, b, 0, stream>>>(P, l);
    kphase<1><<<g, b, 0, stream>>>(P, l);
    kphase<2><<<g, b, 0, stream>>>(P, l);
    kphase<3><<<g, b, 0, stream>>>(P, l);
    kphase<4><<<g, b, 0, stream>>>(P, l);
    kphase<5><<<g, b, 0, stream>>>(P, l);
    kphase<6><<<g, b, 0, stream>>>(P, l);
    kphase<7><<<g, b, 0, stream>>>(P, l);
    kphase<8><<<g, b, 0, stream>>>(P, l);
    kphase<9><<<g, b, 0, stream>>>(P, l);
    kphase<10><<<g, b, 0, stream>>>(P, l);
    kphase<11><<<g, b, 0, stream>>>(P, l);
  }
#endif
}
```

```cpp
#include <hip/hip_runtime.h>
#include <hip/hip_cooperative_groups.h>
#include <stdint.h>
#include <cstdio>
namespace cg = cooperative_groups;

#ifndef ONE_LAUNCH
#define ONE_LAUNCH 1
#endif

#define DI __device__ __forceinline__
typedef unsigned short bf16_t;
using bf16x8 = __attribute__((ext_vector_type(8))) short;
using s16x4 = __attribute__((ext_vector_type(4))) short;
using u32x4 = __attribute__((ext_vector_type(4))) unsigned;
using f32x16 = __attribute__((ext_vector_type(16))) float;
typedef __bf16 bf2_t __attribute__((ext_vector_type(2)));
typedef float f2_t __attribute__((ext_vector_type(2)));
#define MFMA32(a, b, c) __builtin_amdgcn_mfma_f32_32x32x16_bf16((a), (b), (c), 0, 0, 0)

constexpr int D = 1024;
constexpr int T = 16384;
constexpr int CTXL = 256;
constexpr int PB = T + CTXL;
constexpr int R = 2 * PB;
constexpr int INC = 6144;
constexpr int NE = 16;
constexpr int FF = 1408;
constexpr int SLOTS = 4224;
constexpr float EPS = 1e-6f;
constexpr float LOG2E = 1.4426950408889634f;
constexpr float TWO_PI_UNUSED = 6.283185307179586f;

constexpr size_t AL(size_t x) { return (x + 255) & ~(size_t)255; }
constexpr size_t O_WT_IN = 0;
constexpr size_t O_WT_BR = O_WT_IN + (size_t)INC * D * 2;
constexpr size_t O_WT_OUT = O_WT_BR + (size_t)4 * D * 256 * 2;
constexpr size_t O_WT_FN = O_WT_OUT + (size_t)D * D * 2;
constexpr size_t O_WT_13 = O_WT_FN + (size_t)256 * 256 * 2;
constexpr size_t O_WT_2 = O_WT_13 + (size_t)NE * 2 * FF * D * 2;
constexpr size_t O_WC = O_WT_2 + (size_t)NE * D * FF * 2;
constexpr size_t O_D1 = O_WC + (size_t)512 * 256 * 2;
constexpr size_t O_D2 = O_D1 + (size_t)256 * 256 * 2;
constexpr size_t O_DC = O_D2 + (size_t)128 * 256 * 2;
constexpr size_t O_ROPE = O_DC + (size_t)256 * 512 * 2;
constexpr size_t O_MOD = O_ROPE + (size_t)256 * 8 * 2 * 4;
constexpr size_t O_CONST = O_MOD + (size_t)2 * 3 * INC * 4;
constexpr size_t O_H = AL(O_CONST + 256);
constexpr size_t O_Z1 = O_H;
constexpr size_t O_Z2 = O_H + (size_t)2 * T * 512 * 2;
constexpr size_t O_Z1C = O_Z2 + (size_t)2 * T * 512 * 2;
constexpr size_t O_QPF = O_H + (size_t)R * D * 2;
constexpr size_t SZ256 = (size_t)R * 256 * 2;
constexpr size_t O_ACCM = O_QPF;
constexpr size_t O_GATES = O_QPF + 4 * SZ256;
constexpr size_t O_HID = O_GATES;
constexpr size_t O_KV = O_GATES + (size_t)R * 4096 * 2;
constexpr size_t O_Y = O_KV + 4 * SZ256;
constexpr size_t O_XCTX = O_Y + 4 * SZ256;
constexpr size_t O_AFF = O_XCTX + (size_t)512 * D * 4;
constexpr size_t O_ROWS = O_AFF + (size_t)4 * NE * T * 4;
constexpr size_t O_GL = O_ROWS + (size_t)NE * SLOTS * 4;
constexpr size_t O_BAR = AL(O_GL + (size_t)NE * SLOTS * 4);
constexpr size_t O_SMALLW1 = O_BAR + 16384;
constexpr size_t SMALLW = O_WT_13;
constexpr size_t WS_TOTAL = O_SMALLW1 + SMALLW;
static_assert(O_Z1C + (size_t)2 * 256 * 512 * 2 <= O_QPF, "fft scratch must fit in h");
static_assert((size_t)NE * SLOTS * FF * 2 <= (size_t)R * 4096 * 2, "hid must fit in gates");

struct Params {
  const float *x, *c, *ctx, *c_ctx, *w_ada, *b_ada, *g_mix, *g_ffn, *w_in, *na_q_g, *na_k_g, *na_rpb, *df_q_g,
      *df_k_g, *df_lambda, *df_subln_g, *pool_w, *pool_scale, *fnet_w, *w_branch, *w_out, *w_router, *w_gate_e,
      *w_up_e, *w_down_e;
  float* out;
  char* ws;
};

constexpr int SMEM_BYTES = 73728;
constexpr int LROW = 72;
constexpr int TILEB = 128 * LROW * 2;

DI int opaque_tid() { int t = threadIdx.x; asm volatile("" : "+v"(t)); return t; }
DI int opaque_bid() { int t = blockIdx.x; asm volatile("" : "+s"(t)); return t; }
DI size_t oq(size_t x) { asm volatile("" : "+s"(x)); return x; }
#define TIDX opaque_tid()
DI float bf2f(bf16_t b) { return __uint_as_float(((unsigned)b) << 16); }
DI unsigned pack2(float a, float b) {
  f2_t v = {a, b};
  bf2_t r = __builtin_convertvector(v, bf2_t);
  return __builtin_bit_cast(unsigned, r);
}
DI bf16_t f2bf(float a) { return (bf16_t)(pack2(a, 0.f) & 0xffffu); }
DI bf16x8 pack8(float a0, float a1, float a2, float a3, float a4, float a5, float a6, float a7) {
  uint4 u = {pack2(a0, a1), pack2(a2, a3), pack2(a4, a5), pack2(a6, a7)};
  return __builtin_bit_cast(bf16x8, u);
}
DI float wave_sum(float v) {
#pragma unroll
  for (int o = 32; o >= 1; o >>= 1) v += __shfl_xor(v, o, 64);
  return v;
}
DI int crow(int i, int hh) { return (i & 3) + 8 * (i >> 2) + 4 * hh; }
DI f32x16 fzero() {
  f32x16 z;
#pragma unroll
  for (int i = 0; i < 16; ++i) z[i] = 0.f;
  return z;
}
DI void row_info(int r, int& b, int& p) { b = r >= PB ? 1 : 0; p = r - b * PB; }
DI const float* x_in_row(const Params& P, int r) {
  int b, p; row_info(r, b, p);
  return p < T ? P.x + ((size_t)b * T + p) * D : P.ctx + ((size_t)b * CTXL + (p - T)) * D;
}
DI float* x_buf_row(const Params& P, int r) {
  int b, p; row_info(r, b, p);
  return p < T ? P.out + ((size_t)b * T + p) * D : (float*)(P.ws + oq(O_XCTX)) + ((size_t)b * CTXL + (p - T)) * D;
}
DI int row_modsel(int r) { int b, p; row_info(r, b, p); return p < T ? b : 2; }

template <class ARow>
DI void gemm_main(ARow arow, const bf16_t* __restrict__ Bt, long ldb, int K, char* smem, f32x16 (&acc)[2][2]) {
  const int tid = TIDX, lane = tid & 63, w = tid >> 6, wm = w >> 1, wn = w & 1;
  const int r = lane & 31, hh = lane >> 5;
  const int lrow = tid >> 3, lcc = (tid & 7) * 8;
  const bf16_t* pa[4];
#pragma unroll
  for (int i = 0; i < 4; ++i) pa[i] = arow(lrow + 32 * i) + lcc;
  const bf16_t* pb0 = Bt + (long)lrow * ldb + lcc;
  const long ldb32 = 32 * ldb;
  u32x4 ra0[4], rb0[4], ra1[4], rb1[4];
  const int nk = K >> 6;
#define G_LOAD1(RA, RB, kt, i) RA[i] = *(const u32x4*)(pa[i] + (kt) * 64); RB[i] = *(const u32x4*)(pb0 + i * ldb32 + (kt) * 64);
#define G_LOAD(RA, RB, kt) { G_LOAD1(RA, RB, kt, 0) G_LOAD1(RA, RB, kt, 1) G_LOAD1(RA, RB, kt, 2) G_LOAD1(RA, RB, kt, 3) }
#define G_STORE1(RA, RB, i) *(u32x4*)(base_ + ((lrow + 32 * i) * LROW + lcc) * 2) = RA[i]; *(u32x4*)(base_ + TILEB + ((lrow + 32 * i) * LROW + lcc) * 2) = RB[i];
#define G_STORE(RA, RB, buf) { char* base_ = smem + (buf) * 2 * TILEB; G_STORE1(RA, RB, 0) G_STORE1(RA, RB, 1) G_STORE1(RA, RB, 2) G_STORE1(RA, RB, 3) }
#define G_STEP(ks) { \
      bf16x8 a0 = *(const bf16x8*)(bA_ + ks * 32); \
      bf16x8 a1 = *(const bf16x8*)(bA_ + 32 * LROW * 2 + ks * 32); \
      bf16x8 b0 = *(const bf16x8*)(bB_ + ks * 32); \
      bf16x8 b1 = *(const bf16x8*)(bB_ + 32 * LROW * 2 + ks * 32); \
      acc[0][0] = MFMA32(a0, b0, acc[0][0]); \
      acc[0][1] = MFMA32(a0, b1, acc[0][1]); \
      acc[1][0] = MFMA32(a1, b0, acc[1][0]); \
      acc[1][1] = MFMA32(a1, b1, acc[1][1]); }
#define G_COMPUTE(buf) { \
    const char* bA_ = smem + (buf) * 2 * TILEB + ((wm * 64 + r) * LROW + hh * 8) * 2; \
    const char* bB_ = smem + (buf) * 2 * TILEB + TILEB + ((wn * 64 + r) * LROW + hh * 8) * 2; \
    G_STEP(0) G_STEP(1) G_STEP(2) G_STEP(3) }
  G_LOAD(ra0, rb0, 0);
  if (nk > 1) G_LOAD(ra1, rb1, 1);
  G_STORE(ra0, rb0, 0);
  if (nk > 2) G_LOAD(ra0, rb0, 2);
  for (int kt = 0; kt < nk; kt += 2) {
    __syncthreads();
    if (kt + 1 < nk) {
      G_STORE(ra1, rb1, 1);
      if (kt + 3 < nk) G_LOAD(ra1, rb1, kt + 3);
    }
    G_COMPUTE(0);
    if (kt + 1 < nk) {
      __syncthreads();
      if (kt + 2 < nk) {
        G_STORE(ra0, rb0, 0);
        if (kt + 4 < nk) G_LOAD(ra0, rb0, kt + 4);
      }
      G_COMPUTE(1);
    }
  }
  __syncthreads();
#undef G_LOAD
#undef G_STORE
#undef G_COMPUTE
#undef G_LOAD1
#undef G_STORE1
#undef G_STEP
}
struct PlainRows {
  const bf16_t* base; long ld;
  DI const bf16_t* operator()(int m) const { return base + (long)m * ld; }
};

constexpr int T2_B_OFF = 128 * LROW * 2;
template <class ARow>
DI void gemm_main2(ARow arow, const bf16_t* __restrict__ Bt, long ldb, int K, char* smem, f32x16 (&acc)[2][4]) {
  const int tid = TIDX, lane = tid & 63, w = tid >> 6, wm = w >> 1, wn = w & 1;
  const int r = lane & 31, hh = lane >> 5;
  const int lrow = tid >> 3, lcc = (tid & 7) * 8;
  const bf16_t* pa[4];
#pragma unroll
  for (int i = 0; i < 4; ++i) pa[i] = arow(lrow + 32 * i) + lcc;
  const bf16_t* pb0 = Bt + (long)lrow * ldb + lcc;
  const long ldb32 = 32 * ldb;
  u32x4 ra[4], rb[8];
  const int nk = K >> 6;
#define H_LA(i, kt) ra[i] = *(const u32x4*)(pa[i] + (kt) * 64);
#define H_LB(i, kt) rb[i] = *(const u32x4*)(pb0 + i * ldb32 + (kt) * 64);
#define H_LOAD(kt) { H_LA(0, kt) H_LA(1, kt) H_LA(2, kt) H_LA(3, kt) H_LB(0, kt) H_LB(1, kt) H_LB(2, kt) H_LB(3, kt) H_LB(4, kt) H_LB(5, kt) H_LB(6, kt) H_LB(7, kt) }
#define H_SA(i) *(u32x4*)(smem + ((lrow + 32 * i) * LROW + lcc) * 2) = ra[i];
#define H_SB(i) *(u32x4*)(smem + T2_B_OFF + ((lrow + 32 * i) * LROW + lcc) * 2) = rb[i];
#define H_STORE() { H_SA(0) H_SA(1) H_SA(2) H_SA(3) H_SB(0) H_SB(1) H_SB(2) H_SB(3) H_SB(4) H_SB(5) H_SB(6) H_SB(7) }
#define H_STEP(ks) { \
      bf16x8 a0 = *(const bf16x8*)(bA_ + ks * 32); \
      bf16x8 a1 = *(const bf16x8*)(bA_ + 32 * LROW * 2 + ks * 32); \
      bf16x8 b0 = *(const bf16x8*)(bB_ + ks * 32); \
      bf16x8 b1 = *(const bf16x8*)(bB_ + 32 * LROW * 2 + ks * 32); \
      bf16x8 b2 = *(const bf16x8*)(bB_ + 64 * LROW * 2 + ks * 32); \
      bf16x8 b3 = *(const bf16x8*)(bB_ + 96 * LROW * 2 + ks * 32); \
      acc[0][0] = MFMA32(a0, b0, acc[0][0]); \
      acc[1][0] = MFMA32(a1, b0, acc[1][0]); \
      acc[0][1] = MFMA32(a0, b1, acc[0][1]); \
      acc[1][1] = MFMA32(a1, b1, acc[1][1]); \
      acc[0][2] = MFMA32(a0, b2, acc[0][2]); \
      acc[1][2] = MFMA32(a1, b2, acc[1][2]); \
      acc[0][3] = MFMA32(a0, b3, acc[0][3]); \
      acc[1][3] = MFMA32(a1, b3, acc[1][3]); }
  const char* bA_ = smem + ((wm * 64 + r) * LROW + hh * 8) * 2;
  const char* bB_ = smem + T2_B_OFF + ((wn * 128 + r) * LROW + hh * 8) * 2;
  H_LOAD(0);
  for (int kt = 0; kt < nk; ++kt) {
    __syncthreads();
    H_STORE();
    __syncthreads();
    if (kt + 1 < nk) H_LOAD(kt + 1);
    H_STEP(0) H_STEP(1) H_STEP(2) H_STEP(3)
  }
  __syncthreads();
#undef H_LA
#undef H_LB
#undef H_LOAD
#undef H_SA
#undef H_SB
#undef H_STORE
#undef H_STEP
}
DI void zero_acc8(f32x16 (&acc)[2][4]) {
#pragma unroll
  for (int a = 0; a < 2; ++a)
#pragma unroll
    for (int b = 0; b < 4; ++b) acc[a][b] = fzero();
}

DI void transpose_tile(const float* __restrict__ src, long ld_src, bf16_t* __restrict__ dst, long ld_dst, int k0,
                       int n0, int rs, int off, char* smem) {
  float* Tt = (float*)smem;
  const int tid = TIDX;
#pragma unroll
  for (int i = 0; i < 4; ++i) {
    int k = (tid >> 4) + 16 * i, c4 = (tid & 15) * 4;
    float4 v = *(const float4*)(src + (long)(k0 + k) * ld_src + n0 + c4);
    Tt[k * 65 + c4 + 0] = v.x; Tt[k * 65 + c4 + 1] = v.y; Tt[k * 65 + c4 + 2] = v.z; Tt[k * 65 + c4 + 3] = v.w;
  }
  __syncthreads();
  const int n = tid >> 2, kq = (tid & 3) * 16;
  unsigned pk[8];
#pragma unroll
  for (int j = 0; j < 8; ++j) pk[j] = pack2(Tt[(kq + 2 * j) * 65 + n], Tt[(kq + 2 * j + 1) * 65 + n]);
  const int nn = n0 + n;
  const long drow = (long)(nn >> 5) * rs + off + (nn & 31);
  uint4* d = (uint4*)(dst + drow * ld_dst + k0 + kq);
  d[0] = make_uint4(pk[0], pk[1], pk[2], pk[3]);
  d[1] = make_uint4(pk[4], pk[5], pk[6], pk[7]);
  __syncthreads();
}

constexpr int WT_SMALL = 1536 + 256 + 256 + 16;
constexpr int WT_TILES = WT_SMALL + 5632 + 5632 + 5632;
DI size_t smallw(int l) { return l ? oq(O_SMALLW1) : (size_t)0; }
DI void convert_weight_tile(const Params& P, int l, int t, char* smem) {
  char* ws = P.ws;
  const size_t sw = smallw(l);
  if (t < 1536) {
    int kt = t / 96, nt = t % 96;
    transpose_tile(P.w_in + (size_t)l * D * INC, INC, (bf16_t*)(ws + sw + oq(O_WT_IN)), D, kt * 64, nt * 64, 32, 0, smem);
    return;
  }
  t -= 1536;
  if (t < 256) {
    int i = t >> 6, tt = t & 63, kt = tt >> 4, nt = tt & 15;
    transpose_tile(P.w_branch + ((size_t)l * 4 + i) * 256 * D, D, (bf16_t*)(ws + sw + oq(O_WT_BR)) + (size_t)i * D * 256, 256,
                   kt * 64, nt * 64, 32, 0, smem);
    return;
  }
  t -= 256;
  if (t < 256) {
    int kt = t >> 4, nt = t & 15;
    transpose_tile(P.w_out + (size_t)l * D * D, D, (bf16_t*)(ws + sw + oq(O_WT_OUT)), D, kt * 64, nt * 64, 32, 0, smem);
    return;
  }
  t -= 256;
  if (t < 16) {
    int kt = t >> 2, nt = t & 3;
    transpose_tile(P.fnet_w + (size_t)l * 256 * 256, 256, (bf16_t*)(ws + sw + oq(O_WT_FN)), 256, kt * 64, nt * 64, 32, 0, smem);
    return;
  }
  t -= 16;
  if (t < 11264) {
    int which = t >= 5632; if (which) t -= 5632;
    int e = t / 352, tt = t % 352, kt = tt / 22, nt = tt % 22;
    const float* src = (which ? P.w_up_e : P.w_gate_e) + ((size_t)l * NE + e) * D * FF;
    transpose_tile(src, FF, (bf16_t*)(ws + oq(O_WT_13)) + (size_t)e * 2 * FF * D, D, kt * 64, nt * 64, 64, which * 32, smem);
    return;
  }
  t -= 11264;
  {
    int e = t / 352, tt = t % 352, kt = tt / 16, nt = tt % 16;
    transpose_tile(P.w_down_e + ((size_t)l * NE + e) * FF * D, D, (bf16_t*)(ws + oq(O_WT_2)) + (size_t)e * D * FF, FF,
                   kt * 64, nt * 64, 32, 0, smem);
  }
}

DI void ada_task(const Params& P, int t, char* smem) {
  const int l = t / 96, n0 = (t % 96) * 64;
  float* sv = (float*)smem;
  float* red = sv + 3 * 1024;
  const int tid = TIDX;
  for (int i = tid; i < 3 * 1024; i += 256) {
    int s = i >> 10, k = i & 1023;
    float v = s < 2 ? P.c[s * D + k] : P.c_ctx[k];
    sv[i] = v / (1.f + __expf(-v));
  }
  __syncthreads();
  const int col = tid & 63, kg = tid >> 6;
  const float* wp = P.w_ada + (size_t)l * D * INC + n0 + col;
  float a0 = 0.f, a1 = 0.f, a2 = 0.f;
  for (int k = kg * 256; k < kg * 256 + 256; ++k) {
    float wv = wp[(size_t)k * INC];
    a0 += sv[k] * wv; a1 += sv[1024 + k] * wv; a2 += sv[2048 + k] * wv;
  }
  red[(kg * 3 + 0) * 64 + col] = a0; red[(kg * 3 + 1) * 64 + col] = a1; red[(kg * 3 + 2) * 64 + col] = a2;
  __syncthreads();
  if (tid < 192) {
    int s = tid >> 6, cc = tid & 63;
    float v = P.b_ada[(size_t)l * INC + n0 + cc];
    for (int g = 0; g < 4; ++g) v += red[(g * 3 + s) * 64 + cc];
    ((float*)(P.ws + oq(O_MOD)))[((size_t)l * 3 + s) * INC + n0 + cc] = v;
  }
  __syncthreads();
}

DI void tables_task(const Params& P, int t) {
  char* ws = P.ws;
  const int gtid = t * 256 + TIDX, gstride = 64 * 256;
  bf16_t* Wc = (bf16_t*)(ws + oq(O_WC));
  for (int i = gtid; i < 512 * 256; i += gstride) {
    int jj = i >> 8, c = i & 255, part = jj >> 8, j = jj & 255;
    float sn, cs; sincospif(2.f * (float)((j * c) & 255) / 256.f, &sn, &cs);
    Wc[i] = f2bf(part == 0 ? cs : -sn);
  }
  bf16_t* D1 = (bf16_t*)(ws + oq(O_D1));
  for (int i = gtid; i < 256 * 256; i += gstride) {
    int n = i >> 8, k = i & 255;
    int k1 = (n >> 6) * 32 + (n & 31), po = (n >> 5) & 1, pi = k >> 7, n1 = k & 127;
    float sn, cs; sincospif(2.f * (float)((k1 * n1) & 127) / 128.f, &sn, &cs);
    float v = po == 0 ? (pi == 0 ? cs : sn) : (pi == 0 ? -sn : cs);
    D1[i] = f2bf(v);
  }
  bf16_t* D2 = (bf16_t*)(ws + oq(O_D2));
  for (int i = gtid; i < 128 * 256; i += gstride) {
    int k2 = i >> 8, k = i & 255, pi = k >> 7, n2 = k & 127;
    float sn, cs; sincospif(2.f * (float)((k2 * n2) & 127) / 128.f, &sn, &cs);
    D2[i] = f2bf(pi == 0 ? cs : sn);
  }
  bf16_t* Dc = (bf16_t*)(ws + oq(O_DC));
  for (int i = gtid; i < 256 * 512; i += gstride) {
    int kk = i >> 9, k = i & 511, pi = k >> 8, n = k & 255;
    float sn, cs; sincospif(2.f * (float)((kk * n) & 255) / 256.f, &sn, &cs);
    Dc[i] = f2bf(pi == 0 ? cs : sn);
  }
  float* rope = (float*)(ws + oq(O_ROPE));
  for (int i = gtid; i < 256 * 8; i += gstride) {
    int pos = i >> 3, f = i & 7;
    float inv = powf(10000.f, -(float)f / 8.f);
    float ang = (float)pos * inv;
    rope[i * 2 + 0] = cosf(ang);
    rope[i * 2 + 1] = sinf(ang);
  }
  if (t == 0 && TIDX < 2) {
    const int l = TIDX;
    float* cst = (float*)(ws + oq(O_CONST)) + l * 8;
    const float* lv = P.df_lambda + l * 128;
    float d01 = 0.f, d23 = 0.f;
    for (int i = 0; i < 32; ++i) { d01 += lv[i] * lv[32 + i]; d23 += lv[64 + i] * lv[96 + i]; }
    float lam_init = 0.8f - 0.6f * expf(-0.3f * (float)l);
    cst[0] = expf(d01) - expf(d23) + lam_init;
    cst[1] = lam_init;
    float gq = 0.f, gk = 0.f;
    for (int i = 0; i < 32; ++i) { gq = fmaxf(gq, fabsf(P.df_q_g[l * 32 + i])); gk = fmaxf(gk, fabsf(P.df_k_g[l * 32 + i])); }
    cst[2] = sqrtf(32.f) * gq * gk * LOG2E;
    gq = 0.f; gk = 0.f;
    for (int i = 0; i < 64; ++i) { gq = fmaxf(gq, fabsf(P.na_q_g[l * 64 + i])); gk = fmaxf(gk, fabsf(P.na_k_g[l * 64 + i])); }
    float bm = 0.f;
    for (int i = 0; i < 4 * 15 * 31; ++i) bm = fmaxf(bm, fabsf(P.na_rpb[l * 4 * 15 * 31 + i]));
    cst[3] = (8.f * gq * gk + bm) * LOG2E;
  }
}

DI void modnorm_phase(const Params& P, int l, bool second, int bid, int nb, char* smem) {
  const int lane = TIDX & 63, w = TIDX >> 6;
  const int nw = nb * 4;
  bf16_t* h = (bf16_t*)(P.ws + oq(O_H));
  const float* g = (second ? P.g_ffn : P.g_mix) + (size_t)l * D;
  float* wt = (float*)smem;
  if (second) {
    const float* wr = P.w_router + (size_t)l * D * NE;
    for (int idx = TIDX; idx < D * NE; idx += 256) wt[(idx & 15) * D + (idx >> 4)] = wr[idx];
    __syncthreads();
  }
  for (int r = bid * 4 + w; r < R; r += nw) {
    int b, p; row_info(r, b, p);
    const bool isctx = p >= T;
    if (l == 1 && second && isctx) continue;
    const float* src = (l == 0 && !second) ? x_in_row(P, r) : x_buf_row(P, r);
    const int s = isctx ? 2 : b;
    const float* mb = (const float*)(P.ws + oq(O_MOD)) + ((size_t)l * 3 + s) * INC + (second ? 3 * D : 0);
    float4 v[4];
    float ss = 0.f;
#pragma unroll
    for (int i = 0; i < 4; ++i) {
      v[i] = *(const float4*)(src + lane * 4 + 256 * i);
      ss += v[i].x * v[i].x + v[i].y * v[i].y + v[i].z * v[i].z + v[i].w * v[i].w;
    }
    ss = wave_sum(ss);
    const float rstd = rsqrtf(ss * (1.f / D) + EPS);
    float hv[16];
#pragma unroll
    for (int i = 0; i < 4; ++i) {
      const int c = lane * 4 + 256 * i;
      float4 gg = *(const float4*)(g + c), sh = *(const float4*)(mb + c), sc = *(const float4*)(mb + D + c);
      hv[i * 4 + 0] = v[i].x * rstd * gg.x * (1.f + sc.x) + sh.x;
      hv[i * 4 + 1] = v[i].y * rstd * gg.y * (1.f + sc.y) + sh.y;
      hv[i * 4 + 2] = v[i].z * rstd * gg.z * (1.f + sc.z) + sh.z;
      hv[i * 4 + 3] = v[i].w * rstd * gg.w * (1.f + sc.w) + sh.w;
      uint2 o = {pack2(hv[i * 4 + 0], hv[i * 4 + 1]), pack2(hv[i * 4 + 2], hv[i * 4 + 3])};
      *(uint2*)(h + (size_t)r * D + c) = o;
    }
    if (second) {
      float lg[16];
#pragma unroll
      for (int e = 0; e < 16; ++e) lg[e] = 0.f;
#pragma unroll
      for (int i = 0; i < 4; ++i) {
#pragma unroll
        for (int e = 0; e < 16; ++e) {
          const float4 w4 = *(const float4*)(wt + e * D + 256 * i + lane * 4);
          lg[e] += hv[i * 4 + 0] * w4.x + hv[i * 4 + 1] * w4.y + hv[i * 4 + 2] * w4.z + hv[i * 4 + 3] * w4.w;
          if ((e & 3) == 3) __builtin_amdgcn_sched_barrier(0);
        }
      }
      float mx = -1e30f;
#pragma unroll
      for (int e = 0; e < 16; ++e) { lg[e] = wave_sum(lg[e]); mx = fmaxf(mx, lg[e]); }
      float sum = 0.f, mine = 0.f;
#pragma unroll
      for (int e = 0; e < 16; ++e) { float ex = __expf(lg[e] - mx); sum += ex; if (lane == e) mine = ex; }
      if (lane < 16) {
        const int smp = isctx ? 2 + b : b, n = isctx ? p - T : p;
        ((float*)(P.ws + oq(O_AFF)))[((size_t)smp * NE + lane) * T + n] = mine / sum;
      }
    }
  }
  __syncthreads();
}

template <int G>
DI void epi_rms(const float* Tt, const float* __restrict__ gain, bool rope, const float* __restrict__ ropetab,
                float scale, bf16_t* __restrict__ dst, int dcol0, int r0) {
  constexpr int NG = 128 / G;
  for (int it = TIDX; it < 128 * NG; it += 256) {
    const int row = it / NG, grp = it % NG;
    const float* tp = Tt + row * 132 + grp * G;
    float ss = 0.f;
#pragma unroll
    for (int d = 0; d < G; d += 4) {
      float4 q = *(const float4*)(tp + d);
      ss += q.x * q.x + q.y * q.y + q.z * q.z + q.w * q.w;
    }
    const float rstd = rsqrtf(ss * (1.f / G) + EPS);
    const float* gp = gain;
    asm volatile("" : "+s"(gp));
    int b, p; row_info(r0 + row, b, p);
    const bool dorope = (G == 32) && rope && (p < T);
    uint4* dp = (uint4*)(dst + (size_t)(r0 + row) * 256 + dcol0 + grp * G);
#pragma unroll 1
    for (int sub = 0; sub < G / 16; ++sub) {
      float v[16];
#pragma unroll
      for (int d = 0; d < 16; d += 4) {
        float4 q = *(const float4*)(tp + sub * 16 + d);
        float4 g4 = *(const float4*)(gp + sub * 16 + d);
        v[d] = q.x * rstd * g4.x; v[d + 1] = q.y * rstd * g4.y; v[d + 2] = q.z * rstd * g4.z; v[d + 3] = q.w * rstd * g4.w;
      }
      if (dorope) {
        const int pos = sub ? (p & 63) : (p >> 6);
#pragma unroll
        for (int i = 0; i < 8; ++i) {
          const float2 cssn = *(const float2*)(ropetab + (pos * 8 + i) * 2);
          const float x1 = v[i], x2 = v[8 + i];
          v[i] = x1 * cssn.x - x2 * cssn.y;
          v[8 + i] = x1 * cssn.y + x2 * cssn.x;
        }
      }
      dp[sub * 2] = make_uint4(pack2(v[0] * scale, v[1] * scale), pack2(v[2] * scale, v[3] * scale),
                               pack2(v[4] * scale, v[5] * scale), pack2(v[6] * scale, v[7] * scale));
      dp[sub * 2 + 1] = make_uint4(pack2(v[8] * scale, v[9] * scale), pack2(v[10] * scale, v[11] * scale),
                                   pack2(v[12] * scale, v[13] * scale), pack2(v[14] * scale, v[15] * scale));
    }
  }
}
DI void epi_plain(const float* Tt, bf16_t* __restrict__ dst, int dcol0, int r0) {
  const int row = TIDX >> 1, c0 = (TIDX & 1) * 64;
  uint4* dp = (uint4*)(dst + (size_t)(r0 + row) * 256 + dcol0 + c0);
#pragma unroll
  for (int d = 0; d < 64; d += 8) {
    float4 a = *(const float4*)(Tt + row * 132 + c0 + d), b = *(const float4*)(Tt + row * 132 + c0 + d + 4);
    dp[d >> 3] = make_uint4(pack2(a.x, a.y), pack2(a.z, a.w), pack2(b.x, b.y), pack2(b.z, b.w));
  }
}
DI void epi_transposed(const float* Tt, bf16_t* __restrict__ vt, int hd0, int bb, int p0) {
  const int c = TIDX >> 1, half = TIDX & 1;
  const int hd = hd0 + c;
  uint4* dp = (uint4*)(vt + ((size_t)bb * 256 + hd) * PB + p0 + half * 64);
#pragma unroll
  for (int q = 0; q < 8; ++q) {
    float f[8];
#pragma unroll
    for (int j = 0; j < 8; ++j) {
      const int tk = (q >> 1) * 16 + ((q & 1) ? (j < 4 ? j + 4 : j + 8) : (j < 4 ? j : j + 4));
      f[j] = Tt[(half * 64 + tk) * 132 + c];
    }
    dp[q] = make_uint4(pack2(f[0], f[1]), pack2(f[2], f[3]), pack2(f[4], f[5]), pack2(f[6], f[7]));
  }
}

DI void inproj_tile(const Params& P, int l, int mt, int nt, char* smem) {
  char* ws = P.ws;
  const int r0 = mt * 128;
  f32x16 acc[2][4];
  zero_acc8(acc);
  PlainRows ar{(const bf16_t*)(ws + oq(O_H)) + (size_t)r0 * D, D};
  gemm_main2(ar, (const bf16_t*)(ws + smallw(l) + oq(O_WT_IN)) + (size_t)nt * 256 * D, D, D, smem, acc);
  const int tid = TIDX, lane = tid & 63, w = tid >> 6, wm = w >> 1, wn = w & 1, r = lane & 31, hh = lane >> 5;
  if (nt >= 4 && nt < 20) {
    bf16_t* gates = (bf16_t*)(ws + oq(O_GATES));
#pragma unroll
    for (int mb = 0; mb < 2; ++mb)
#pragma unroll
      for (int nb2 = 0; nb2 < 4; ++nb2) {
        const int mt32 = mt * 4 + wm * 2 + mb, nt32 = (nt - 4) * 8 + wn * 4 + nb2;
        float sg[16];
#pragma unroll
        for (int i = 0; i < 16; ++i) sg[i] = 1.f / (1.f + __expf(-acc[mb][nb2][i]));
        uint4* gp = (uint4*)(gates + (((size_t)mt32 * 128 + nt32) * 64 + lane) * 16);
        gp[0] = make_uint4(pack2(sg[0], sg[1]), pack2(sg[2], sg[3]), pack2(sg[4], sg[5]), pack2(sg[6], sg[7]));
        gp[1] = make_uint4(pack2(sg[8], sg[9]), pack2(sg[10], sg[11]), pack2(sg[12], sg[13]), pack2(sg[14], sg[15]));
      }
    return;
  }
  float* Tt = (float*)smem;
  bf16_t* qpf = (bf16_t*)(ws + oq(O_QPF));
  bf16_t* kv = (bf16_t*)(ws + oq(O_KV));
  const float* ropetab = (const float*)(ws + oq(O_ROPE));
  const size_t S = (size_t)R * 256;
  int bb, p0; row_info(r0, bb, p0);
#pragma unroll 1
  for (int half = 0; half < 2; ++half) {
    if (wn == half) {
#pragma unroll
      for (int mb = 0; mb < 2; ++mb)
#pragma unroll
        for (int nb2 = 0; nb2 < 4; ++nb2)
#pragma unroll
          for (int i = 0; i < 16; ++i) {
            const int m = wm * 64 + mb * 32 + crow(i, hh), n = nb2 * 32 + r;
            Tt[m * 132 + n] = acc[mb][nb2][i];
          }
    }
    __syncthreads();
    const int dc = half * 128;
    if (nt == 0) epi_rms<64>(Tt, P.na_q_g + l * 64, false, ropetab, 0.125f * LOG2E, qpf, dc, r0);
    else if (nt == 1) epi_rms<32>(Tt, P.df_q_g + l * 32, true, ropetab, 0.17677669529663687f * LOG2E, qpf + S, dc, r0);
    else if (nt == 2) epi_plain(Tt, qpf + 2 * S, dc, r0);
    else if (nt == 3) epi_plain(Tt, qpf + 3 * S, dc, r0);
    else if (nt == 20) epi_rms<64>(Tt, P.na_k_g + l * 64, false, ropetab, 1.f, kv, dc, r0);
    else if (nt == 21) epi_transposed(Tt, kv + 2 * S, dc, bb, p0);
    else if (nt == 22) epi_rms<32>(Tt, P.df_k_g + l * 32, true, ropetab, 1.f, kv + S, dc, r0);
    else epi_transposed(Tt, kv + 3 * S, dc, bb, p0);
    __syncthreads();
  }
}

DI void diffattn_task(const Params& P, int l, int b, int hd, int q0, int key_lo, int nkeys, char* smem) {
  char* ws = P.ws;
  const int tid = TIDX, lane = tid & 63, w = tid >> 6, r = lane & 31, hh = lane >> 5;
  const bf16_t* qd = (const bf16_t*)(ws + oq(O_QPF)) + (size_t)R * 256;
  const bf16_t* kd = (const bf16_t*)(ws + oq(O_KV)) + (size_t)R * 256;
  const bf16_t* vt = (const bf16_t*)(ws + oq(O_KV)) + (size_t)3 * R * 256;
  bf16_t* yd = (bf16_t*)(ws + oq(O_Y)) + (size_t)R * 256;
  const float* cst = (const float*)(ws + oq(O_CONST)) + l * 8;
  const float lam = cst[0], lam_init = cst[1], negC = -cst[2];
  const int qrow = b * PB + q0 + w * 32 + r;
  bf16x8 qf[2][2];
#pragma unroll
  for (int m = 0; m < 2; ++m)
#pragma unroll
    for (int ks = 0; ks < 2; ++ks)
      qf[m][ks] = *(const bf16x8*)(qd + (size_t)qrow * 256 + hd * 64 + m * 32 + ks * 16 + hh * 8);
  f32x16 O[2][2];
  O[0][0] = O[0][1] = O[1][0] = O[1][1] = fzero();
  float ls0 = 0.f, ls1 = 0.f;
  constexpr int KT = 64 * LROW * 2;
  const bf16_t* kbase = kd + ((size_t)b * PB + key_lo) * 256 + hd * 64;
  const bf16_t* vbase = vt + ((size_t)(b * 4 + hd) * 64) * PB + key_lo;
  const int c0 = tid, c1 = tid + 256;
  u32x4 rk0, rk1, rv0, rv1;
#define DA_LOAD(t)                                                                       \
  {                                                                                      \
    rk0 = *(const u32x4*)(kbase + ((size_t)((t) * 64 + (c0 >> 3))) * 256 + (c0 & 7) * 8); \
    rk1 = *(const u32x4*)(kbase + ((size_t)((t) * 64 + (c1 >> 3))) * 256 + (c1 & 7) * 8); \
    rv0 = *(const u32x4*)(vbase + (size_t)(c0 >> 3) * PB + (t) * 64 + (c0 & 7) * 8);      \
    rv1 = *(const u32x4*)(vbase + (size_t)(c1 >> 3) * PB + (t) * 64 + (c1 & 7) * 8);      \
  }
#define DA_STORE(buf)                                                          \
  {                                                                            \
    char* kb_ = smem + (buf) * 2 * KT;                                         \
    *(u32x4*)(kb_ + ((c0 >> 3) * LROW + (c0 & 7) * 8) * 2) = rk0;              \
    *(u32x4*)(kb_ + ((c1 >> 3) * LROW + (c1 & 7) * 8) * 2) = rk1;              \
    *(u32x4*)(kb_ + KT + ((c0 >> 3) * LROW + (c0 & 7) * 8) * 2) = rv0;         \
    *(u32x4*)(kb_ + KT + ((c1 >> 3) * LROW + (c1 & 7) * 8) * 2) = rv1;         \
  }
  const int nt = nkeys >> 6;
  DA_LOAD(0);
  DA_STORE(0);
  if (nt > 1) DA_LOAD(1);
  for (int t = 0; t < nt; ++t) {
    __syncthreads();
    if (t + 1 < nt) {
      DA_STORE((t + 1) & 1);
      if (t + 2 < nt) DA_LOAD(t + 2);
    }
    const char* Ks = smem + (t & 1) * 2 * KT;
    const char* Vs = Ks + KT;
#pragma unroll 1
    for (int kb = 0; kb < 2; ++kb) {
      f32x16 S0, S1;
#pragma unroll
      for (int i = 0; i < 16; ++i) { S0[i] = negC; S1[i] = negC; }
#pragma unroll
      for (int ks = 0; ks < 2; ++ks) {
        bf16x8 k0 = *(const bf16x8*)(Ks + ((kb * 32 + r) * LROW + ks * 16 + hh * 8) * 2);
        bf16x8 k1 = *(const bf16x8*)(Ks + ((kb * 32 + r) * LROW + 32 + ks * 16 + hh * 8) * 2);
        S0 = MFMA32(k0, qf[0][ks], S0);
        S1 = MFMA32(k1, qf[1][ks], S1);
      }
#pragma unroll
      for (int i = 0; i < 16; ++i) {
        S0[i] = __builtin_amdgcn_exp2f(S0[i]); ls0 += S0[i];
        S1[i] = __builtin_amdgcn_exp2f(S1[i]); ls1 += S1[i];
      }
#pragma unroll
      for (int s = 0; s < 2; ++s) {
        bf16x8 p0 = pack8(S0[8 * s], S0[8 * s + 1], S0[8 * s + 2], S0[8 * s + 3], S0[8 * s + 4], S0[8 * s + 5], S0[8 * s + 6], S0[8 * s + 7]);
        bf16x8 p1 = pack8(S1[8 * s], S1[8 * s + 1], S1[8 * s + 2], S1[8 * s + 3], S1[8 * s + 4], S1[8 * s + 5], S1[8 * s + 6], S1[8 * s + 7]);
#pragma unroll
        for (int vb = 0; vb < 2; ++vb) {
          const bf16x8 vf = *(const bf16x8*)(Vs + ((vb * 32 + r) * LROW + kb * 32 + 16 * s + 8 * hh) * 2);
          O[0][vb] = MFMA32(vf, p0, O[0][vb]);
          O[1][vb] = MFMA32(vf, p1, O[1][vb]);
        }
      }
    }
  }
  __syncthreads();
#undef DA_LOAD
#undef DA_STORE
  ls0 += __shfl_xor(ls0, 32, 64);
  ls1 += __shfl_xor(ls1, 32, 64);
  const float i0 = 1.f / ls0, i1 = lam / ls1;
  float ssq = 0.f;
#pragma unroll
  for (int vb = 0; vb < 2; ++vb)
#pragma unroll
    for (int i = 0; i < 16; ++i) {
      float o = O[0][vb][i] * i0 - O[1][vb][i] * i1;
      O[0][vb][i] = o;
      ssq += o * o;
    }
  ssq += __shfl_xor(ssq, 32, 64);
  const float rstd = rsqrtf(ssq * (1.f / 64.f) + EPS) * (1.f - lam_init);
  const float* sg = P.df_subln_g + l * 64;
#pragma unroll
  for (int vb = 0; vb < 2; ++vb)
#pragma unroll
    for (int g4 = 0; g4 < 4; ++g4) {
      const int vd = vb * 32 + 8 * g4 + 4 * hh;
      float o0 = O[0][vb][4 * g4] * rstd * sg[vd], o1 = O[0][vb][4 * g4 + 1] * rstd * sg[vd + 1];
      float o2 = O[0][vb][4 * g4 + 2] * rstd * sg[vd + 2], o3 = O[0][vb][4 * g4 + 3] * rstd * sg[vd + 3];
      uint2 pk = {pack2(o0, o1), pack2(o2, o3)};
      *(uint2*)(yd + (size_t)qrow * 256 + hd * 64 + vd) = pk;
    }
}

DI void na_task(const Params& P, int l, int b, bool ctxq, int rr, int qsel, char* smem) {
  char* ws = P.ws;
  const int tid = TIDX, lane = tid & 63, hd = tid >> 6, r = lane & 31, hh = lane >> 5;
  float* rp = (float*)smem;
  if (!ctxq) {
    for (int i = tid; i < 4 * 15 * 31; i += 256) rp[i] = P.na_rpb[(size_t)l * 4 * 15 * 31 + i] * LOG2E;
  }
  __syncthreads();
  const bf16_t* qn = (const bf16_t*)(ws + oq(O_QPF));
  const bf16_t* kn = (const bf16_t*)(ws + oq(O_KV));
  const bf16_t* vt = (const bf16_t*)(ws + oq(O_KV)) + (size_t)2 * R * 256;
  bf16_t* yn = (bf16_t*)(ws + oq(O_Y));
  const float negC = -((const float*)(ws + oq(O_CONST)))[l * 8 + 3];
  int cq[2], qrow[2], cs[2];
  bf16x8 qf[2][4];
  f32x16 O[2][2];
  float ls[2];
#pragma unroll
  for (int a = 0; a < 2; ++a) {
    cq[a] = (qsel + a) * 32 + r;
    const int qp = ctxq ? T + cq[a] : rr * 64 + cq[a];
    qrow[a] = b * PB + qp;
    cs[a] = min(max(cq[a] - 8, 0), 48);
#pragma unroll
    for (int ks = 0; ks < 4; ++ks) qf[a][ks] = *(const bf16x8*)(qn + (size_t)qrow[a] * 256 + hd * 64 + ks * 16 + hh * 8);
    O[a][0] = O[a][1] = fzero();
    ls[a] = 0.f;
  }
  const int rs = min(max(rr - 4, 0), 248);
  const int nblk = ctxq ? 8 : 24;
  const bf16_t* vtb = vt + ((size_t)(b * 4 + hd) * 64) * PB;
  for (int kbi = 0; kbi < nblk; ++kbi) {
    const bool loc = !ctxq && kbi < 16;
    const int ir = kbi >> 1, kb = kbi & 1;
    const int pk0 = loc ? (rs + ir) * 64 + kb * 32 : T + (kbi - (ctxq ? 0 : 16)) * 32;
    const bf16_t* kp = kn + ((size_t)b * PB + pk0 + r) * 256 + hd * 64 + hh * 8;
    bf16x8 kf[4];
#pragma unroll
    for (int ks = 0; ks < 4; ++ks) kf[ks] = *(const bf16x8*)(kp + ks * 16);
    bf16x8 vf[2][2];
#pragma unroll
    for (int s = 0; s < 2; ++s)
#pragma unroll
      for (int vb = 0; vb < 2; ++vb) vf[s][vb] = *(const bf16x8*)(vtb + (size_t)(vb * 32 + r) * PB + pk0 + 16 * s + 8 * hh);
    const float* rpr = rp + (hd * 15 + (rs + ir - rr + 7)) * 31;
#pragma unroll
    for (int a = 0; a < 2; ++a) {
      f32x16 S;
#pragma unroll
      for (int i = 0; i < 16; ++i) S[i] = negC;
#pragma unroll
      for (int ks = 0; ks < 4; ++ks) S = MFMA32(kf[ks], qf[a][ks], S);
      if (loc) {
#pragma unroll
        for (int i = 0; i < 16; ++i) {
          const int kc = kb * 32 + crow(i, hh);
          const bool valid = (kc >= cs[a]) && (kc < cs[a] + 16);
          const int ci = min(max(kc - cq[a] + 15, 0), 30);
          const float pv = __builtin_amdgcn_exp2f(S[i] + rpr[ci]);
          S[i] = valid ? pv : 0.f;
          ls[a] += S[i];
        }
      } else {
#pragma unroll
        for (int i = 0; i < 16; ++i) { S[i] = __builtin_amdgcn_exp2f(S[i]); ls[a] += S[i]; }
      }
#pragma unroll
      for (int s = 0; s < 2; ++s) {
        bf16x8 pf = pack8(S[8 * s], S[8 * s + 1], S[8 * s + 2], S[8 * s + 3], S[8 * s + 4], S[8 * s + 5], S[8 * s + 6], S[8 * s + 7]);
#pragma unroll
        for (int vb = 0; vb < 2; ++vb) O[a][vb] = MFMA32(vf[s][vb], pf, O[a][vb]);
      }
    }
  }
#pragma unroll
  for (int a = 0; a < 2; ++a) {
    float lsa = ls[a];
    lsa += __shfl_xor(lsa, 32, 64);
    const float inv = 1.f / lsa;
#pragma unroll
    for (int vb = 0; vb < 2; ++vb)
#pragma unroll
      for (int g4 = 0; g4 < 4; ++g4) {
        const int vd = vb * 32 + 8 * g4 + 4 * hh;
        uint2 pk = {pack2(O[a][vb][4 * g4] * inv, O[a][vb][4 * g4 + 1] * inv), pack2(O[a][vb][4 * g4 + 2] * inv, O[a][vb][4 * g4 + 3] * inv)};
        *(uint2*)(yn + (size_t)qrow[a] * 256 + hd * 64 + vd) = pk;
      }
  }
  __syncthreads();
}

DI void pool_task(const Params& P, int l, int tile, char* smem) {
  char* ws = P.ws;
  const int tid = TIDX;
  const int r0 = tile * 32;
  int b, p0; row_info(r0, b, p0);
  const bool isctx = p0 >= T;
  const int seq0 = isctx ? T : 0, N = isctx ? CTXL : T;
  const int t0 = p0 - seq0;
  const bf16_t* pin = (const bf16_t*)(ws + oq(O_QPF)) + (size_t)2 * R * 256;
  bf16_t* yp = (bf16_t*)(ws + oq(O_Y)) + (size_t)2 * R * 256;
  bf16_t* us = (bf16_t*)smem;
  float* ds = (float*)(smem + 48 * 256 * 2);
  for (int i = tid; i < 48 * 32; i += 256) {
    const int rowi = i >> 5, ch = (i & 31) * 8;
    const int tk = t0 - 8 + rowi;
    uint4 v = make_uint4(0, 0, 0, 0);
    if (tk >= 0 && tk < N) v = *(const uint4*)(pin + ((size_t)b * PB + seq0 + tk) * 256 + ch);
    *(uint4*)(us + rowi * 256 + ch) = v;
  }
  __syncthreads();
  {
    const int ch = tid, gi = ch >> 6, wv = 2 << gi;
    for (int t = 0; t < 32; ++t) {
      const int tk = t0 + t;
      const int lo = max(tk - wv / 2, 0), hi = min(tk + wv / 2, N);
      float s = 0.f;
      for (int q = lo; q < hi; ++q) s += bf2f(us[(q - t0 + 8) * 256 + ch]);
      ds[t * 256 + ch] = s / (float)(hi - lo) - bf2f(us[(t + 8) * 256 + ch]);
    }
  }
  __syncthreads();
  {
    const int o = tid, gi = o >> 6;
    const float* wp = P.pool_w + ((size_t)l * 4 + gi) * 64 * 64 + (o & 63);
    float acc[32];
#pragma unroll
    for (int t = 0; t < 32; ++t) acc[t] = 0.f;
    for (int k = 0; k < 64; ++k) {
      const float wv = wp[k * 64];
#pragma unroll
      for (int t = 0; t < 32; ++t) acc[t] += ds[t * 256 + gi * 64 + k] * wv;
    }
    const float sc = P.pool_scale[l * 256 + o];
#pragma unroll
    for (int t = 0; t < 32; ++t) yp[(size_t)(r0 + t) * 256 + o] = f2bf(acc[t] * sc);
  }
  __syncthreads();
}

struct StridedRows {
  const bf16_t* base; long ld;
  DI const bf16_t* operator()(int m) const { return base + (long)m * ld; }
};
DI void fft_stage0_lat(const Params& P, int task, char* smem) {
  char* ws = P.ws;
  const int ntile = task & 3, n2 = (task >> 2) & 127, b = task >> 9;
  const bf16_t* fin = (const bf16_t*)(ws + oq(O_QPF)) + (size_t)3 * R * 256;
  f32x16 acc[2][2];
  acc[0][0] = acc[0][1] = acc[1][0] = acc[1][1] = fzero();
  StridedRows ar{fin + ((size_t)b * PB + n2) * 256, 128 * 256};
  gemm_main(ar, (const bf16_t*)(ws + oq(O_WC)) + (size_t)ntile * 128 * 256, 256, 256, smem, acc);
  bf16_t* Z1 = (bf16_t*)(ws + oq(O_Z1));
  const int lane = TIDX & 63, w = TIDX >> 6, wm = w >> 1, wn = w & 1, r = lane & 31, hh = lane >> 5;
#pragma unroll
  for (int mb = 0; mb < 2; ++mb)
#pragma unroll
    for (int nb2 = 0; nb2 < 2; ++nb2) {
      const int jj = ntile * 128 + wn * 64 + nb2 * 32 + r, part = jj >> 8, j = jj & 255;
#pragma unroll
      for (int g4 = 0; g4 < 4; ++g4) {
        const int n1 = wm * 64 + mb * 32 + 8 * g4 + 4 * hh;
        uint2 pk = {pack2(acc[mb][nb2][4 * g4], acc[mb][nb2][4 * g4 + 1]), pack2(acc[mb][nb2][4 * g4 + 2], acc[mb][nb2][4 * g4 + 3])};
        *(uint2*)(Z1 + (((size_t)(b * 128 + n2) * 256 + j) * 256 + part * 128 + n1)) = pk;
      }
    }
}
DI void fft_stage0_ctx(const Params& P, int task, char* smem) {
  char* ws = P.ws;
  const int ntile = task & 3, mtile = (task >> 2) & 1, b = task >> 3;
  const bf16_t* fin = (const bf16_t*)(ws + oq(O_QPF)) + (size_t)3 * R * 256;
  f32x16 acc[2][2];
  acc[0][0] = acc[0][1] = acc[1][0] = acc[1][1] = fzero();
  PlainRows ar{fin + ((size_t)b * PB + T + mtile * 128) * 256, 256};
  gemm_main(ar, (const bf16_t*)(ws + oq(O_WC)) + (size_t)ntile * 128 * 256, 256, 256, smem, acc);
  bf16_t* Z1c = (bf16_t*)(ws + oq(O_Z1C));
  const int lane = TIDX & 63, w = TIDX >> 6, wm = w >> 1, wn = w & 1, r = lane & 31, hh = lane >> 5;
#pragma unroll
  for (int mb = 0; mb < 2; ++mb)
#pragma unroll
    for (int nb2 = 0; nb2 < 2; ++nb2) {
      const int jj = ntile * 128 + wn * 64 + nb2 * 32 + r, part = jj >> 8, j = jj & 255;
#pragma unroll
      for (int g4 = 0; g4 < 4; ++g4) {
        const int n = mtile * 128 + wm * 64 + mb * 32 + 8 * g4 + 4 * hh;
        uint2 pk = {pack2(acc[mb][nb2][4 * g4], acc[mb][nb2][4 * g4 + 1]), pack2(acc[mb][nb2][4 * g4 + 2], acc[mb][nb2][4 * g4 + 3])};
        *(uint2*)(Z1c + (((size_t)(b * 256 + j)) * 512 + part * 256 + n)) = pk;
      }
    }
}
DI void fft_stage1_lat(const Params& P, int task, char* smem) {
  char* ws = P.ws;
  const int ntile = task & 1, j = (task >> 1) & 255, b = task >> 9;
  f32x16 acc[2][2];
  acc[0][0] = acc[0][1] = acc[1][0] = acc[1][1] = fzero();
  StridedRows ar{(const bf16_t*)(ws + oq(O_Z1)) + ((size_t)(b * 128) * 256 + j) * 256, 256 * 256};
  gemm_main(ar, (const bf16_t*)(ws + oq(O_D1)) + (size_t)ntile * 128 * 256, 256, 256, smem, acc);
  bf16_t* Z2 = (bf16_t*)(ws + oq(O_Z2));
  const int lane = TIDX & 63, w = TIDX >> 6, wm = w >> 1, wn = w & 1, r = lane & 31, hh = lane >> 5;
  const int k1 = (ntile * 2 + wn) * 32 + r;
#pragma unroll
  for (int mb = 0; mb < 2; ++mb)
#pragma unroll
    for (int g4 = 0; g4 < 4; ++g4) {
      const int n2 = wm * 64 + mb * 32 + 8 * g4 + 4 * hh;
      float yr[4], yi[4];
#pragma unroll
      for (int q = 0; q < 4; ++q) {
        const float re = acc[mb][0][4 * g4 + q], im = acc[mb][1][4 * g4 + q];
        float sn, cs; sincospif(2.f * (float)((k1 * (n2 + q)) & 16383) / 16384.f, &sn, &cs);
        yr[q] = re * cs + im * sn;
        yi[q] = im * cs - re * sn;
      }
      bf16_t* zp = Z2 + (((size_t)(b * 128 + k1) * 256 + j) * 256 + n2);
      uint2 pr = {pack2(yr[0], yr[1]), pack2(yr[2], yr[3])}, pi = {pack2(yi[0], yi[1]), pack2(yi[2], yi[3])};
      *(uint2*)zp = pr;
      *(uint2*)(zp + 128) = pi;
    }
}
DI void fft_stage1_ctx(const Params& P, int task, char* smem) {
  char* ws = P.ws;
  const int ntile = task & 1, mtile = (task >> 1) & 1, b = task >> 2;
  f32x16 acc[2][2];
  acc[0][0] = acc[0][1] = acc[1][0] = acc[1][1] = fzero();
  PlainRows ar{(const bf16_t*)(ws + oq(O_Z1C)) + ((size_t)(b * 256 + mtile * 128)) * 512, 512};
  gemm_main(ar, (const bf16_t*)(ws + oq(O_DC)) + (size_t)ntile * 128 * 512, 512, 512, smem, acc);
  bf16_t* f = (bf16_t*)(ws + oq(O_QPF)) + (size_t)3 * R * 256;
  const int lane = TIDX & 63, w = TIDX >> 6, wm = w >> 1, wn = w & 1, r = lane & 31, hh = lane >> 5;
#pragma unroll
  for (int mb = 0; mb < 2; ++mb)
#pragma unroll
    for (int nb2 = 0; nb2 < 2; ++nb2) {
      const int k = ntile * 128 + wn * 64 + nb2 * 32 + r;
#pragma unroll
      for (int g4 = 0; g4 < 4; ++g4) {
        const int j = mtile * 128 + wm * 64 + mb * 32 + 8 * g4 + 4 * hh;
        const float sc = 1.f / 256.f;
        uint2 pk = {pack2(acc[mb][nb2][4 * g4] * sc, acc[mb][nb2][4 * g4 + 1] * sc),
                    pack2(acc[mb][nb2][4 * g4 + 2] * sc, acc[mb][nb2][4 * g4 + 3] * sc)};
        *(uint2*)(f + ((size_t)b * PB + T + k) * 256 + j) = pk;
      }
    }
}
DI void fft_stage2_lat(const Params& P, int task, char* smem) {
  char* ws = P.ws;
  const int jt = task & 1, k1 = (task >> 1) & 127, b = task >> 8;
  f32x16 acc[2][2];
  acc[0][0] = acc[0][1] = acc[1][0] = acc[1][1] = fzero();
  PlainRows ar{(const bf16_t*)(ws + oq(O_Z2)) + ((size_t)(b * 128 + k1) * 256 + jt * 128) * 256, 256};
  gemm_main(ar, (const bf16_t*)(ws + oq(O_D2)), 256, 256, smem, acc);
  bf16_t* f = (bf16_t*)(ws + oq(O_QPF)) + (size_t)3 * R * 256;
  const int lane = TIDX & 63, w = TIDX >> 6, wm = w >> 1, wn = w & 1, r = lane & 31, hh = lane >> 5;
#pragma unroll
  for (int mb = 0; mb < 2; ++mb)
#pragma unroll
    for (int nb2 = 0; nb2 < 2; ++nb2) {
      const int k2 = wn * 64 + nb2 * 32 + r;
#pragma unroll
      for (int g4 = 0; g4 < 4; ++g4) {
        const int j = jt * 128 + wm * 64 + mb * 32 + 8 * g4 + 4 * hh;
        const float sc = 1.f / 2048.f;
        uint2 pk = {pack2(acc[mb][nb2][4 * g4] * sc, acc[mb][nb2][4 * g4 + 1] * sc),
                    pack2(acc[mb][nb2][4 * g4 + 2] * sc, acc[mb][nb2][4 * g4 + 3] * sc)};
        *(uint2*)(f + ((size_t)b * PB + k1 + 128 * k2) * 256 + j) = pk;
      }
    }
}
DI void fnet_final_tile(const Params& P, int l, int mt, int nt, char* smem) {
  char* ws = P.ws;
  const int r0 = mt * 128;
  f32x16 acc[2][2];
  acc[0][0] = acc[0][1] = acc[1][0] = acc[1][1] = fzero();
  PlainRows ar{(const bf16_t*)(ws + oq(O_QPF)) + (size_t)3 * R * 256 + (size_t)r0 * 256, 256};
  gemm_main(ar, (const bf16_t*)(ws + smallw(l) + oq(O_WT_FN)) + (size_t)nt * 128 * 256, 256, 256, smem, acc);
  bf16_t* yf = (bf16_t*)(ws + oq(O_Y)) + (size_t)3 * R * 256;
  const int lane = TIDX & 63, w = TIDX >> 6, wm = w >> 1, wn = w & 1, r = lane & 31, hh = lane >> 5;
#pragma unroll
  for (int mb = 0; mb < 2; ++mb)
#pragma unroll
    for (int nb2 = 0; nb2 < 2; ++nb2)
#pragma unroll
      for (int i = 0; i < 16; ++i) {
        const int m = wm * 64 + mb * 32 + crow(i, hh), n = nt * 128 + wn * 64 + nb2 * 32 + r;
        yf[(size_t)(r0 + m) * 256 + n] = f2bf(acc[mb][nb2][i]);
      }
}

DI void merge_tile(const Params& P, int l, int mt, int nt, char* smem) {
  char* ws = P.ws;
  const int r0 = mt * 128;
  const int tid = TIDX, lane = tid & 63, w = tid >> 6, wm = w >> 1, wn = w & 1, r = lane & 31, hh = lane >> 5;
  const bf16_t* gates = (const bf16_t*)(ws + oq(O_GATES));
  f32x16 tot[2][2], acc[2][2];
  tot[0][0] = tot[0][1] = tot[1][0] = tot[1][1] = fzero();
  acc[0][0] = acc[0][1] = acc[1][0] = acc[1][1] = fzero();
  const int lrow = tid >> 3, lcc = (tid & 7) * 8;
  const bf16_t* pa0 = (const bf16_t*)(ws + oq(O_Y)) + (size_t)(r0 + lrow) * 256 + lcc;
  const bf16_t* pb0 = (const bf16_t*)(ws + smallw(l) + oq(O_WT_BR)) + (size_t)(nt * 128 + lrow) * 256 + lcc;
  constexpr long SA = (long)R * 256, SB = (long)D * 256;
  u32x4 ra0[4], rb0[4];
  u32x4 gq[2][2][2];
#define M_OFFA(kt) (((kt) >> 2) * SA + ((kt) & 3) * 64)
#define M_OFFB(kt) (((kt) >> 2) * SB + ((kt) & 3) * 64)
#define M_LOAD1(RA, RB, kt, i) RA[i] = *(const u32x4*)(pa0 + M_OFFA(kt) + i * 32 * 256); RB[i] = *(const u32x4*)(pb0 + M_OFFB(kt) + i * 32 * 256);
#define M_LOAD(RA, RB, kt) { M_LOAD1(RA, RB, kt, 0) M_LOAD1(RA, RB, kt, 1) M_LOAD1(RA, RB, kt, 2) M_LOAD1(RA, RB, kt, 3) }
#define M_STORE1(RA, RB, i) *(u32x4*)(base_ + ((lrow + 32 * i) * LROW + lcc) * 2) = RA[i]; *(u32x4*)(base_ + TILEB + ((lrow + 32 * i) * LROW + lcc) * 2) = RB[i];
#define M_STORE(RA, RB, buf) { char* base_ = smem + (buf) * 2 * TILEB; M_STORE1(RA, RB, 0) M_STORE1(RA, RB, 1) M_STORE1(RA, RB, 2) M_STORE1(RA, RB, 3) }
#define M_STEP(ks) { \
      bf16x8 a0 = *(const bf16x8*)(bA_ + ks * 32); \
      bf16x8 a1 = *(const bf16x8*)(bA_ + 32 * LROW * 2 + ks * 32); \
      bf16x8 b0 = *(const bf16x8*)(bB_ + ks * 32); \
      bf16x8 b1 = *(const bf16x8*)(bB_ + 32 * LROW * 2 + ks * 32); \
      acc[0][0] = MFMA32(a0, b0, acc[0][0]); \
      acc[0][1] = MFMA32(a0, b1, acc[0][1]); \
      acc[1][0] = MFMA32(a1, b0, acc[1][0]); \
      acc[1][1] = MFMA32(a1, b1, acc[1][1]); }
#define M_COMPUTE(buf) { \
    const char* bA_ = smem + (buf) * 2 * TILEB + ((wm * 64 + r) * LROW + hh * 8) * 2; \
    const char* bB_ = smem + (buf) * 2 * TILEB + TILEB + ((wn * 64 + r) * LROW + hh * 8) * 2; \
    M_STEP(0) M_STEP(1) M_STEP(2) M_STEP(3) }
#define M_GLOAD(i) { \
    _Pragma("unroll") for (int mb = 0; mb < 2; ++mb) \
      _Pragma("unroll") for (int nb2 = 0; nb2 < 2; ++nb2) { \
        const int mt32 = mt * 4 + wm * 2 + mb, nt32 = (i) * 32 + nt * 4 + wn * 2 + nb2; \
        const u32x4* gp = (const u32x4*)(gates + (((size_t)mt32 * 128 + nt32) * 64 + lane) * 16); \
        gq[mb][nb2][0] = gp[0]; gq[mb][nb2][1] = gp[1]; } }
#define M_APPLY() { \
    _Pragma("unroll") for (int mb = 0; mb < 2; ++mb) \
      _Pragma("unroll") for (int nb2 = 0; nb2 < 2; ++nb2) { \
        _Pragma("unroll") for (int q = 0; q < 16; ++q) { \
          const unsigned wv = gq[mb][nb2][q >> 3][(q >> 1) & 3]; \
          const float gv = __uint_as_float((q & 1) ? (wv & 0xffff0000u) : (wv << 16)); \
          tot[mb][nb2][q] += gv * acc[mb][nb2][q]; } \
        acc[mb][nb2] = fzero(); } }
  M_GLOAD(0);
  M_LOAD(ra0, rb0, 0);
  M_STORE(ra0, rb0, 0);
  M_LOAD(ra0, rb0, 1);
#pragma unroll 1
  for (int kt = 0; kt < 16; kt += 2) {
    __syncthreads();
    M_STORE(ra0, rb0, 1);
    if (kt + 2 < 16) M_LOAD(ra0, rb0, kt + 2);
    M_COMPUTE(0);
    __syncthreads();
    if (kt + 2 < 16) {
      M_STORE(ra0, rb0, 0);
      if (kt + 3 < 16) M_LOAD(ra0, rb0, kt + 3);
    }
    M_COMPUTE(1);
    if ((kt & 3) == 2) {
      M_APPLY();
      if (kt + 2 < 16) M_GLOAD((kt + 2) >> 2);
    }
  }
  __syncthreads();
#undef M_OFFA
#undef M_OFFB
#undef M_LOAD1
#undef M_LOAD
#undef M_STORE1
#undef M_STORE
#undef M_STEP
#undef M_COMPUTE
#undef M_GLOAD
#undef M_APPLY
  bf16_t* am = (bf16_t*)(ws + oq(O_ACCM));
#pragma unroll
  for (int mb = 0; mb < 2; ++mb)
#pragma unroll
    for (int nb2 = 0; nb2 < 2; ++nb2)
#pragma unroll
      for (int q = 0; q < 16; ++q) {
        const int m = wm * 64 + mb * 32 + crow(q, hh), n = nt * 128 + wn * 64 + nb2 * 32 + r;
        am[(size_t)(r0 + m) * D + n] = f2bf(tot[mb][nb2][q]);
      }
}
DI void outproj_tile(const Params& P, int l, int mt, int nt, char* smem) {
  char* ws = P.ws;
  const int r0 = mt * 128;
  f32x16 acc[2][4];
  zero_acc8(acc);
  PlainRows ar{(const bf16_t*)(ws + oq(O_ACCM)) + (size_t)r0 * D, D};
  gemm_main2(ar, (const bf16_t*)(ws + smallw(l) + oq(O_WT_OUT)) + (size_t)nt * 256 * D, D, D, smem, acc);
  const int lane = TIDX & 63, w = TIDX >> 6, wm = w >> 1, wn = w & 1, r = lane & 31, hh = lane >> 5;
  const int s = row_modsel(r0);
  const float* gt1 = (const float*)(ws + oq(O_MOD)) + ((size_t)l * 3 + s) * INC + 2 * D;
#pragma unroll
  for (int mb = 0; mb < 2; ++mb)
#pragma unroll
    for (int q = 0; q < 16; ++q) {
      const int m = wm * 64 + mb * 32 + crow(q, hh);
      const float* xi = (l == 0) ? x_in_row(P, r0 + m) : x_buf_row(P, r0 + m);
      float* xo = x_buf_row(P, r0 + m);
#pragma unroll
      for (int nb2 = 0; nb2 < 4; ++nb2) {
        const int n = nt * 256 + wn * 128 + nb2 * 32 + r;
        xo[n] = xi[n] + gt1[n] * acc[mb][nb2][q];
      }
    }
}

template <int NPT>
DI void topk_task(const Params& P, int smp, int e, char* smem) {
  char* ws = P.ws;
  constexpr int N = NPT * 256;
  constexpr int cap = N / 8;
  const int tid = TIDX, lane = tid & 63, w = tid >> 6;
  float* sv = (float*)smem;
  int* red = (int*)(smem + 65536);
  int* cg_ = (int*)(smem + 65536 + 64);
  int* ce_ = cg_ + 256;
  const float* aff = (const float*)(ws + oq(O_AFF)) + ((size_t)smp * NE + e) * T;
  for (int i = tid; i < N; i += 256) sv[i] = aff[i];
  __syncthreads();
  unsigned u[NPT];
#pragma unroll
  for (int j = 0; j < NPT; ++j) u[j] = __float_as_uint(sv[tid * NPT + j]);
  unsigned thr = 0;
  for (int bit = 30; bit >= 0; --bit) {
    const unsigned cand = thr | (1u << bit);
    int cnt = 0;
#pragma unroll
    for (int j = 0; j < NPT; ++j) cnt += (u[j] >= cand) ? 1 : 0;
#pragma unroll
    for (int o = 32; o >= 1; o >>= 1) cnt += __shfl_xor(cnt, o, 64);
    if (lane == 0) red[w] = cnt;
    __syncthreads();
    const int total = red[0] + red[1] + red[2] + red[3];
    __syncthreads();
    if (total >= cap) thr = cand;
  }
  int ng = 0, neq = 0;
#pragma unroll
  for (int j = 0; j < NPT; ++j) { ng += (u[j] > thr) ? 1 : 0; neq += (u[j] == thr) ? 1 : 0; }
  cg_[tid] = ng; ce_[tid] = neq;
  __syncthreads();
  int pg = 0, pe = 0, totg = 0;
  for (int i = 0; i < 256; ++i) {
    const int a = cg_[i], bq = ce_[i];
    if (i < tid) { pg += a; pe += bq; }
    totg += a;
  }
  const int need_eq = cap - totg;
  int* rows = (int*)(ws + oq(O_ROWS)) + (size_t)e * SLOTS;
  float* gl = (float*)(ws + oq(O_GL)) + (size_t)e * SLOTS;
  const int slot_base = smp < 2 ? smp * 2048 : 4096 + (smp - 2) * 32;
  const int row_base = smp < 2 ? smp * PB : (smp - 2) * PB + T;
#pragma unroll
  for (int j = 0; j < NPT; ++j) {
    const int idx = tid * NPT + j;
    int slot = -1;
    if (u[j] > thr) { slot = pg; ++pg; }
    else if (u[j] == thr) { if (pe < need_eq) slot = totg + pe; ++pe; }
    if (slot >= 0) { rows[slot_base + slot] = row_base + idx; gl[slot_base + slot] = __uint_as_float(u[j]); }
  }
  if (smp == 0 && tid < 64) rows[4160 + tid] = -1;
  __syncthreads();
}

struct GatherRows {
  const bf16_t* base; const int* rows;
  DI const bf16_t* operator()(int m) const { int rr = rows[m]; return base + (size_t)(rr < 0 ? 0 : rr) * D; }
};
DI void expert1_tile(const Params& P, int e, int mt, int nt, char* smem) {
  char* ws = P.ws;
  f32x16 acc[2][4];
  zero_acc8(acc);
  GatherRows ar{(const bf16_t*)(ws + oq(O_H)), (const int*)(ws + oq(O_ROWS)) + (size_t)e * SLOTS + mt * 128};
  gemm_main2(ar, (const bf16_t*)(ws + oq(O_WT_13)) + ((size_t)e * 2 * FF + nt * 256) * D, D, D, smem, acc);
  bf16_t* hid = (bf16_t*)(ws + oq(O_HID)) + ((size_t)e * SLOTS + mt * 128) * FF;
  const int lane = TIDX & 63, w = TIDX >> 6, wm = w >> 1, wn = w & 1, r = lane & 31, hh = lane >> 5;
#pragma unroll
  for (int pr = 0; pr < 2; ++pr) {
    const int f = nt * 128 + wn * 64 + pr * 32 + r;
#pragma unroll
    for (int mb = 0; mb < 2; ++mb)
#pragma unroll
      for (int q = 0; q < 16; ++q) {
        const int m = wm * 64 + mb * 32 + crow(q, hh);
        const float gv = acc[mb][2 * pr][q], uv = acc[mb][2 * pr + 1][q];
        hid[(size_t)m * FF + f] = f2bf(gv / (1.f + __expf(-gv)) * uv);
      }
  }
}
DI void expert2_tile(const Params& P, int l, int e, int mt, int nt, char* smem) {
  char* ws = P.ws;
  f32x16 acc[2][4];
  zero_acc8(acc);
  PlainRows ar{(const bf16_t*)(ws + oq(O_HID)) + ((size_t)e * SLOTS + mt * 128) * FF, FF};
  gemm_main2(ar, (const bf16_t*)(ws + oq(O_WT_2)) + ((size_t)e * D + nt * 256) * FF, FF, FF, smem, acc);
  const int* rows = (const int*)(ws + oq(O_ROWS)) + (size_t)e * SLOTS + mt * 128;
  const float* gl = (const float*)(ws + oq(O_GL)) + (size_t)e * SLOTS + mt * 128;
  const int lane = TIDX & 63, w = TIDX >> 6, wm = w >> 1, wn = w & 1, r = lane & 31, hh = lane >> 5;
#pragma unroll
  for (int mb = 0; mb < 2; ++mb)
#pragma unroll
    for (int q = 0; q < 16; ++q) {
      const int m = wm * 64 + mb * 32 + crow(q, hh);
      const int row = rows[m];
      if (row < 0) continue;
      const float gv = gl[m];
      const float* gt2 = (const float*)(ws + oq(O_MOD)) + ((size_t)l * 3 + row_modsel(row)) * INC + 5 * D;
      float* xo = x_buf_row(P, row);
#pragma unroll
      for (int nb2 = 0; nb2 < 4; ++nb2) {
        const int n = nt * 256 + wn * 128 + nb2 * 32 + r;
        unsafeAtomicAdd(xo + n, gt2[n] * gv * acc[mb][nb2][q]);
      }
    }
}

#define XB_TMO      128
#define XB_XCNT(j)  (256  + 64 * (j))
#define XB_XSUB(j)  (1280 + 64 * (j))
#define XB_XGEN(j)  (2304 + 64 * (j))
#define XB_TOP      3328
#define XB_TOPGEN   3392
#define XCD_BAR_WORDS 3456
#define XB_SPIN_CAP (1u << 18)
#define LAS __attribute__((address_space(3)))

__device__ __forceinline__ unsigned xb_ld(unsigned* p)              { return __hip_atomic_load(p, __ATOMIC_RELAXED, __HIP_MEMORY_SCOPE_AGENT); }
__device__ __forceinline__ unsigned xb_add(unsigned* p, unsigned v) { return __hip_atomic_fetch_add(p, v, __ATOMIC_RELAXED, __HIP_MEMORY_SCOPE_AGENT); }
__device__ __forceinline__ unsigned xb_xcc_id() { return (unsigned)__builtin_amdgcn_s_getreg((3 << 11) | 20) & 0xFu; }
#define XB_SPIN(cond, bar) do { unsigned _sp = 0; while (cond) { __builtin_amdgcn_s_sleep(1); \
    if ((++_sp & 255u) == 0u) { if (xb_ld(&(bar)[XB_TMO])) break; if (_sp > XB_SPIN_CAP) { atomicAdd(&(bar)[XB_TMO], 1u); break; } } } } while (0)

struct XcdBarrier {
    unsigned* bar; unsigned x;
    volatile LAS unsigned* st;
};

__device__ __forceinline__ XcdBarrier xcd_barrier_post(unsigned* bar, volatile LAS unsigned* st) {
    XcdBarrier b; b.bar = bar; b.x = xb_xcc_id(); b.st = st;
    if (threadIdx.x == 0) (void)xb_add(&bar[XB_XCNT(b.x)], 1u);
    return b;
}
__device__ __forceinline__ void xcd_barrier_complete(unsigned* bar, unsigned x, unsigned& nloc, unsigned& nx) {
    const unsigned G = gridDim.x * gridDim.y * gridDim.z;
    unsigned sum, cnt, mine, sp = 0u;
    for (;;) {
        sum = 0u; cnt = 0u; mine = 0u;
#pragma unroll
        for (unsigned j = 0; j < 16; ++j) { const unsigned c = xb_ld(&bar[XB_XCNT(j)]); sum += c; cnt += (c > 0u) ? 1u : 0u; mine = (j == x) ? c : mine; }
        if (sum == G) break;
        __builtin_amdgcn_s_sleep(1);
        if ((++sp & 255u) == 0u) { if (xb_ld(&bar[XB_TMO])) break; if (sp > XB_SPIN_CAP) { atomicAdd(&bar[XB_TMO], 1u); break; } }
    }
    nloc = mine > 0u ? mine : 1u; nx = cnt > 0u ? cnt : 1u;
}

__device__ __forceinline__ void xcd_barrier(const XcdBarrier& b) {
    asm volatile("s_waitcnt vmcnt(0)" ::: "memory");
    __syncthreads();
    if (threadIdx.x == 0) {
        unsigned* bar = b.bar;
        __builtin_amdgcn_s_waitcnt(0);
        unsigned nloc = b.st[0], nx = b.st[1];
        if (nloc == 0u) { xcd_barrier_complete(bar, b.x, nloc, nx); b.st[0] = nloc; b.st[1] = nx; }
        const unsigned old = xb_add(&bar[XB_XSUB(b.x)], 1u);
        const unsigned gen = old / nloc;
        if (old + 1u == (gen + 1u) * nloc) {
            __builtin_amdgcn_fence(__ATOMIC_RELEASE, "agent");
            asm volatile("s_waitcnt vmcnt(0)" ::: "memory");
            const unsigned og = xb_add(&bar[XB_TOP], 1u);
            const unsigned tg = og / nx;
            if (og + 1u == (tg + 1u) * nx) xb_add(&bar[XB_TOPGEN], 1u);
            else XB_SPIN(xb_ld(&bar[XB_TOPGEN]) == tg, bar);
            __builtin_amdgcn_fence(__ATOMIC_ACQUIRE, "agent");
            xb_add(&bar[XB_XGEN(b.x)], 1u);
            asm volatile("s_waitcnt vmcnt(0)" ::: "memory");
        } else {
            XB_SPIN(xb_ld(&bar[XB_XGEN(b.x)]) == gen, bar);
            __builtin_amdgcn_fence(__ATOMIC_ACQUIRE, "agent");
            asm volatile("s_waitcnt vmcnt(0)" ::: "memory");
        }
    }
    __syncthreads();
}


constexpr int NPL = 12;
constexpr int NPHASE = 1 + 2 * NPL;

DI void run_phase0(const Params& P, char* smem) {
  const int bid = opaque_bid(), nb = gridDim.x;
  {
    for (int t = bid; t < 192 + 64 + 2 * WT_SMALL; t += nb) {
      if (t < 192) ada_task(P, t, smem);
      else if (t < 256) tables_task(P, t - 192);
      else if (t < 256 + WT_SMALL) convert_weight_tile(P, 0, t - 256, smem);
      else convert_weight_tile(P, 1, t - 256 - WT_SMALL, smem);
    }
  }
}
template <int SP>
DI void run_sub(const Params& P, int l, char* smem) {
  const int bid = opaque_bid(), nb = gridDim.x;
  const bool last = l == 1;
  if constexpr (SP == 0) {
      modnorm_phase(P, l, false, bid, nb, smem);
  }
  if constexpr (SP == 1) {
      const int x = bid & 7, j = bid >> 3, nbx = nb >> 3;
      if (bid < nbx * 8)
        for (int lt = j; lt < 130 * 6; lt += nbx) {
          const int mt = (x >> 2) * 130 + lt / 6, nt = (x & 3) * 6 + lt % 6;
          if (last && (mt % 130) >= 128 && nt < 20) continue;
          inproj_tile(P, l, mt, nt, smem);
        }
  }
  if constexpr (SP == 2) {
      const bool conv_first = (bid >= (nb >> 1));
      if (conv_first)
        for (int t = bid - (nb >> 1); t < WT_TILES - WT_SMALL; t += nb) convert_weight_tile(P, l, WT_SMALL + t, smem);
      {
        const int x = bid & 7, j = bid >> 3, nbx = nb >> 3;
        if (bid < nbx * 8) {
          for (int q = j; q < 128; q += nbx) diffattn_task(P, l, x >> 2, x & 3, q * 128, 0, PB, smem);
          if (!last && j < 2) diffattn_task(P, l, x >> 2, x & 3, T + j * 128, T, CTXL, smem);
        }
      }
#ifndef PROBE_PART
#define PROBE_PART 0
#endif
#pragma unroll 1
      for (int rep = 0; rep < 1 + PROBE_PART; ++rep) {
      {
        const int x = bid & 7, j = bid >> 3, nbx = nb >> 3;
        if (bid < nbx * 8) {
          for (int q = j; q < 64; q += nbx) na_task(P, l, x >> 2, false, (x & 3) * 64 + q, 0, smem);
          if (!last && j == 0) na_task(P, l, x >> 2, true, 0, (x & 3) * 2, smem);
        }
      }
      for (int tile = bid; tile < 1040; tile += nb) {
        const bool isctx = (tile % 520) >= 512;
        if (!(last && isctx)) pool_task(P, l, tile, smem);
      }
      for (int t = bid; t < 1024; t += nb) fft_stage0_lat(P, t, smem);
      if (!last) for (int t = bid; t < 16; t += nb) fft_stage0_ctx(P, t, smem);      }
      if (!conv_first)
        for (int t = bid + (nb >> 1); t < WT_TILES - WT_SMALL; t += nb) convert_weight_tile(P, l, WT_SMALL + t, smem);

  }
  if constexpr (SP == 3) {
      const int n = 1024 + (last ? 0 : 8);
      for (int t = bid; t < n; t += nb) { if (t < 1024) fft_stage1_lat(P, t, smem); else fft_stage1_ctx(P, t - 1024, smem); }
  }
  if constexpr (SP == 4) {
      for (int t = bid; t < 512; t += nb) fft_stage2_lat(P, t, smem);
  }
  if constexpr (SP == 5) {
      for (int t = bid; t < 520; t += nb) { const int mt = t >> 1; if (last && (mt % 130) >= 128) continue; fnet_final_tile(P, l, mt, t & 1, smem); }
  }
  if constexpr (SP == 6) {
      const int x = bid & 7, j = bid >> 3, nbx = nb >> 3;
      if (bid < nbx * 8)
        for (int lt = j; lt < 33 * 8; lt += nbx) {
          const int mt = x + 8 * (lt >> 3);
          if (mt >= 260 || (last && (mt % 130) >= 128)) continue;
          merge_tile(P, l, mt, lt & 7, smem);
        }
  }
  if constexpr (SP == 7) {
      const int x = bid & 7, j = bid >> 3, nbx = nb >> 3;
      if (bid < nbx * 8)
        for (int lt = j; lt < 33 * 4; lt += nbx) {
          const int mt = x + 8 * (lt >> 2);
          if (mt >= 260 || (last && (mt % 130) >= 128)) continue;
          outproj_tile(P, l, mt, lt & 3, smem);
        }
  }
  if constexpr (SP == 8) { modnorm_phase(P, l, true, bid, nb, smem); }
  if constexpr (SP == 9) {
      const int n = last ? 32 : 64;
      for (int t = bid; t < n; t += nb) {
        const int smp = t >> 4, e = t & 15;
        if (smp < 2) topk_task<64>(P, smp, e, smem); else topk_task<1>(P, smp, e, smem);
      }
  }
  if constexpr (SP == 10) {
      const int nmt = last ? 32 : 33;
      const int x = bid & 7, j = bid >> 3, nbx = nb >> 3, npairs = NE * nmt;
      if (bid < nbx * 8)
        for (int lt = j; lt < ((npairs + 7) >> 3) * 11; lt += nbx) {
          const int p = x + 8 * (lt / 11);
          if (p >= npairs) continue;
          expert1_tile(P, p / nmt, p % nmt, lt % 11, smem);
        }
  }
  if constexpr (SP == 11) {
      const int nmt = last ? 32 : 33;
      const int x = bid & 7, j = bid >> 3, nbx = nb >> 3, npairs = NE * nmt;
      if (bid < nbx * 8)
        for (int lt = j; lt < ((npairs + 7) >> 3) * 4; lt += nbx) {
          const int p = x + 8 * (lt >> 2);
          if (p >= npairs) continue;
          expert2_tile(P, l, p / nmt, p % nmt, lt & 3, smem);
        }
  }
}

__shared__ __attribute__((aligned(16))) char g_smem[SMEM_BYTES];

#if ONE_LAUNCH
#ifndef PROBE_DUP
#define PROBE_DUP -1
#endif
#ifndef PROBE_MASK
#define PROBE_MASK 0
#endif
#define PH_STEP(SPV, L)                                \
  xcd_barrier(xb);                                     \
  run_sub<SPV>(P, L, g_smem);                          \
  if (SPV == PROBE_DUP || ((PROBE_MASK >> SPV) & 1)) { xcd_barrier(xb); run_sub<SPV>(P, L, g_smem); }
#define PH_LAYER(L)                                                                      \
  PH_STEP(0, L) PH_STEP(1, L) PH_STEP(2, L) PH_STEP(3, L) PH_STEP(4, L) PH_STEP(5, L)    \
  PH_STEP(6, L) PH_STEP(7, L) PH_STEP(8, L) PH_STEP(9, L) PH_STEP(10, L) PH_STEP(11, L)
#define PH_LAYER0_NOSYNC                                                                 \
  run_sub<0>(P, 0, g_smem);                                                              \
  PH_STEP(1, 0) PH_STEP(2, 0) PH_STEP(3, 0) PH_STEP(4, 0) PH_STEP(5, 0)                  \
  PH_STEP(6, 0) PH_STEP(7, 0) PH_STEP(8, 0) PH_STEP(9, 0) PH_STEP(10, 0) PH_STEP(11, 0)
__shared__ uint4 xb_words;
__global__ void __launch_bounds__(256, 2) mega(Params P) {
  cg::grid_group grid = cg::this_grid();
  if (threadIdx.x == 0) xb_words = make_uint4(0u, 0u, 0u, 0u);
  __syncthreads();
  XcdBarrier xb = xcd_barrier_post((unsigned*)(P.ws + O_BAR), (volatile LAS unsigned*)&xb_words);
  run_phase0(P, g_smem);
  if (xb_ld((unsigned*)(P.ws + O_BAR) + XB_TMO) == 0xFFFFFFFFu) grid.sync();
  xcd_barrier(xb);
  PH_LAYER0_NOSYNC
  PH_LAYER(1)
}
#else
__global__ void __launch_bounds__(256, 2) kphase0(Params P) { run_phase0(P, g_smem); }
template <int SP>
__global__ void __launch_bounds__(256, 2) kphase(Params P, int l) { run_sub<SP>(P, l, g_smem); }
#endif

extern "C" void kernel_launch(void* const* d_in, const int* in_sizes, int n_in, void* d_out, int out_size, void* d_ws,
                              size_t ws_size, hipStream_t stream) {
  static int grid_blocks = 0;
  if (!grid_blocks) {
    int dev = 0, cus = 0, per_cu = 0;
    (void)hipGetDevice(&dev);
    (void)hipDeviceGetAttribute(&cus, hipDeviceAttributeMultiprocessorCount, dev);
#if ONE_LAUNCH
    (void)hipOccupancyMaxActiveBlocksPerMultiprocessor(&per_cu, mega, 256, 0);
#else
    per_cu = 2;
#endif
    if (per_cu < 1) per_cu = 1;
    if (per_cu > 2) per_cu = 2;
    grid_blocks = cus * per_cu;
  }
  if (ws_size < WS_TOTAL) { fprintf(stderr, "workspace too small: %zu < %zu\n", ws_size, (size_t)WS_TOTAL); }
  Params P{};
  const float** pp = (const float**)&P;
  for (int i = 0; i < 25; ++i) pp[i] = (const float*)d_in[i];
  P.out = (float*)d_out;
  P.ws = (char*)d_ws;
#if ONE_LAUNCH
  (void)hipMemsetAsync((char*)d_ws + O_BAR, 0, 16384, stream);
  void* args[] = {&P};
  hipError_t e = hipLaunchCooperativeKernel((void*)mega, dim3(grid_blocks), dim3(256), args, 0, stream);
  if (e != hipSuccess) fprintf(stderr, "cooperative launch failed: %s (grid %d)\n", hipGetErrorString(e), grid_blocks);
#else
  const dim3 g(grid_blocks), b(256);
  kphase0<<<g, b, 0, stream>>>(P);
  for (int l = 0; l < 2; ++l) {
    kphase<0><<<g, b, 0, stream>>>(P, l);
    kphase<1><<<g, b, 0, stream>>>(P, l);
    kphase<2><<<g, b, 0, stream>>>(P, l);
    kphase<3><<<g, b, 0, stream>>>(P, l);
    kphase<4><<<g, b, 0, stream>>>(P, l);
    kphase<5><<<g, b, 0, stream>>>(P, l);
    kphase<6><<<g, b, 0, stream>>>(P, l);
    kphase<7><<<g, b, 0, stream>>>(P, l);
    kphase<8><<<g, b, 0, stream>>>(P, l);
    kphase<9><<<g, b, 0, stream>>>(P, l);
    kphase<10><<<g, b, 0, stream>>>(P, l);
    kphase<11><<<g, b, 0, stream>>>(P, l);
  }
#endif
}
```

```cpp
#include <hip/hip_runtime.h>
#include <hip/hip_cooperative_groups.h>
#include <stdint.h>
#include <cstdio>
namespace cg = cooperative_groups;

#ifndef ONE_LAUNCH
#define ONE_LAUNCH 1
#endif

#define DI __device__ __forceinline__
typedef unsigned short bf16_t;
using bf16x8 = __attribute__((ext_vector_type(8))) short;
using s16x4 = __attribute__((ext_vector_type(4))) short;
using u32x4 = __attribute__((ext_vector_type(4))) unsigned;
using f32x16 = __attribute__((ext_vector_type(16))) float;
typedef __bf16 bf2_t __attribute__((ext_vector_type(2)));
typedef float f2_t __attribute__((ext_vector_type(2)));
#define MFMA32(a, b, c) __builtin_amdgcn_mfma_f32_32x32x16_bf16((a), (b), (c), 0, 0, 0)

constexpr int D = 1024;
constexpr int T = 16384;
constexpr int CTXL = 256;
constexpr int PB = T + CTXL;
constexpr int R = 2 * PB;
constexpr int INC = 6144;
constexpr int NE = 16;
constexpr int FF = 1408;
constexpr int SLOTS = 4224;
constexpr float EPS = 1e-6f;
constexpr float LOG2E = 1.4426950408889634f;
constexpr float TWO_PI_UNUSED = 6.283185307179586f;

constexpr size_t AL(size_t x) { return (x + 255) & ~(size_t)255; }
constexpr size_t O_WT_IN = 0;
constexpr size_t O_WT_BR = O_WT_IN + (size_t)INC * D * 2;
constexpr size_t O_WT_OUT = O_WT_BR + (size_t)4 * D * 256 * 2;
constexpr size_t O_WT_FN = O_WT_OUT + (size_t)D * D * 2;
constexpr size_t O_WT_13 = O_WT_FN + (size_t)256 * 256 * 2;
constexpr size_t O_WT_2 = O_WT_13 + (size_t)NE * 2 * FF * D * 2;
constexpr size_t O_WC = O_WT_2 + (size_t)NE * D * FF * 2;
constexpr size_t O_D1 = O_WC + (size_t)512 * 256 * 2;
constexpr size_t O_D2 = O_D1 + (size_t)256 * 256 * 2;
constexpr size_t O_DC = O_D2 + (size_t)128 * 256 * 2;
constexpr size_t O_ROPE = O_DC + (size_t)256 * 512 * 2;
constexpr size_t O_MOD = O_ROPE + (size_t)256 * 8 * 2 * 4;
constexpr size_t O_CONST = O_MOD + (size_t)2 * 3 * INC * 4;
constexpr size_t O_H = AL(O_CONST + 256);
constexpr size_t O_Z1 = O_H;
constexpr size_t O_Z2 = O_H + (size_t)2 * T * 512 * 2;
constexpr size_t O_Z1C = O_Z2 + (size_t)2 * T * 512 * 2;
constexpr size_t O_QPF = O_H + (size_t)R * D * 2;
constexpr size_t SZ256 = (size_t)R * 256 * 2;
constexpr size_t O_ACCM = O_QPF;
constexpr size_t O_GATES = O_QPF + 4 * SZ256;
constexpr size_t O_HID = O_GATES;
constexpr size_t O_KV = O_GATES + (size_t)R * 4096 * 2;
constexpr size_t O_Y = O_KV + 4 * SZ256;
constexpr size_t O_XCTX = O_Y + 4 * SZ256;
constexpr size_t O_AFF = O_XCTX + (size_t)512 * D * 4;
constexpr size_t O_ROWS = O_AFF + (size_t)4 * NE * T * 4;
constexpr size_t O_GL = O_ROWS + (size_t)NE * SLOTS * 4;
constexpr size_t O_BAR = AL(O_GL + (size_t)NE * SLOTS * 4);
constexpr size_t O_SMALLW1 = O_BAR + 16384;
constexpr size_t SMALLW = O_WT_13;
constexpr size_t WS_TOTAL = O_SMALLW1 + SMALLW;
static_assert(O_Z1C + (size_t)2 * 256 * 512 * 2 <= O_QPF, "fft scratch must fit in h");
static_assert((size_t)NE * SLOTS * FF * 2 <= (size_t)R * 4096 * 2, "hid must fit in gates");

struct Params {
  const float *x, *c, *ctx, *c_ctx, *w_ada, *b_ada, *g_mix, *g_ffn, *w_in, *na_q_g, *na_k_g, *na_rpb, *df_q_g,
      *df_k_g, *df_lambda, *df_subln_g, *pool_w, *pool_scale, *fnet_w, *w_branch, *w_out, *w_router, *w_gate_e,
      *w_up_e, *w_down_e;
  float* out;
  char* ws;
};

constexpr int SMEM_BYTES = 73728;
constexpr int LROW = 72;
constexpr int TILEB = 128 * LROW * 2;

DI int opaque_tid() { int t = threadIdx.x; asm volatile("" : "+v"(t)); return t; }
DI int opaque_bid() { int t = blockIdx.x; asm volatile("" : "+s"(t)); return t; }
DI size_t oq(size_t x) { asm volatile("" : "+s"(x)); return x; }
#define TIDX opaque_tid()
DI float bf2f(bf16_t b) { return __uint_as_float(((unsigned)b) << 16); }
DI unsigned pack2(float a, float b) {
  f2_t v = {a, b};
  bf2_t r = __builtin_convertvector(v, bf2_t);
  return __builtin_bit_cast(unsigned, r);
}
DI bf16_t f2bf(float a) { return (bf16_t)(pack2(a, 0.f) & 0xffffu); }
DI bf16x8 pack8(float a0, float a1, float a2, float a3, float a4, float a5, float a6, float a7) {
  uint4 u = {pack2(a0, a1), pack2(a2, a3), pack2(a4, a5), pack2(a6, a7)};
  return __builtin_bit_cast(bf16x8, u);
}
DI float wave_sum(float v) {
#pragma unroll
  for (int o = 32; o >= 1; o >>= 1) v += __shfl_xor(v, o, 64);
  return v;
}
DI int crow(int i, int hh) { return (i & 3) + 8 * (i >> 2) + 4 * hh; }
DI f32x16 fzero() {
  f32x16 z;
#pragma unroll
  for (int i = 0; i < 16; ++i) z[i] = 0.f;
  return z;
}
DI void row_info(int r, int& b, int& p) { b = r >= PB ? 1 : 0; p = r - b * PB; }
DI const float* x_in_row(const Params& P, int r) {
  int b, p; row_info(r, b, p);
  return p < T ? P.x + ((size_t)b * T + p) * D : P.ctx + ((size_t)b * CTXL + (p - T)) * D;
}
DI float* x_buf_row(const Params& P, int r) {
  int b, p; row_info(r, b, p);
  return p < T ? P.out + ((size_t)b * T + p) * D : (float*)(P.ws + oq(O_XCTX)) + ((size_t)b * CTXL + (p - T)) * D;
}
DI int row_modsel(int r) { int b, p; row_info(r, b, p); return p < T ? b : 2; }

template <class ARow>
DI void gemm_main(ARow arow, const bf16_t* __restrict__ Bt, long ldb, int K, char* smem, f32x16 (&acc)[2][2]) {
  const int tid = TIDX, lane = tid & 63, w = tid >> 6, wm = w >> 1, wn = w & 1;
  const int r = lane & 31, hh = lane >> 5;
  const int lrow = tid >> 3, lcc = (tid & 7) * 8;
  const bf16_t* pa[4];
#pragma unroll
  for (int i = 0; i < 4; ++i) pa[i] = arow(lrow + 32 * i) + lcc;
  const bf16_t* pb0 = Bt + (long)lrow * ldb + lcc;
  const long ldb32 = 32 * ldb;
  u32x4 ra0[4], rb0[4], ra1[4], rb1[4];
  const int nk = K >> 6;
#define G_LOAD1(RA, RB, kt, i) RA[i] = *(const u32x4*)(pa[i] + (kt) * 64); RB[i] = *(const u32x4*)(pb0 + i * ldb32 + (kt) * 64);
#define G_LOAD(RA, RB, kt) { G_LOAD1(RA, RB, kt, 0) G_LOAD1(RA, RB, kt, 1) G_LOAD1(RA, RB, kt, 2) G_LOAD1(RA, RB, kt, 3) }
#define G_STORE1(RA, RB, i) *(u32x4*)(base_ + ((lrow + 32 * i) * LROW + lcc) * 2) = RA[i]; *(u32x4*)(base_ + TILEB + ((lrow + 32 * i) * LROW + lcc) * 2) = RB[i];
#define G_STORE(RA, RB, buf) { char* base_ = smem + (buf) * 2 * TILEB; G_STORE1(RA, RB, 0) G_STORE1(RA, RB, 1) G_STORE1(RA, RB, 2) G_STORE1(RA, RB, 3) }
#define G_STEP(ks) { \
      bf16x8 a0 = *(const bf16x8*)(bA_ + ks * 32); \
      bf16x8 a1 = *(const bf16x8*)(bA_ + 32 * LROW * 2 + ks * 32); \
      bf16x8 b0 = *(const bf16x8*)(bB_ + ks * 32); \
      bf16x8 b1 = *(const bf16x8*)(bB_ + 32 * LROW * 2 + ks * 32); \
      acc[0][0] = MFMA32(a0, b0, acc[0][0]); \
      acc[0][1] = MFMA32(a0, b1, acc[0][1]); \
      acc[1][0] = MFMA32(a1, b0, acc[1][0]); \
      acc[1][1] = MFMA32(a1, b1, acc[1][1]); }
#define G_COMPUTE(buf) { \
    const char* bA_ = smem + (buf) * 2 * TILEB + ((wm * 64 + r) * LROW + hh * 8) * 2; \
    const char* bB_ = smem + (buf) * 2 * TILEB + TILEB + ((wn * 64 + r) * LROW + hh * 8) * 2; \
    G_STEP(0) G_STEP(1) G_STEP(2) G_STEP(3) }
  G_LOAD(ra0, rb0, 0);
  if (nk > 1) G_LOAD(ra1, rb1, 1);
  G_STORE(ra0, rb0, 0);
  if (nk > 2) G_LOAD(ra0, rb0, 2);
  for (int kt = 0; kt < nk; kt += 2) {
    __syncthreads();
    if (kt + 1 < nk) {
      G_STORE(ra1, rb1, 1);
      if (kt + 3 < nk) G_LOAD(ra1, rb1, kt + 3);
    }
    G_COMPUTE(0);
    if (kt + 1 < nk) {
      __syncthreads();
      if (kt + 2 < nk) {
        G_STORE(ra0, rb0, 0);
        if (kt + 4 < nk) G_LOAD(ra0, rb0, kt + 4);
      }
      G_COMPUTE(1);
    }
  }
  __syncthreads();
#undef G_LOAD
#undef G_STORE
#undef G_COMPUTE
#undef G_LOAD1
#undef G_STORE1
#undef G_STEP
}
struct PlainRows {
  const bf16_t* base; long ld;
  DI const bf16_t* operator()(int m) const { return base + (long)m * ld; }
};

constexpr int T2_B_OFF = 128 * LROW * 2;
template <class ARow>
DI void gemm_main2(ARow arow, const bf16_t* __restrict__ Bt, long ldb, int K, char* smem, f32x16 (&acc)[2][4]) {
  const int tid = TIDX, lane = tid & 63, w = tid >> 6, wm = w >> 1, wn = w & 1;
  const int r = lane & 31, hh = lane >> 5;
  const int lrow = tid >> 3, lcc = (tid & 7) * 8;
  const bf16_t* pa[4];
#pragma unroll
  for (int i = 0; i < 4; ++i) pa[i] = arow(lrow + 32 * i) + lcc;
  const bf16_t* pb0 = Bt + (long)lrow * ldb + lcc;
  const long ldb32 = 32 * ldb;
  u32x4 ra[4], rb[8];
  const int nk = K >> 6;
#define H_LA(i, kt) ra[i] = *(const u32x4*)(pa[i] + (kt) * 64);
#define H_LB(i, kt) rb[i] = *(const u32x4*)(pb0 + i * ldb32 + (kt) * 64);
#define H_LOAD(kt) { H_LA(0, kt) H_LA(1, kt) H_LA(2, kt) H_LA(3, kt) H_LB(0, kt) H_LB(1, kt) H_LB(2, kt) H_LB(3, kt) H_LB(4, kt) H_LB(5, kt) H_LB(6, kt) H_LB(7, kt) }
#define H_SA(i) *(u32x4*)(smem + ((lrow + 32 * i) * LROW + lcc) * 2) = ra[i];
#define H_SB(i) *(u32x4*)(smem + T2_B_OFF + ((lrow + 32 * i) * LROW + lcc) * 2) = rb[i];
#define H_STORE() { H_SA(0) H_SA(1) H_SA(2) H_SA(3) H_SB(0) H_SB(1) H_SB(2) H_SB(3) H_SB(4) H_SB(5) H_SB(6) H_SB(7) }
#define H_STEP(ks) { \
      bf16x8 a0 = *(const bf16x8*)(bA_ + ks * 32); \
      bf16x8 a1 = *(const bf16x8*)(bA_ + 32 * LROW * 2 + ks * 32); \
      bf16x8 b0 = *(const bf16x8*)(bB_ + ks * 32); \
      bf16x8 b1 = *(const bf16x8*)(bB_ + 32 * LROW * 2 + ks * 32); \
      bf16x8 b2 = *(const bf16x8*)(bB_ + 64 * LROW * 2 + ks * 32); \
      bf16x8 b3 = *(const bf16x8*)(bB_ + 96 * LROW * 2 + ks * 32); \
      acc[0][0] = MFMA32(a0, b0, acc[0][0]); \
      acc[1][0] = MFMA32(a1, b0, acc[1][0]); \
      acc[0][1] = MFMA32(a0, b1, acc[0][1]); \
      acc[1][1] = MFMA32(a1, b1, acc[1][1]); \
      acc[0][2] = MFMA32(a0, b2, acc[0][2]); \
      acc[1][2] = MFMA32(a1, b2, acc[1][2]); \
      acc[0][3] = MFMA32(a0, b3, acc[0][3]); \
      acc[1][3] = MFMA32(a1, b3, acc[1][3]); }
  const char* bA_ = smem + ((wm * 64 + r) * LROW + hh * 8) * 2;
  const char* bB_ = smem + T2_B_OFF + ((wn * 128 + r) * LROW + hh * 8) * 2;
  H_LOAD(0);
  for (int kt = 0; kt < nk; ++kt) {
    __syncthreads();
    H_STORE();
    __syncthreads();
    if (kt + 1 < nk) H_LOAD(kt + 1);
    H_STEP(0) H_STEP(1) H_STEP(2) H_STEP(3)
  }
  __syncthreads();
#undef H_LA
#undef H_LB
#undef H_LOAD
#undef H_SA
#undef H_SB
#undef H_STORE
#undef H_STEP
}
DI void zero_acc8(f32x16 (&acc)[2][4]) {
#pragma unroll
  for (int a = 0; a < 2; ++a)
#pragma unroll
    for (int b = 0; b < 4; ++b) acc[a][b] = fzero();
}

DI void transpose_tile(const float* __restrict__ src, long ld_src, bf16_t* __restrict__ dst, long ld_dst, int k0,
                       int n0, int rs, int off, char* smem) {
  float* Tt = (float*)smem;
  const int tid = TIDX;
#pragma unroll
  for (int i = 0; i < 4; ++i) {
    int k = (tid >> 4) + 16 * i, c4 = (tid & 15) * 4;
    float4 v = *(const float4*)(src + (long)(k0 + k) * ld_src + n0 + c4);
    Tt[k * 65 + c4 + 0] = v.x; Tt[k * 65 + c4 + 1] = v.y; Tt[k * 65 + c4 + 2] = v.z; Tt[k * 65 + c4 + 3] = v.w;
  }
  __syncthreads();
  const int n = tid >> 2, kq = (tid & 3) * 16;
  unsigned pk[8];
#pragma unroll
  for (int j = 0; j < 8; ++j) pk[j] = pack2(Tt[(kq + 2 * j) * 65 + n], Tt[(kq + 2 * j + 1) * 65 + n]);
  const int nn = n0 + n;
  const long drow = (long)(nn >> 5) * rs + off + (nn & 31);
  uint4* d = (uint4*)(dst + drow * ld_dst + k0 + kq);
  d[0] = make_uint4(pk[0], pk[1], pk[2], pk[3]);
  d[1] = make_uint4(pk[4], pk[5], pk[6], pk[7]);
  __syncthreads();
}

constexpr int WT_SMALL = 1536 + 256 + 256 + 16;
constexpr int WT_TILES = WT_SMALL + 5632 + 5632 + 5632;
DI size_t smallw(int l) { return l ? oq(O_SMALLW1) : (size_t)0; }
DI void convert_weight_tile(const Params& P, int l, int t, char* smem) {
  char* ws = P.ws;
  const size_t sw = smallw(l);
  if (t < 1536) {
    int kt = t / 96, nt = t % 96;
    transpose_tile(P.w_in + (size_t)l * D * INC, INC, (bf16_t*)(ws + sw + oq(O_WT_IN)), D, kt * 64, nt * 64, 32, 0, smem);
    return;
  }
  t -= 1536;
  if (t < 256) {
    int i = t >> 6, tt = t & 63, kt = tt >> 4, nt = tt & 15;
    transpose_tile(P.w_branch + ((size_t)l * 4 + i) * 256 * D, D, (bf16_t*)(ws + sw + oq(O_WT_BR)) + (size_t)i * D * 256, 256,
                   kt * 64, nt * 64, 32, 0, smem);
    return;
  }
  t -= 256;
  if (t < 256) {
    int kt = t >> 4, nt = t & 15;
    transpose_tile(P.w_out + (size_t)l * D * D, D, (bf16_t*)(ws + sw + oq(O_WT_OUT)), D, kt * 64, nt * 64, 32, 0, smem);
    return;
  }
  t -= 256;
  if (t < 16) {
    int kt = t >> 2, nt = t & 3;
    transpose_tile(P.fnet_w + (size_t)l * 256 * 256, 256, (bf16_t*)(ws + sw + oq(O_WT_FN)), 256, kt * 64, nt * 64, 32, 0, smem);
    return;
  }
  t -= 16;
  if (t < 11264) {
    int which = t >= 5632; if (which) t -= 5632;
    int e = t / 352, tt = t % 352, kt = tt / 22, nt = tt % 22;
    const float* src = (which ? P.w_up_e : P.w_gate_e) + ((size_t)l * NE + e) * D * FF;
    transpose_tile(src, FF, (bf16_t*)(ws + oq(O_WT_13)) + (size_t)e * 2 * FF * D, D, kt * 64, nt * 64, 64, which * 32, smem);
    return;
  }
  t -= 11264;
  {
    int e = t / 352, tt = t % 352, kt = tt / 16, nt = tt % 16;
    transpose_tile(P.w_down_e + ((size_t)l * NE + e) * FF * D, D, (bf16_t*)(ws + oq(O_WT_2)) + (size_t)e * D * FF, FF,
                   kt * 64, nt * 64, 32, 0, smem);
  }
}

DI void ada_task(const Params& P, int t, char* smem) {
  const int l = t / 96, n0 = (t % 96) * 64;
  float* sv = (float*)smem;
  float* red = sv + 3 * 1024;
  const int tid = TIDX;
  for (int i = tid; i < 3 * 1024; i += 256) {
    int s = i >> 10, k = i & 1023;
    float v = s < 2 ? P.c[s * D + k] : P.c_ctx[k];
    sv[i] = v / (1.f + __expf(-v));
  }
  __syncthreads();
  const int col = tid & 63, kg = tid >> 6;
  const float* wp = P.w_ada + (size_t)l * D * INC + n0 + col;
  float a0 = 0.f, a1 = 0.f, a2 = 0.f;
  for (int k = kg * 256; k < kg * 256 + 256; ++k) {
    float wv = wp[(size_t)k * INC];
    a0 += sv[k] * wv; a1 += sv[1024 + k] * wv; a2 += sv[2048 + k] * wv;
  }
  red[(kg * 3 + 0) * 64 + col] = a0; red[(kg * 3 + 1) * 64 + col] = a1; red[(kg * 3 + 2) * 64 + col] = a2;
  __syncthreads();
  if (tid < 192) {
    int s = tid >> 6, cc = tid & 63;
    float v = P.b_ada[(size_t)l * INC + n0 + cc];
    for (int g = 0; g < 4; ++g) v += red[(g * 3 + s) * 64 + cc];
    ((float*)(P.ws + oq(O_MOD)))[((size_t)l * 3 + s) * INC + n0 + cc] = v;
  }
  __syncthreads();
}

DI void tables_task(const Params& P, int t) {
  char* ws = P.ws;
  const int gtid = t * 256 + TIDX, gstride = 64 * 256;
  bf16_t* Wc = (bf16_t*)(ws + oq(O_WC));
  for (int i = gtid; i < 512 * 256; i += gstride) {
    int jj = i >> 8, c = i & 255, part = jj >> 8, j = jj & 255;
    float sn, cs; sincospif(2.f * (float)((j * c) & 255) / 256.f, &sn, &cs);
    Wc[i] = f2bf(part == 0 ? cs : -sn);
  }
  bf16_t* D1 = (bf16_t*)(ws + oq(O_D1));
  for (int i = gtid; i < 256 * 256; i += gstride) {
    int n = i >> 8, k = i & 255;
    int k1 = (n >> 6) * 32 + (n & 31), po = (n >> 5) & 1, pi = k >> 7, n1 = k & 127;
    float sn, cs; sincospif(2.f * (float)((k1 * n1) & 127) / 128.f, &sn, &cs);
    float v = po == 0 ? (pi == 0 ? cs : sn) : (pi == 0 ? -sn : cs);
    D1[i] = f2bf(v);
  }
  bf16_t* D2 = (bf16_t*)(ws + oq(O_D2));
  for (int i = gtid; i < 128 * 256; i += gstride) {
    int k2 = i >> 8, k = i & 255, pi = k >> 7, n2 = k & 127;
    float sn, cs; sincospif(2.f * (float)((k2 * n2) & 127) / 128.f, &sn, &cs);
    D2[i] = f2bf(pi == 0 ? cs : sn);
  }
  bf16_t* Dc = (bf16_t*)(ws + oq(O_DC));
  for (int i = gtid; i < 256 * 512; i += gstride) {
    int kk = i >> 9, k = i & 511, pi = k >> 8, n = k & 255;
    float sn, cs; sincospif(2.f * (float)((kk * n) & 255) / 256.f, &sn, &cs);
    Dc[i] = f2bf(pi == 0 ? cs : sn);
  }
  float* rope = (float*)(ws + oq(O_ROPE));
  for (int i = gtid; i < 256 * 8; i += gstride) {
    int pos = i >> 3, f = i & 7;
    float inv = powf(10000.f, -(float)f / 8.f);
    float ang = (float)pos * inv;
    rope[i * 2 + 0] = cosf(ang);
    rope[i * 2 + 1] = sinf(ang);
  }
  if (t == 0 && TIDX < 2) {
    const int l = TIDX;
    float* cst = (float*)(ws + oq(O_CONST)) + l * 8;
    const float* lv = P.df_lambda + l * 128;
    float d01 = 0.f, d23 = 0.f;
    for (int i = 0; i < 32; ++i) { d01 += lv[i] * lv[32 + i]; d23 += lv[64 + i] * lv[96 + i]; }
    float lam_init = 0.8f - 0.6f * expf(-0.3f * (float)l);
    cst[0] = expf(d01) - expf(d23) + lam_init;
    cst[1] = lam_init;
    float gq = 0.f, gk = 0.f;
    for (int i = 0; i < 32; ++i) { gq = fmaxf(gq, fabsf(P.df_q_g[l * 32 + i])); gk = fmaxf(gk, fabsf(P.df_k_g[l * 32 + i])); }
    cst[2] = sqrtf(32.f) * gq * gk * LOG2E;
    gq = 0.f; gk = 0.f;
    for (int i = 0; i < 64; ++i) { gq = fmaxf(gq, fabsf(P.na_q_g[l * 64 + i])); gk = fmaxf(gk, fabsf(P.na_k_g[l * 64 + i])); }
    float bm = 0.f;
    for (int i = 0; i < 4 * 15 * 31; ++i) bm = fmaxf(bm, fabsf(P.na_rpb[l * 4 * 15 * 31 + i]));
    cst[3] = (8.f * gq * gk + bm) * LOG2E;
  }
}

DI void modnorm_phase(const Params& P, int l, bool second, int bid, int nb, char* smem) {
  const int lane = TIDX & 63, w = TIDX >> 6;
  const int nw = nb * 4;
  bf16_t* h = (bf16_t*)(P.ws + oq(O_H));
  const float* g = (second ? P.g_ffn : P.g_mix) + (size_t)l * D;
  float* wt = (float*)smem;
  if (second) {
    const float* wr = P.w_router + (size_t)l * D * NE;
    for (int idx = TIDX; idx < D * NE; idx += 256) wt[(idx & 15) * D + (idx >> 4)] = wr[idx];
    __syncthreads();
  }
  for (int r = bid * 4 + w; r < R; r += nw) {
    int b, p; row_info(r, b, p);
    const bool isctx = p >= T;
    if (l == 1 && second && isctx) continue;
    const float* src = (l == 0 && !second) ? x_in_row(P, r) : x_buf_row(P, r);
    const int s = isctx ? 2 : b;
    const float* mb = (const float*)(P.ws + oq(O_MOD)) + ((size_t)l * 3 + s) * INC + (second ? 3 * D : 0);
    float4 v[4];
    float ss = 0.f;
#pragma unroll
    for (int i = 0; i < 4; ++i) {
      v[i] = *(const float4*)(src + lane * 4 + 256 * i);
      ss += v[i].x * v[i].x + v[i].y * v[i].y + v[i].z * v[i].z + v[i].w * v[i].w;
    }
    ss = wave_sum(ss);
    const float rstd = rsqrtf(ss * (1.f / D) + EPS);
    float hv[16];
#pragma unroll
    for (int i = 0; i < 4; ++i) {
      const int c = lane * 4 + 256 * i;
      float4 gg = *(const float4*)(g + c), sh = *(const float4*)(mb + c), sc = *(const float4*)(mb + D + c);
      hv[i * 4 + 0] = v[i].x * rstd * gg.x * (1.f + sc.x) + sh.x;
      hv[i * 4 + 1] = v[i].y * rstd * gg.y * (1.f + sc.y) + sh.y;
      hv[i * 4 + 2] = v[i].z * rstd * gg.z * (1.f + sc.z) + sh.z;
      hv[i * 4 + 3] = v[i].w * rstd * gg.w * (1.f + sc.w) + sh.w;
      uint2 o = {pack2(hv[i * 4 + 0], hv[i * 4 + 1]), pack2(hv[i * 4 + 2], hv[i * 4 + 3])};
      *(uint2*)(h + (size_t)r * D + c) = o;
    }
    if (second) {
      float lg[16];
#pragma unroll
      for (int e = 0; e < 16; ++e) lg[e] = 0.f;
#pragma unroll
      for (int i = 0; i < 4; ++i) {
#pragma unroll
        for (int e = 0; e < 16; ++e) {
          const float4 w4 = *(const float4*)(wt + e * D + 256 * i + lane * 4);
          lg[e] += hv[i * 4 + 0] * w4.x + hv[i * 4 + 1] * w4.y + hv[i * 4 + 2] * w4.z + hv[i * 4 + 3] * w4.w;
          if ((e & 3) == 3) __builtin_amdgcn_sched_barrier(0);
        }
      }
      float mx = -1e30f;
#pragma unroll
      for (int e = 0; e < 16; ++e) { lg[e] = wave_sum(lg[e]); mx = fmaxf(mx, lg[e]); }
      float sum = 0.f, mine = 0.f;
#pragma unroll
      for (int e = 0; e < 16; ++e) { float ex = __expf(lg[e] - mx); sum += ex; if (lane == e) mine = ex; }
      if (lane < 16) {
        const int smp = isctx ? 2 + b : b, n = isctx ? p - T : p;
        ((float*)(P.ws + oq(O_AFF)))[((size_t)smp * NE + lane) * T + n] = mine / sum;
      }
    }
  }
  __syncthreads();
}

template <int G>
DI void epi_rms(const float* Tt, const float* __restrict__ gain, bool rope, const float* __restrict__ ropetab,
                float scale, bf16_t* __restrict__ dst, int dcol0, int r0) {
  constexpr int NG = 128 / G;
  for (int it = TIDX; it < 128 * NG; it += 256) {
    const int row = it / NG, grp = it % NG;
    const float* tp = Tt + row * 132 + grp * G;
    float ss = 0.f;
#pragma unroll
    for (int d = 0; d < G; d += 4) {
      float4 q = *(const float4*)(tp + d);
      ss += q.x * q.x + q.y * q.y + q.z * q.z + q.w * q.w;
    }
    const float rstd = rsqrtf(ss * (1.f / G) + EPS);
    const float* gp = gain;
    asm volatile("" : "+s"(gp));
    int b, p; row_info(r0 + row, b, p);
    const bool dorope = (G == 32) && rope && (p < T);
    uint4* dp = (uint4*)(dst + (size_t)(r0 + row) * 256 + dcol0 + grp * G);
#pragma unroll 1
    for (int sub = 0; sub < G / 16; ++sub) {
      float v[16];
#pragma unroll
      for (int d = 0; d < 16; d += 4) {
        float4 q = *(const float4*)(tp + sub * 16 + d);
        float4 g4 = *(const float4*)(gp + sub * 16 + d);
        v[d] = q.x * rstd * g4.x; v[d + 1] = q.y * rstd * g4.y; v[d + 2] = q.z * rstd * g4.z; v[d + 3] = q.w * rstd * g4.w;
      }
      if (dorope) {
        const int pos = sub ? (p & 63) : (p >> 6);
#pragma unroll
        for (int i = 0; i < 8; ++i) {
          const float2 cssn = *(const float2*)(ropetab + (pos * 8 + i) * 2);
          const float x1 = v[i], x2 = v[8 + i];
          v[i] = x1 * cssn.x - x2 * cssn.y;
          v[8 + i] = x1 * cssn.y + x2 * cssn.x;
        }
      }
      dp[sub * 2] = make_uint4(pack2(v[0] * scale, v[1] * scale), pack2(v[2] * scale, v[3] * scale),
                               pack2(v[4] * scale, v[5] * scale), pack2(v[6] * scale, v[7] * scale));
      dp[sub * 2 + 1] = make_uint4(pack2(v[8] * scale, v[9] * scale), pack2(v[10] * scale, v[11] * scale),
                                   pack2(v[12] * scale, v[13] * scale), pack2(v[14] * scale, v[15] * scale));
    }
  }
}
DI void epi_plain(const float* Tt, bf16_t* __restrict__ dst, int dcol0, int r0) {
  const int row = TIDX >> 1, c0 = (TIDX & 1) * 64;
  uint4* dp = (uint4*)(dst + (size_t)(r0 + row) * 256 + dcol0 + c0);
#pragma unroll
  for (int d = 0; d < 64; d += 8) {
    float4 a = *(const float4*)(Tt + row * 132 + c0 + d), b = *(const float4*)(Tt + row * 132 + c0 + d + 4);
    dp[d >> 3] = make_uint4(pack2(a.x, a.y), pack2(a.z, a.w), pack2(b.x, b.y), pack2(b.z, b.w));
  }
}
DI void epi_transposed(const float* Tt, bf16_t* __restrict__ vt, int hd0, int bb, int p0) {
  const int c = TIDX >> 1, half = TIDX & 1;
  const int hd = hd0 + c;
  uint4* dp = (uint4*)(vt + ((size_t)bb * 256 + hd) * PB + p0 + half * 64);
#pragma unroll
  for (int q = 0; q < 8; ++q) {
    float f[8];
#pragma unroll
    for (int j = 0; j < 8; ++j) {
      const int tk = (q >> 1) * 16 + ((q & 1) ? (j < 4 ? j + 4 : j + 8) : (j < 4 ? j : j + 4));
      f[j] = Tt[(half * 64 + tk) * 132 + c];
    }
    dp[q] = make_uint4(pack2(f[0], f[1]), pack2(f[2], f[3]), pack2(f[4], f[5]), pack2(f[6], f[7]));
  }
}

DI void inproj_tile(const Params& P, int l, int mt, int nt, char* smem) {
  char* ws = P.ws;
  const int r0 = mt * 128;
  f32x16 acc[2][4];
  zero_acc8(acc);
  PlainRows ar{(const bf16_t*)(ws + oq(O_H)) + (size_t)r0 * D, D};
  gemm_main2(ar, (const bf16_t*)(ws + smallw(l) + oq(O_WT_IN)) + (size_t)nt * 256 * D, D, D, smem, acc);
  const int tid = TIDX, lane = tid & 63, w = tid >> 6, wm = w >> 1, wn = w & 1, r = lane & 31, hh = lane >> 5;
  if (nt >= 4 && nt < 20) {
    bf16_t* gates = (bf16_t*)(ws + oq(O_GATES));
#pragma unroll
    for (int mb = 0; mb < 2; ++mb)
#pragma unroll
      for (int nb2 = 0; nb2 < 4; ++nb2) {
        const int mt32 = mt * 4 + wm * 2 + mb, nt32 = (nt - 4) * 8 + wn * 4 + nb2;
        float sg[16];
#pragma unroll
        for (int i = 0; i < 16; ++i) sg[i] = 1.f / (1.f + __expf(-acc[mb][nb2][i]));
        uint4* gp = (uint4*)(gates + (((size_t)mt32 * 128 + nt32) * 64 + lane) * 16);
        gp[0] = make_uint4(pack2(sg[0], sg[1]), pack2(sg[2], sg[3]), pack2(sg[4], sg[5]), pack2(sg[6], sg[7]));
        gp[1] = make_uint4(pack2(sg[8], sg[9]), pack2(sg[10], sg[11]), pack2(sg[12], sg[13]), pack2(sg[14], sg[15]));
      }
    return;
  }
  float* Tt = (float*)smem;
  bf16_t* qpf = (bf16_t*)(ws + oq(O_QPF));
  bf16_t* kv = (bf16_t*)(ws + oq(O_KV));
  const float* ropetab = (const float*)(ws + oq(O_ROPE));
  const size_t S = (size_t)R * 256;
  int bb, p0; row_info(r0, bb, p0);
#pragma unroll 1
  for (int half = 0; half < 2; ++half) {
    if (wn == half) {
#pragma unroll
      for (int mb = 0; mb < 2; ++mb)
#pragma unroll
        for (int nb2 = 0; nb2 < 4; ++nb2)
#pragma unroll
          for (int i = 0; i < 16; ++i) {
            const int m = wm * 64 + mb * 32 + crow(i, hh), n = nb2 * 32 + r;
            Tt[m * 132 + n] = acc[mb][nb2][i];
          }
    }
    __syncthreads();
    const int dc = half * 128;
    if (nt == 0) epi_rms<64>(Tt, P.na_q_g + l * 64, false, ropetab, 0.125f * LOG2E, qpf, dc, r0);
    else if (nt == 1) epi_rms<32>(Tt, P.df_q_g + l * 32, true, ropetab, 0.17677669529663687f * LOG2E, qpf + S, dc, r0);
    else if (nt == 2) epi_plain(Tt, qpf + 2 * S, dc, r0);
    else if (nt == 3) epi_plain(Tt, qpf + 3 * S, dc, r0);
    else if (nt == 20) epi_rms<64>(Tt, P.na_k_g + l * 64, false, ropetab, 1.f, kv, dc, r0);
    else if (nt == 21) epi_transposed(Tt, kv + 2 * S, dc, bb, p0);
    else if (nt == 22) epi_rms<32>(Tt, P.df_k_g + l * 32, true, ropetab, 1.f, kv + S, dc, r0);
    else epi_transposed(Tt, kv + 3 * S, dc, bb, p0);
    __syncthreads();
  }
}

DI void diffattn_task(const Params& P, int l, int b, int hd, int q0, int key_lo, int nkeys, char* smem) {
  char* ws = P.ws;
  const int tid = TIDX, lane = tid & 63, w = tid >> 6, r = lane & 31, hh = lane >> 5;
  const bf16_t* qd = (const bf16_t*)(ws + oq(O_QPF)) + (size_t)R * 256;
  const bf16_t* kd = (const bf16_t*)(ws + oq(O_KV)) + (size_t)R * 256;
  const bf16_t* vt = (const bf16_t*)(ws + oq(O_KV)) + (size_t)3 * R * 256;
  bf16_t* yd = (bf16_t*)(ws + oq(O_Y)) + (size_t)R * 256;
  const float* cst = (const float*)(ws + oq(O_CONST)) + l * 8;
  const float lam = cst[0], lam_init = cst[1], negC = -cst[2];
  const int qrow = b * PB + q0 + w * 32 + r;
  bf16x8 qf[2][2];
#pragma unroll
  for (int m = 0; m < 2; ++m)
#pragma unroll
    for (int ks = 0; ks < 2; ++ks)
      qf[m][ks] = *(const bf16x8*)(qd + (size_t)qrow * 256 + hd * 64 + m * 32 + ks * 16 + hh * 8);
  f32x16 O[2][2];
  O[0][0] = O[0][1] = O[1][0] = O[1][1] = fzero();
  float ls0 = 0.f, ls1 = 0.f;
  constexpr int KT = 64 * LROW * 2;
  const bf16_t* kbase = kd + ((size_t)b * PB + key_lo) * 256 + hd * 64;
  const bf16_t* vbase = vt + ((size_t)(b * 4 + hd) * 64) * PB + key_lo;
  const int c0 = tid, c1 = tid + 256;
  u32x4 rk0, rk1, rv0, rv1;
#define DA_LOAD(t)                                                                       \
  {                                                                                      \
    rk0 = *(const u32x4*)(kbase + ((size_t)((t) * 64 + (c0 >> 3))) * 256 + (c0 & 7) * 8); \
    rk1 = *(const u32x4*)(kbase + ((size_t)((t) * 64 + (c1 >> 3))) * 256 + (c1 & 7) * 8); \
    rv0 = *(const u32x4*)(vbase + (size_t)(c0 >> 3) * PB + (t) * 64 + (c0 & 7) * 8);      \
    rv1 = *(const u32x4*)(vbase + (size_t)(c1 >> 3) * PB + (t) * 64 + (c1 & 7) * 8);      \
  }
#define DA_STORE(buf)                                                          \
  {                                                                            \
    char* kb_ = smem + (buf) * 2 * KT;                                         \
    *(u32x4*)(kb_ + ((c0 >> 3) * LROW + (c0 & 7) * 8) * 2) = rk0;              \
    *(u32x4*)(kb_ + ((c1 >> 3) * LROW + (c1 & 7) * 8) * 2) = rk1;              \
    *(u32x4*)(kb_ + KT + ((c0 >> 3) * LROW + (c0 & 7) * 8) * 2) = rv0;         \
    *(u32x4*)(kb_ + KT + ((c1 >> 3) * LROW + (c1 & 7) * 8) * 2) = rv1;         \
  }
  const int nt = nkeys >> 6;
  DA_LOAD(0);
  DA_STORE(0);
  if (nt > 1) DA_LOAD(1);
  for (int t = 0; t < nt; ++t) {
    __syncthreads();
    if (t + 1 < nt) {
      DA_STORE((t + 1) & 1);
      if (t + 2 < nt) DA_LOAD(t + 2);
    }
    const char* Ks = smem + (t & 1) * 2 * KT;
    const char* Vs = Ks + KT;
#pragma unroll 1
    for (int kb = 0; kb < 2; ++kb) {
      f32x16 S0, S1;
#pragma unroll
      for (int i = 0; i < 16; ++i) { S0[i] = negC; S1[i] = negC; }
#pragma unroll
      for (int ks = 0; ks < 2; ++ks) {
        bf16x8 k0 = *(const bf16x8*)(Ks + ((kb * 32 + r) * LROW + ks * 16 + hh * 8) * 2);
        bf16x8 k1 = *(const bf16x8*)(Ks + ((kb * 32 + r) * LROW + 32 + ks * 16 + hh * 8) * 2);
        S0 = MFMA32(k0, qf[0][ks], S0);
        S1 = MFMA32(k1, qf[1][ks], S1);
      }
#pragma unroll
      for (int i = 0; i < 16; ++i) {
        S0[i] = __builtin_amdgcn_exp2f(S0[i]); ls0 += S0[i];
        S1[i] = __builtin_amdgcn_exp2f(S1[i]); ls1 += S1[i];
      }
#pragma unroll
      for (int s = 0; s < 2; ++s) {
        bf16x8 p0 = pack8(S0[8 * s], S0[8 * s + 1], S0[8 * s + 2], S0[8 * s + 3], S0[8 * s + 4], S0[8 * s + 5], S0[8 * s + 6], S0[8 * s + 7]);
        bf16x8 p1 = pack8(S1[8 * s], S1[8 * s + 1], S1[8 * s + 2], S1[8 * s + 3], S1[8 * s + 4], S1[8 * s + 5], S1[8 * s + 6], S1[8 * s + 7]);
#pragma unroll
        for (int vb = 0; vb < 2; ++vb) {
          const bf16x8 vf = *(const bf16x8*)(Vs + ((vb * 32 + r) * LROW + kb * 32 + 16 * s + 8 * hh) * 2);
          O[0][vb] = MFMA32(vf, p0, O[0][vb]);
          O[1][vb] = MFMA32(vf, p1, O[1][vb]);
        }
      }
    }
  }
  __syncthreads();
#undef DA_LOAD
#undef DA_STORE
  ls0 += __shfl_xor(ls0, 32, 64);
  ls1 += __shfl_xor(ls1, 32, 64);
  const float i0 = 1.f / ls0, i1 = lam / ls1;
  float ssq = 0.f;
#pragma unroll
  for (int vb = 0; vb < 2; ++vb)
#pragma unroll
    for (int i = 0; i < 16; ++i) {
      float o = O[0][vb][i] * i0 - O[1][vb][i] * i1;
      O[0][vb][i] = o;
      ssq += o * o;
    }
  ssq += __shfl_xor(ssq, 32, 64);
  const float rstd = rsqrtf(ssq * (1.f / 64.f) + EPS) * (1.f - lam_init);
  const float* sg = P.df_subln_g + l * 64;
#pragma unroll
  for (int vb = 0; vb < 2; ++vb)
#pragma unroll
    for (int g4 = 0; g4 < 4; ++g4) {
      const int vd = vb * 32 + 8 * g4 + 4 * hh;
      float o0 = O[0][vb][4 * g4] * rstd * sg[vd], o1 = O[0][vb][4 * g4 + 1] * rstd * sg[vd + 1];
      float o2 = O[0][vb][4 * g4 + 2] * rstd * sg[vd + 2], o3 = O[0][vb][4 * g4 + 3] * rstd * sg[vd + 3];
      uint2 pk = {pack2(o0, o1), pack2(o2, o3)};
      *(uint2*)(yd + (size_t)qrow * 256 + hd * 64 + vd) = pk;
    }
}

DI void na_task(const Params& P, int l, int b, bool ctxq, int rr, int qsel, char* smem) {
  char* ws = P.ws;
  const int tid = TIDX, lane = tid & 63, hd = tid >> 6, r = lane & 31, hh = lane >> 5;
  float* rp = (float*)smem;
  if (!ctxq) {
    for (int i = tid; i < 4 * 15 * 31; i += 256) rp[i] = P.na_rpb[(size_t)l * 4 * 15 * 31 + i] * LOG2E;
  }
  __syncthreads();
  const bf16_t* qn = (const bf16_t*)(ws + oq(O_QPF));
  const bf16_t* kn = (const bf16_t*)(ws + oq(O_KV));
  const bf16_t* vt = (const bf16_t*)(ws + oq(O_KV)) + (size_t)2 * R * 256;
  bf16_t* yn = (bf16_t*)(ws + oq(O_Y));
  const float negC = -((const float*)(ws + oq(O_CONST)))[l * 8 + 3];
  int cq[2], qrow[2], cs[2];
  bf16x8 qf[2][4];
  f32x16 O[2][2];
  float ls[2];
#pragma unroll
  for (int a = 0; a < 2; ++a) {
    cq[a] = (qsel + a) * 32 + r;
    const int qp = ctxq ? T + cq[a] : rr * 64 + cq[a];
    qrow[a] = b * PB + qp;
    cs[a] = min(max(cq[a] - 8, 0), 48);
#pragma unroll
    for (int ks = 0; ks < 4; ++ks) qf[a][ks] = *(const bf16x8*)(qn + (size_t)qrow[a] * 256 + hd * 64 + ks * 16 + hh * 8);
    O[a][0] = O[a][1] = fzero();
    ls[a] = 0.f;
  }
  const int rs = min(max(rr - 4, 0), 248);
  const int nblk = ctxq ? 8 : 24;
  const bf16_t* vtb = vt + ((size_t)(b * 4 + hd) * 64) * PB;
  for (int kbi = 0; kbi < nblk; ++kbi) {
    const bool loc = !ctxq && kbi < 16;
    const int ir = kbi >> 1, kb = kbi & 1;
    const int pk0 = loc ? (rs + ir) * 64 + kb * 32 : T + (kbi - (ctxq ? 0 : 16)) * 32;
    const bf16_t* kp = kn + ((size_t)b * PB + pk0 + r) * 256 + hd * 64 + hh * 8;
    bf16x8 kf[4];
#pragma unroll
    for (int ks = 0; ks < 4; ++ks) kf[ks] = *(const bf16x8*)(kp + ks * 16);
    bf16x8 vf[2][2];
#pragma unroll
    for (int s = 0; s < 2; ++s)
#pragma unroll
      for (int vb = 0; vb < 2; ++vb) vf[s][vb] = *(const bf16x8*)(vtb + (size_t)(vb * 32 + r) * PB + pk0 + 16 * s + 8 * hh);
    const float* rpr = rp + (hd * 15 + (rs + ir - rr + 7)) * 31;
#pragma unroll
    for (int a = 0; a < 2; ++a) {
      f32x16 S;
#pragma unroll
      for (int i = 0; i < 16; ++i) S[i] = negC;
#pragma unroll
      for (int ks = 0; ks < 4; ++ks) S = MFMA32(kf[ks], qf[a][ks], S);
      if (loc) {
#pragma unroll
        for (int i = 0; i < 16; ++i) {
          const int kc = kb * 32 + crow(i, hh);
          const bool valid = (kc >= cs[a]) && (kc < cs[a] + 16);
          const int ci = min(max(kc - cq[a] + 15, 0), 30);
          const float pv = __builtin_amdgcn_exp2f(S[i] + rpr[ci]);
          S[i] = valid ? pv : 0.f;
          ls[a] += S[i];
        }
      } else {
#pragma unroll
        for (int i = 0; i < 16; ++i) { S[i] = __builtin_amdgcn_exp2f(S[i]); ls[a] += S[i]; }
      }
#pragma unroll
      for (int s = 0; s < 2; ++s) {
        bf16x8 pf = pack8(S[8 * s], S[8 * s + 1], S[8 * s + 2], S[8 * s + 3], S[8 * s + 4], S[8 * s + 5], S[8 * s + 6], S[8 * s + 7]);
#pragma unroll
        for (int vb = 0; vb < 2; ++vb) O[a][vb] = MFMA32(vf[s][vb], pf, O[a][vb]);
      }
    }
  }
#pragma unroll
  for (int a = 0; a < 2; ++a) {
    float lsa = ls[a];
    lsa += __shfl_xor(lsa, 32, 64);
    const float inv = 1.f / lsa;
#pragma unroll
    for (int vb = 0; vb < 2; ++vb)
#pragma unroll
      for (int g4 = 0; g4 < 4; ++g4) {
        const int vd = vb * 32 + 8 * g4 + 4 * hh;
        uint2 pk = {pack2(O[a][vb][4 * g4] * inv, O[a][vb][4 * g4 + 1] * inv), pack2(O[a][vb][4 * g4 + 2] * inv, O[a][vb][4 * g4 + 3] * inv)};
        *(uint2*)(yn + (size_t)qrow[a] * 256 + hd * 64 + vd) = pk;
      }
  }
  __syncthreads();
}

DI void pool_task(const Params& P, int l, int tile, char* smem) {
  char* ws = P.ws;
  const int tid = TIDX;
  const int r0 = tile * 32;
  int b, p0; row_info(r0, b, p0);
  const bool isctx = p0 >= T;
  const int seq0 = isctx ? T : 0, N = isctx ? CTXL : T;
  const int t0 = p0 - seq0;
  const bf16_t* pin = (const bf16_t*)(ws + oq(O_QPF)) + (size_t)2 * R * 256;
  bf16_t* yp = (bf16_t*)(ws + oq(O_Y)) + (size_t)2 * R * 256;
  bf16_t* us = (bf16_t*)smem;
  float* ds = (float*)(smem + 48 * 256 * 2);
  for (int i = tid; i < 48 * 32; i += 256) {
    const int rowi = i >> 5, ch = (i & 31) * 8;
    const int tk = t0 - 8 + rowi;
    uint4 v = make_uint4(0, 0, 0, 0);
    if (tk >= 0 && tk < N) v = *(const uint4*)(pin + ((size_t)b * PB + seq0 + tk) * 256 + ch);
    *(uint4*)(us + rowi * 256 + ch) = v;
  }
  __syncthreads();
  {
    const int ch = tid, gi = ch >> 6, wv = 2 << gi;
    for (int t = 0; t < 32; ++t) {
      const int tk = t0 + t;
      const int lo = max(tk - wv / 2, 0), hi = min(tk + wv / 2, N);
      float s = 0.f;
      for (int q = lo; q < hi; ++q) s += bf2f(us[(q - t0 + 8) * 256 + ch]);
      ds[t * 256 + ch] = s / (float)(hi - lo) - bf2f(us[(t + 8) * 256 + ch]);
    }
  }
  __syncthreads();
  {
    const int o = tid, gi = o >> 6;
    const float* wp = P.pool_w + ((size_t)l * 4 + gi) * 64 * 64 + (o & 63);
    float acc[32];
#pragma unroll
    for (int t = 0; t < 32; ++t) acc[t] = 0.f;
    for (int k = 0; k < 64; ++k) {
      const float wv = wp[k * 64];
#pragma unroll
      for (int t = 0; t < 32; ++t) acc[t] += ds[t * 256 + gi * 64 + k] * wv;
    }
    const float sc = P.pool_scale[l * 256 + o];
#pragma unroll
    for (int t = 0; t < 32; ++t) yp[(size_t)(r0 + t) * 256 + o] = f2bf(acc[t] * sc);
  }
  __syncthreads();
}

struct StridedRows {
  const bf16_t* base; long ld;
  DI const bf16_t* operator()(int m) const { return base + (long)m * ld; }
};
DI void fft_stage0_lat(const Params& P, int task, char* smem) {
  char* ws = P.ws;
  const int ntile = task & 3, n2 = (task >> 2) & 127, b = task >> 9;
  const bf16_t* fin = (const bf16_t*)(ws + oq(O_QPF)) + (size_t)3 * R * 256;
  f32x16 acc[2][2];
  acc[0][0] = acc[0][1] = acc[1][0] = acc[1][1] = fzero();
  StridedRows ar{fin + ((size_t)b * PB + n2) * 256, 128 * 256};
  gemm_main(ar, (const bf16_t*)(ws + oq(O_WC)) + (size_t)ntile * 128 * 256, 256, 256, smem, acc);
  bf16_t* Z1 = (bf16_t*)(ws + oq(O_Z1));
  const int lane = TIDX & 63, w = TIDX >> 6, wm = w >> 1, wn = w & 1, r = lane & 31, hh = lane >> 5;
#pragma unroll
  for (int mb = 0; mb < 2; ++mb)
#pragma unroll
    for (int nb2 = 0; nb2 < 2; ++nb2) {
      const int jj = ntile * 128 + wn * 64 + nb2 * 32 + r, part = jj >> 8, j = jj & 255;
#pragma unroll
      for (int g4 = 0; g4 < 4; ++g4) {
        const int n1 = wm * 64 + mb * 32 + 8 * g4 + 4 * hh;
        uint2 pk = {pack2(acc[mb][nb2][4 * g4], acc[mb][nb2][4 * g4 + 1]), pack2(acc[mb][nb2][4 * g4 + 2], acc[mb][nb2][4 * g4 + 3])};
        *(uint2*)(Z1 + (((size_t)(b * 128 + n2) * 256 + j) * 256 + part * 128 + n1)) = pk;
      }
    }
}
DI void fft_stage0_ctx(const Params& P, int task, char* smem) {
  char* ws = P.ws;
  const int ntile = task & 3, mtile = (task >> 2) & 1, b = task >> 3;
  const bf16_t* fin = (const bf16_t*)(ws + oq(O_QPF)) + (size_t)3 * R * 256;
  f32x16 acc[2][2];
  acc[0][0] = acc[0][1] = acc[1][0] = acc[1][1] = fzero();
  PlainRows ar{fin + ((size_t)b * PB + T + mtile * 128) * 256, 256};
  gemm_main(ar, (const bf16_t*)(ws + oq(O_WC)) + (size_t)ntile * 128 * 256, 256, 256, smem, acc);
  bf16_t* Z1c = (bf16_t*)(ws + oq(O_Z1C));
  const int lane = TIDX & 63, w = TIDX >> 6, wm = w >> 1, wn = w & 1, r = lane & 31, hh = lane >> 5;
#pragma unroll
  for (int mb = 0; mb < 2; ++mb)
#pragma unroll
    for (int nb2 = 0; nb2 < 2; ++nb2) {
      const int jj = ntile * 128 + wn * 64 + nb2 * 32 + r, part = jj >> 8, j = jj & 255;
#pragma unroll
      for (int g4 = 0; g4 < 4; ++g4) {
        const int n = mtile * 128 + wm * 64 + mb * 32 + 8 * g4 + 4 * hh;
        uint2 pk = {pack2(acc[mb][nb2][4 * g4], acc[mb][nb2][4 * g4 + 1]), pack2(acc[mb][nb2][4 * g4 + 2], acc[mb][nb2][4 * g4 + 3])};
        *(uint2*)(Z1c + (((size_t)(b * 256 + j)) * 512 + part * 256 + n)) = pk;
      }
    }
}
DI void fft_stage1_lat(const Params& P, int task, char* smem) {
  char* ws = P.ws;
  const int ntile = task & 1, j = (task >> 1) & 255, b = task >> 9;
  f32x16 acc[2][2];
  acc[0][0] = acc[0][1] = acc[1][0] = acc[1][1] = fzero();
  StridedRows ar{(const bf16_t*)(ws + oq(O_Z1)) + ((size_t)(b * 128) * 256 + j) * 256, 256 * 256};
  gemm_main(ar, (const bf16_t*)(ws + oq(O_D1)) + (size_t)ntile * 128 * 256, 256, 256, smem, acc);
  bf16_t* Z2 = (bf16_t*)(ws + oq(O_Z2));
  const int lane = TIDX & 63, w = TIDX >> 6, wm = w >> 1, wn = w & 1, r = lane & 31, hh = lane >> 5;
  const int k1 = (ntile * 2 + wn) * 32 + r;
#pragma unroll
  for (int mb = 0; mb < 2; ++mb)
#pragma unroll
    for (int g4 = 0; g4 < 4; ++g4) {
      const int n2 = wm * 64 + mb * 32 + 8 * g4 + 4 * hh;
      float yr[4], yi[4];
#pragma unroll
      for (int q = 0; q < 4; ++q) {
        const float re = acc[mb][0][4 * g4 + q], im = acc[mb][1][4 * g4 + q];
        float sn, cs; sincospif(2.f * (float)((k1 * (n2 + q)) & 16383) / 16384.f, &sn, &cs);
        yr[q] = re * cs + im * sn;
        yi[q] = im * cs - re * sn;
      }
      bf16_t* zp = Z2 + (((size_t)(b * 128 + k1) * 256 + j) * 256 + n2);
      uint2 pr = {pack2(yr[0], yr[1]), pack2(yr[2], yr[3])}, pi = {pack2(yi[0], yi[1]), pack2(yi[2], yi[3])};
      *(uint2*)zp = pr;
      *(uint2*)(zp + 128) = pi;
    }
}
DI void fft_stage1_ctx(const Params& P, int task, char* smem) {
  char* ws = P.ws;
  const int ntile = task & 1, mtile = (task >> 1) & 1, b = task >> 2;
  f32x16 acc[2][2];
  acc[0][0] = acc[0][1] = acc[1][0] = acc[1][1] = fzero();
  PlainRows ar{(const bf16_t*)(ws + oq(O_Z1C)) + ((size_t)(b * 256 + mtile * 128)) * 512, 512};
  gemm_main(ar, (const bf16_t*)(ws + oq(O_DC)) + (size_t)ntile * 128 * 512, 512, 512, smem, acc);
  bf16_t* f = (bf16_t*)(ws + oq(O_QPF)) + (size_t)3 * R * 256;
  const int lane = TIDX & 63, w = TIDX >> 6, wm = w >> 1, wn = w & 1, r = lane & 31, hh = lane >> 5;
#pragma unroll
  for (int mb = 0; mb < 2; ++mb)
#pragma unroll
    for (int nb2 = 0; nb2 < 2; ++nb2) {
      const int k = ntile * 128 + wn * 64 + nb2 * 32 + r;
#pragma unroll
      for (int g4 = 0; g4 < 4; ++g4) {
        const int j = mtile * 128 + wm * 64 + mb * 32 + 8 * g4 + 4 * hh;
        const float sc = 1.f / 256.f;
        uint2 pk = {pack2(acc[mb][nb2][4 * g4] * sc, acc[mb][nb2][4 * g4 + 1] * sc),
                    pack2(acc[mb][nb2][4 * g4 + 2] * sc, acc[mb][nb2][4 * g4 + 3] * sc)};
        *(uint2*)(f + ((size_t)b * PB + T + k) * 256 + j) = pk;
      }
    }
}
DI void fft_stage2_lat(const Params& P, int task, char* smem) {
  char* ws = P.ws;
  const int jt = task & 1, k1 = (task >> 1) & 127, b = task >> 8;
  f32x16 acc[2][2];
  acc[0][0] = acc[0][1] = acc[1][0] = acc[1][1] = fzero();
  PlainRows ar{(const bf16_t*)(ws + oq(O_Z2)) + ((size_t)(b * 128 + k1) * 256 + jt * 128) * 256, 256};
  gemm_main(ar, (const bf16_t*)(ws + oq(O_D2)), 256, 256, smem, acc);
  bf16_t* f = (bf16_t*)(ws + oq(O_QPF)) + (size_t)3 * R * 256;
  const int lane = TIDX & 63, w = TIDX >> 6, wm = w >> 1, wn = w & 1, r = lane & 31, hh = lane >> 5;
#pragma unroll
  for (int mb = 0; mb < 2; ++mb)
#pragma unroll
    for (int nb2 = 0; nb2 < 2; ++nb2) {
      const int k2 = wn * 64 + nb2 * 32 + r;
#pragma unroll
      for (int g4 = 0; g4 < 4; ++g4) {
        const int j = jt * 128 + wm * 64 + mb * 32 + 8 * g4 + 4 * hh;
        const float sc = 1.f / 2048.f;
        uint2 pk = {pack2(acc[mb][nb2][4 * g4] * sc, acc[mb][nb2][4 * g4 + 1] * sc),
                    pack2(acc[mb][nb2][4 * g4 + 2] * sc, acc[mb][nb2][4 * g4 + 3] * sc)};
        *(uint2*)(f + ((size_t)b * PB + k1 + 128 * k2) * 256 + j) = pk;
      }
    }
}
DI void fnet_final_tile(const Params& P, int l, int mt, int nt, char* smem) {
  char* ws = P.ws;
  const int r0 = mt * 128;
  f32x16 acc[2][2];
  acc[0][0] = acc[0][1] = acc[1][0] = acc[1][1] = fzero();
  PlainRows ar{(const bf16_t*)(ws + oq(O_QPF)) + (size_t)3 * R * 256 + (size_t)r0 * 256, 256};
  gemm_main(ar, (const bf16_t*)(ws + smallw(l) + oq(O_WT_FN)) + (size_t)nt * 128 * 256, 256, 256, smem, acc);
  bf16_t* yf = (bf16_t*)(ws + oq(O_Y)) + (size_t)3 * R * 256;
  const int lane = TIDX & 63, w = TIDX >> 6, wm = w >> 1, wn = w & 1, r = lane & 31, hh = lane >> 5;
#pragma unroll
  for (int mb = 0; mb < 2; ++mb)
#pragma unroll
    for (int nb2 = 0; nb2 < 2; ++nb2)
#pragma unroll
      for (int i = 0; i < 16; ++i) {
        const int m = wm * 64 + mb * 32 + crow(i, hh), n = nt * 128 + wn * 64 + nb2 * 32 + r;
        yf[(size_t)(r0 + m) * 256 + n] = f2bf(acc[mb][nb2][i]);
      }
}

DI void merge_tile(const Params& P, int l, int mt, int nt, char* smem) {
  char* ws = P.ws;
  const int r0 = mt * 128;
  const int tid = TIDX, lane = tid & 63, w = tid >> 6, wm = w >> 1, wn = w & 1, r = lane & 31, hh = lane >> 5;
  const bf16_t* gates = (const bf16_t*)(ws + oq(O_GATES));
  f32x16 tot[2][2], acc[2][2];
  tot[0][0] = tot[0][1] = tot[1][0] = tot[1][1] = fzero();
  acc[0][0] = acc[0][1] = acc[1][0] = acc[1][1] = fzero();
  const int lrow = tid >> 3, lcc = (tid & 7) * 8;
  const bf16_t* pa0 = (const bf16_t*)(ws + oq(O_Y)) + (size_t)(r0 + lrow) * 256 + lcc;
  const bf16_t* pb0 = (const bf16_t*)(ws + smallw(l) + oq(O_WT_BR)) + (size_t)(nt * 128 + lrow) * 256 + lcc;
  constexpr long SA = (long)R * 256, SB = (long)D * 256;
  u32x4 ra0[4], rb0[4];
  u32x4 gq[2][2][2];
#define M_OFFA(kt) (((kt) >> 2) * SA + ((kt) & 3) * 64)
#define M_OFFB(kt) (((kt) >> 2) * SB + ((kt) & 3) * 64)
#define M_LOAD1(RA, RB, kt, i) RA[i] = *(const u32x4*)(pa0 + M_OFFA(kt) + i * 32 * 256); RB[i] = *(const u32x4*)(pb0 + M_OFFB(kt) + i * 32 * 256);
#define M_LOAD(RA, RB, kt) { M_LOAD1(RA, RB, kt, 0) M_LOAD1(RA, RB, kt, 1) M_LOAD1(RA, RB, kt, 2) M_LOAD1(RA, RB, kt, 3) }
#define M_STORE1(RA, RB, i) *(u32x4*)(base_ + ((lrow + 32 * i) * LROW + lcc) * 2) = RA[i]; *(u32x4*)(base_ + TILEB + ((lrow + 32 * i) * LROW + lcc) * 2) = RB[i];
#define M_STORE(RA, RB, buf) { char* base_ = smem + (buf) * 2 * TILEB; M_STORE1(RA, RB, 0) M_STORE1(RA, RB, 1) M_STORE1(RA, RB, 2) M_STORE1(RA, RB, 3) }
#define M_STEP(ks) { \
      bf16x8 a0 = *(const bf16x8*)(bA_ + ks * 32); \
      bf16x8 a1 = *(const bf16x8*)(bA_ + 32 * LROW * 2 + ks * 32); \
      bf16x8 b0 = *(const bf16x8*)(bB_ + ks * 32); \
      bf16x8 b1 = *(const bf16x8*)(bB_ + 32 * LROW * 2 + ks * 32); \
      acc[0][0] = MFMA32(a0, b0, acc[0][0]); \
      acc[0][1] = MFMA32(a0, b1, acc[0][1]); \
      acc[1][0] = MFMA32(a1, b0, acc[1][0]); \
      acc[1][1] = MFMA32(a1, b1, acc[1][1]); }
#define M_COMPUTE(buf) { \
    const char* bA_ = smem + (buf) * 2 * TILEB + ((wm * 64 + r) * LROW + hh * 8) * 2; \
    const char* bB_ = smem + (buf) * 2 * TILEB + TILEB + ((wn * 64 + r) * LROW + hh * 8) * 2; \
    M_STEP(0) M_STEP(1) M_STEP(2) M_STEP(3) }
#define M_GLOAD(i) { \
    _Pragma("unroll") for (int mb = 0; mb < 2; ++mb) \
      _Pragma("unroll") for (int nb2 = 0; nb2 < 2; ++nb2) { \
        const int mt32 = mt * 4 + wm * 2 + mb, nt32 = (i) * 32 + nt * 4 + wn * 2 + nb2; \
        const u32x4* gp = (const u32x4*)(gates + (((size_t)mt32 * 128 + nt32) * 64 + lane) * 16); \
        gq[mb][nb2][0] = gp[0]; gq[mb][nb2][1] = gp[1]; } }
#define M_APPLY() { \
    _Pragma("unroll") for (int mb = 0; mb < 2; ++mb) \
      _Pragma("unroll") for (int nb2 = 0; nb2 < 2; ++nb2) { \
        _Pragma("unroll") for (int q = 0; q < 16; ++q) { \
          const unsigned wv = gq[mb][nb2][q >> 3][(q >> 1) & 3]; \
          const float gv = __uint_as_float((q & 1) ? (wv & 0xffff0000u) : (wv << 16)); \
          tot[mb][nb2][q] += gv * acc[mb][nb2][q]; } \
        acc[mb][nb2] = fzero(); } }
  M_GLOAD(0);
  M_LOAD(ra0, rb0, 0);
  M_STORE(ra0, rb0, 0);
  M_LOAD(ra0, rb0, 1);
#pragma unroll 1
  for (int kt = 0; kt < 16; kt += 2) {
    __syncthreads();
    M_STORE(ra0, rb0, 1);
    if (kt + 2 < 16) M_LOAD(ra0, rb0, kt + 2);
    M_COMPUTE(0);
    __syncthreads();
    if (kt + 2 < 16) {
      M_STORE(ra0, rb0, 0);
      if (kt + 3 < 16) M_LOAD(ra0, rb0, kt + 3);
    }
    M_COMPUTE(1);
    if ((kt & 3) == 2) {
      M_APPLY();
      if (kt + 2 < 16) M_GLOAD((kt + 2) >> 2);
    }
  }
  __syncthreads();
#undef M_OFFA
#undef M_OFFB
#undef M_LOAD1
#undef M_LOAD
#undef M_STORE1
#undef M_STORE
#undef M_STEP
#undef M_COMPUTE
#undef M_GLOAD
#undef M_APPLY
  bf16_t* am = (bf16_t*)(ws + oq(O_ACCM));
#pragma unroll
  for (int mb = 0; mb < 2; ++mb)
#pragma unroll
    for (int nb2 = 0; nb2 < 2; ++nb2)
#pragma unroll
      for (int q = 0; q < 16; ++q) {
        const int m = wm * 64 + mb * 32 + crow(q, hh), n = nt * 128 + wn * 64 + nb2 * 32 + r;
        am[(size_t)(r0 + m) * D + n] = f2bf(tot[mb][nb2][q]);
      }
}
DI void outproj_tile(const Params& P, int l, int mt, int nt, char* smem) {
  char* ws = P.ws;
  const int r0 = mt * 128;
  f32x16 acc[2][4];
  zero_acc8(acc);
  PlainRows ar{(const bf16_t*)(ws + oq(O_ACCM)) + (size_t)r0 * D, D};
  gemm_main2(ar, (const bf16_t*)(ws + smallw(l) + oq(O_WT_OUT)) + (size_t)nt * 256 * D, D, D, smem, acc);
  const int lane = TIDX & 63, w = TIDX >> 6, wm = w >> 1, wn = w & 1, r = lane & 31, hh = lane >> 5;
  const int s = row_modsel(r0);
  const float* gt1 = (const float*)(ws + oq(O_MOD)) + ((size_t)l * 3 + s) * INC + 2 * D;
#pragma unroll
  for (int mb = 0; mb < 2; ++mb)
#pragma unroll
    for (int q = 0; q < 16; ++q) {
      const int m = wm * 64 + mb * 32 + crow(q, hh);
      const float* xi = (l == 0) ? x_in_row(P, r0 + m) : x_buf_row(P, r0 + m);
      float* xo = x_buf_row(P, r0 + m);
#pragma unroll
      for (int nb2 = 0; nb2 < 4; ++nb2) {
        const int n = nt * 256 + wn * 128 + nb2 * 32 + r;
        xo[n] = xi[n] + gt1[n] * acc[mb][nb2][q];
      }
    }
}

template <int NPT>
DI void topk_task(const Params& P, int smp, int e, char* smem) {
  char* ws = P.ws;
  constexpr int N = NPT * 256;
  constexpr int cap = N / 8;
  const int tid = TIDX, lane = tid & 63, w = tid >> 6;
  float* sv = (float*)smem;
  int* red = (int*)(smem + 65536);
  int* cg_ = (int*)(smem + 65536 + 64);
  int* ce_ = cg_ + 256;
  const float* aff = (const float*)(ws + oq(O_AFF)) + ((size_t)smp * NE + e) * T;
  for (int i = tid; i < N; i += 256) sv[i] = aff[i];
  __syncthreads();
  unsigned u[NPT];
#pragma unroll
  for (int j = 0; j < NPT; ++j) u[j] = __float_as_uint(sv[tid * NPT + j]);
  unsigned thr = 0;
  for (int bit = 30; bit >= 0; --bit) {
    const unsigned cand = thr | (1u << bit);
    int cnt = 0;
#pragma unroll
    for (int j = 0; j < NPT; ++j) cnt += (u[j] >= cand) ? 1 : 0;
#pragma unroll
    for (int o = 32; o >= 1; o >>= 1) cnt += __shfl_xor(cnt, o, 64);
    if (lane == 0) red[w] = cnt;
    __syncthreads();
    const int total = red[0] + red[1] + red[2] + red[3];
    __syncthreads();
    if (total >= cap) thr = cand;
  }
  int ng = 0, neq = 0;
#pragma unroll
  for (int j = 0; j < NPT; ++j) { ng += (u[j] > thr) ? 1 : 0; neq += (u[j] == thr) ? 1 : 0; }
  cg_[tid] = ng; ce_[tid] = neq;
  __syncthreads();
  int pg = 0, pe = 0, totg = 0;
  for (int i = 0; i < 256; ++i) {
    const int a = cg_[i], bq = ce_[i];
    if (i < tid) { pg += a; pe += bq; }
    totg += a;
  }
  const int need_eq = cap - totg;
  int* rows = (int*)(ws + oq(O_ROWS)) + (size_t)e * SLOTS;
  float* gl = (float*)(ws + oq(O_GL)) + (size_t)e * SLOTS;
  const int slot_base = smp < 2 ? smp * 2048 : 4096 + (smp - 2) * 32;
  const int row_base = smp < 2 ? smp * PB : (smp - 2) * PB + T;
#pragma unroll
  for (int j = 0; j < NPT; ++j) {
    const int idx = tid * NPT + j;
    int slot = -1;
    if (u[j] > thr) { slot = pg; ++pg; }
    else if (u[j] == thr) { if (pe < need_eq) slot = totg + pe; ++pe; }
    if (slot >= 0) { rows[slot_base + slot] = row_base + idx; gl[slot_base + slot] = __uint_as_float(u[j]); }
  }
  if (smp == 0 && tid < 64) rows[4160 + tid] = -1;
  __syncthreads();
}

struct GatherRows {
  const bf16_t* base; const int* rows;
  DI const bf16_t* operator()(int m) const { int rr = rows[m]; return base + (size_t)(rr < 0 ? 0 : rr) * D; }
};
DI void expert1_tile(const Params& P, int e, int mt, int nt, char* smem) {
  char* ws = P.ws;
  f32x16 acc[2][4];
  zero_acc8(acc);
  GatherRows ar{(const bf16_t*)(ws + oq(O_H)), (const int*)(ws + oq(O_ROWS)) + (size_t)e * SLOTS + mt * 128};
  gemm_main2(ar, (const bf16_t*)(ws + oq(O_WT_13)) + ((size_t)e * 2 * FF + nt * 256) * D, D, D, smem, acc);
  bf16_t* hid = (bf16_t*)(ws + oq(O_HID)) + ((size_t)e * SLOTS + mt * 128) * FF;
  const int lane = TIDX & 63, w = TIDX >> 6, wm = w >> 1, wn = w & 1, r = lane & 31, hh = lane >> 5;
#pragma unroll
  for (int pr = 0; pr < 2; ++pr) {
    const int f = nt * 128 + wn * 64 + pr * 32 + r;
#pragma unroll
    for (int mb = 0; mb < 2; ++mb)
#pragma unroll
      for (int q = 0; q < 16; ++q) {
        const int m = wm * 64 + mb * 32 + crow(q, hh);
        const float gv = acc[mb][2 * pr][q], uv = acc[mb][2 * pr + 1][q];
        hid[(size_t)m * FF + f] = f2bf(gv / (1.f + __expf(-gv)) * uv);
      }
  }
}
DI void expert2_tile(const Params& P, int l, int e, int mt, int nt, char* smem) {
  char* ws = P.ws;
  f32x16 acc[2][4];
  zero_acc8(acc);
  PlainRows ar{(const bf16_t*)(ws + oq(O_HID)) + ((size_t)e * SLOTS + mt * 128) * FF, FF};
  gemm_main2(ar, (const bf16_t*)(ws + oq(O_WT_2)) + ((size_t)e * D + nt * 256) * FF, FF, FF, smem, acc);
  const int* rows = (const int*)(ws + oq(O_ROWS)) + (size_t)e * SLOTS + mt * 128;
  const float* gl = (const float*)(ws + oq(O_GL)) + (size_t)e * SLOTS + mt * 128;
  const int lane = TIDX & 63, w = TIDX >> 6, wm = w >> 1, wn = w & 1, r = lane & 31, hh = lane >> 5;
#pragma unroll
  for (int mb = 0; mb < 2; ++mb)
#pragma unroll
    for (int q = 0; q < 16; ++q) {
      const int m = wm * 64 + mb * 32 + crow(q, hh);
      const int row = rows[m];
      if (row < 0) continue;
      const float gv = gl[m];
      const float* gt2 = (const float*)(ws + oq(O_MOD)) + ((size_t)l * 3 + row_modsel(row)) * INC + 5 * D;
      float* xo = x_buf_row(P, row);
#pragma unroll
      for (int nb2 = 0; nb2 < 4; ++nb2) {
        const int n = nt * 256 + wn * 128 + nb2 * 32 + r;
        unsafeAtomicAdd(xo + n, gt2[n] * gv * acc[mb][nb2][q]);
      }
    }
}

#define XB_TMO      128
#define XB_XCNT(j)  (256  + 64 * (j))
#define XB_XSUB(j)  (1280 + 64 * (j))
#define XB_XGEN(j)  (2304 + 64 * (j))
#define XB_TOP      3328
#define XB_TOPGEN   3392
#define XCD_BAR_WORDS 3456
#define XB_SPIN_CAP (1u << 18)
#define LAS __attribute__((address_space(3)))

__device__ __forceinline__ unsigned xb_ld(unsigned* p)              { return __hip_atomic_load(p, __ATOMIC_RELAXED, __HIP_MEMORY_SCOPE_AGENT); }
__device__ __forceinline__ unsigned xb_add(unsigned* p, unsigned v) { return __hip_atomic_fetch_add(p, v, __ATOMIC_RELAXED, __HIP_MEMORY_SCOPE_AGENT); }
__device__ __forceinline__ unsigned xb_xcc_id() { return (unsigned)__builtin_amdgcn_s_getreg((3 << 11) | 20) & 0xFu; }
#define XB_SPIN(cond, bar) do { unsigned _sp = 0; while (cond) { __builtin_amdgcn_s_sleep(1); \
    if ((++_sp & 255u) == 0u) { if (xb_ld(&(bar)[XB_TMO])) break; if (_sp > XB_SPIN_CAP) { atomicAdd(&(bar)[XB_TMO], 1u); break; } } } } while (0)

struct XcdBarrier {
    unsigned* bar; unsigned x;
    volatile LAS unsigned* st;
};

__device__ __forceinline__ XcdBarrier xcd_barrier_post(unsigned* bar, volatile LAS unsigned* st) {
    XcdBarrier b; b.bar = bar; b.x = xb_xcc_id(); b.st = st;
    if (threadIdx.x == 0) (void)xb_add(&bar[XB_XCNT(b.x)], 1u);
    return b;
}
__device__ __forceinline__ void xcd_barrier_complete(unsigned* bar, unsigned x, unsigned& nloc, unsigned& nx) {
    const unsigned G = gridDim.x * gridDim.y * gridDim.z;
    unsigned sum, cnt, mine, sp = 0u;
    for (;;) {
        sum = 0u; cnt = 0u; mine = 0u;
#pragma unroll
        for (unsigned j = 0; j < 16; ++j) { const unsigned c = xb_ld(&bar[XB_XCNT(j)]); sum += c; cnt += (c > 0u) ? 1u : 0u; mine = (j == x) ? c : mine; }
        if (sum == G) break;
        __builtin_amdgcn_s_sleep(1);
        if ((++sp & 255u) == 0u) { if (xb_ld(&bar[XB_TMO])) break; if (sp > XB_SPIN_CAP) { atomicAdd(&bar[XB_TMO], 1u); break; } }
    }
    nloc = mine > 0u ? mine : 1u; nx = cnt > 0u ? cnt : 1u;
}

__device__ __forceinline__ void xcd_barrier(const XcdBarrier& b) {
    asm volatile("s_waitcnt vmcnt(0)" ::: "memory");
    __syncthreads();
    if (threadIdx.x == 0) {
        unsigned* bar = b.bar;
        __builtin_amdgcn_s_waitcnt(0);
        unsigned nloc = b.st[0], nx = b.st[1];
        if (nloc == 0u) { xcd_barrier_complete(bar, b.x, nloc, nx); b.st[0] = nloc; b.st[1] = nx; }
        const unsigned old = xb_add(&bar[XB_XSUB(b.x)], 1u);
        const unsigned gen = old / nloc;
        if (old + 1u == (gen + 1u) * nloc) {
            __builtin_amdgcn_fence(__ATOMIC_RELEASE, "agent");
            asm volatile("s_waitcnt vmcnt(0)" ::: "memory");
            const unsigned og = xb_add(&bar[XB_TOP], 1u);
            const unsigned tg = og / nx;
            if (og + 1u == (tg + 1u) * nx) xb_add(&bar[XB_TOPGEN], 1u);
            else XB_SPIN(xb_ld(&bar[XB_TOPGEN]) == tg, bar);
            __builtin_amdgcn_fence(__ATOMIC_ACQUIRE, "agent");
            xb_add(&bar[XB_XGEN(b.x)], 1u);
            asm volatile("s_waitcnt vmcnt(0)" ::: "memory");
        } else {
            XB_SPIN(xb_ld(&bar[XB_XGEN(b.x)]) == gen, bar);
            __builtin_amdgcn_fence(__ATOMIC_ACQUIRE, "agent");
            asm volatile("s_waitcnt vmcnt(0)" ::: "memory");
        }
    }
    __syncthreads();
}


constexpr int NPL = 12;
constexpr int NPHASE = 1 + 2 * NPL;

DI void run_phase0(const Params& P, char* smem) {
  const int bid = opaque_bid(), nb = gridDim.x;
  {
    for (int t = bid; t < 192 + 64 + 2 * WT_SMALL; t += nb) {
      if (t < 192) ada_task(P, t, smem);
      else if (t < 256) tables_task(P, t - 192);
      else if (t < 256 + WT_SMALL) convert_weight_tile(P, 0, t - 256, smem);
      else convert_weight_tile(P, 1, t - 256 - WT_SMALL, smem);
    }
  }
}
template <int SP>
DI void run_sub(const Params& P, int l, char* smem) {
  const int bid = opaque_bid(), nb = gridDim.x;
  const bool last = l == 1;
  if constexpr (SP == 0) {
      modnorm_phase(P, l, false, bid, nb, smem);
  }
  if constexpr (SP == 1) {
      const int x = bid & 7, j = bid >> 3, nbx = nb >> 3;
      if (bid < nbx * 8)
        for (int lt = j; lt < 130 * 6; lt += nbx) {
          const int g = x & 3, ci = lt % 6;
          const int mt = (x >> 2) * 130 + lt / 6, nt = ci == 0 ? g : (ci == 1 ? 20 + g : 4 * g + 2 + ci);
          if (last && (mt % 130) >= 128 && nt < 20) continue;
          inproj_tile(P, l, mt, nt, smem);
        }
  }
  if constexpr (SP == 2) {
      const bool conv_first = (bid >= (nb >> 1));
      if (conv_first)
        for (int t = bid - (nb >> 1); t < WT_TILES - WT_SMALL; t += nb) convert_weight_tile(P, l, WT_SMALL + t, smem);
      {
        const int x = bid & 7, j = bid >> 3, nbx = nb >> 3;
        if (bid < nbx * 8) {
          for (int q = j; q < 128; q += nbx) diffattn_task(P, l, x >> 2, x & 3, q * 128, 0, PB, smem);
          if (!last && j < 2) diffattn_task(P, l, x >> 2, x & 3, T + j * 128, T, CTXL, smem);
        }
      }
#ifndef PROBE_PART
#define PROBE_PART 0
#endif
#pragma unroll 1
      for (int rep = 0; rep < 1 + PROBE_PART; ++rep) {
      {
        const int x = bid & 7, j = bid >> 3, nbx = nb >> 3;
        if (bid < nbx * 8) {
          for (int q = j; q < 64; q += nbx) na_task(P, l, x >> 2, false, (x & 3) * 64 + q, 0, smem);
          if (!last && j == 0) na_task(P, l, x >> 2, true, 0, (x & 3) * 2, smem);
        }
      }
      for (int tile = bid; tile < 1040; tile += nb) {
        const bool isctx = (tile % 520) >= 512;
        if (!(last && isctx)) pool_task(P, l, tile, smem);
      }
      for (int t = bid; t < 1024; t += nb) fft_stage0_lat(P, t, smem);
      if (!last) for (int t = bid; t < 16; t += nb) fft_stage0_ctx(P, t, smem);      }
      if (!conv_first)
        for (int t = bid + (nb >> 1); t < WT_TILES - WT_SMALL; t += nb) convert_weight_tile(P, l, WT_SMALL + t, smem);

  }
  if constexpr (SP == 3) {
      const int n = 1024 + (last ? 0 : 8);
      for (int t = bid; t < n; t += nb) { if (t < 1024) fft_stage1_lat(P, t, smem); else fft_stage1_ctx(P, t - 1024, smem); }
  }
  if constexpr (SP == 4) {
      for (int t = bid; t < 512; t += nb) fft_stage2_lat(P, t, smem);
  }
  if constexpr (SP == 5) {
      for (int t = bid; t < 520; t += nb) { const int mt = t >> 1; if (last && (mt % 130) >= 128) continue; fnet_final_tile(P, l, mt, t & 1, smem); }
  }
  if constexpr (SP == 6) {
      const int x = bid & 7, j = bid >> 3, nbx = nb >> 3;
      if (bid < nbx * 8)
        for (int lt = j; lt < 33 * 8; lt += nbx) {
          const int mt = x + 8 * (lt >> 3);
          if (mt >= 260 || (last && (mt % 130) >= 128)) continue;
          merge_tile(P, l, mt, lt & 7, smem);
        }
  }
  if constexpr (SP == 7) {
      const int x = bid & 7, j = bid >> 3, nbx = nb >> 3;
      if (bid < nbx * 8)
        for (int lt = j; lt < 33 * 4; lt += nbx) {
          const int mt = x + 8 * (lt >> 2);
          if (mt >= 260 || (last && (mt % 130) >= 128)) continue;
          outproj_tile(P, l, mt, lt & 3, smem);
        }
  }
  if constexpr (SP == 8) { modnorm_phase(P, l, true, bid, nb, smem); }
  if constexpr (SP == 9) {
      const int n = last ? 32 : 64;
      for (int t = bid; t < n; t += nb) {
        const int smp = t >> 4, e = t & 15;
        if (smp < 2) topk_task<64>(P, smp, e, smem); else topk_task<1>(P, smp, e, smem);
      }
  }
  if constexpr (SP == 10) {
      const int nmt = last ? 32 : 33;
      const int x = bid & 7, j = bid >> 3, nbx = nb >> 3, npairs = NE * nmt;
      if (bid < nbx * 8)
        for (int lt = j; lt < ((npairs + 7) >> 3) * 11; lt += nbx) {
          const int p = x + 8 * (lt / 11);
          if (p >= npairs) continue;
          expert1_tile(P, p / nmt, p % nmt, lt % 11, smem);
        }
  }
  if constexpr (SP == 11) {
      const int nmt = last ? 32 : 33;
      const int x = bid & 7, j = bid >> 3, nbx = nb >> 3, npairs = NE * nmt;
      if (bid < nbx * 8)
        for (int lt = j; lt < ((npairs + 7) >> 3) * 4; lt += nbx) {
          const int p = x + 8 * (lt >> 2);
          if (p >= npairs) continue;
          expert2_tile(P, l, p / nmt, p % nmt, lt & 3, smem);
        }
  }
}

__shared__ __attribute__((aligned(16))) char g_smem[SMEM_BYTES];

#if ONE_LAUNCH
#ifndef PROBE_DUP
#define PROBE_DUP -1
#endif
#ifndef PROBE_MASK
#define PROBE_MASK 0
#endif
#define PH_STEP(SPV, L)                                \
  xcd_barrier(xb);                                     \
  run_sub<SPV>(P, L, g_smem);                          \
  if (SPV == PROBE_DUP || ((PROBE_MASK >> SPV) & 1)) { xcd_barrier(xb); run_sub<SPV>(P, L, g_smem); }
#define PH_LAYER(L)                                                                      \
  PH_STEP(0, L) PH_STEP(1, L) PH_STEP(2, L) PH_STEP(3, L) PH_STEP(4, L) PH_STEP(5, L)    \
  PH_STEP(6, L) PH_STEP(7, L) PH_STEP(8, L) PH_STEP(9, L) PH_STEP(10, L) PH_STEP(11, L)
#define PH_LAYER0_NOSYNC                                                                 \
  run_sub<0>(P, 0, g_smem);                                                              \
  PH_STEP(1, 0) PH_STEP(2, 0) PH_STEP(3, 0) PH_STEP(4, 0) PH_STEP(5, 0)                  \
  PH_STEP(6, 0) PH_STEP(7, 0) PH_STEP(8, 0) PH_STEP(9, 0) PH_STEP(10, 0) PH_STEP(11, 0)
__shared__ uint4 xb_words;
__global__ void __launch_bounds__(256, 2) mega(Params P) {
  cg::grid_group grid = cg::this_grid();
  if (threadIdx.x == 0) xb_words = make_uint4(0u, 0u, 0u, 0u);
  __syncthreads();
  XcdBarrier xb = xcd_barrier_post((unsigned*)(P.ws + O_BAR), (volatile LAS unsigned*)&xb_words);
  run_phase0(P, g_smem);
  if (xb_ld((unsigned*)(P.ws + O_BAR) + XB_TMO) == 0xFFFFFFFFu) grid.sync();
  xcd_barrier(xb);
  PH_LAYER0_NOSYNC
  PH_LAYER(1)
}
#else
__global__ void __launch_bounds__(256, 2) kphase0(Params P) { run_phase0(P, g_smem); }
template <int SP>
__global__ void __launch_bounds__(256, 2) kphase(Params P, int l) { run_sub<SP>(P, l, g_smem); }
#endif

extern "C" void kernel_launch(void* const* d_in, const int* in_sizes, int n_in, void* d_out, int out_size, void* d_ws,
                              size_t ws_size, hipStream_t stream) {
  static int grid_blocks = 0;
  if (!grid_blocks) {
    int dev = 0, cus = 0, per_cu = 0;
    (void)hipGetDevice(&dev);
    (void)hipDeviceGetAttribute(&cus, hipDeviceAttributeMultiprocessorCount, dev);
#if ONE_LAUNCH
    (void)hipOccupancyMaxActiveBlocksPerMultiprocessor(&per_cu, mega, 256, 0);
#else
    per_cu = 2;
#endif
    if (per_cu < 1) per_cu = 1;
    if (per_cu > 2) per_cu = 2;
    grid_blocks = cus * per_cu;
  }
  if (ws_size < WS_TOTAL) { fprintf(stderr, "workspace too small: %zu < %zu\n", ws_size, (size_t)WS_TOTAL); }
  Params P{};
  const float** pp = (const float**)&P;
  for (int i = 0; i < 25; ++i) pp[i] = (const float*)d_in[i];
  P.out = (float*)d_out;
  P.ws = (char*)d_ws;
#if ONE_LAUNCH
  (void)hipMemsetAsync((char*)d_ws + O_BAR, 0, 16384, stream);
  void* args[] = {&P};
  hipError_t e = hipLaunchCooperativeKernel((void*)mega, dim3(grid_blocks), dim3(256), args, 0, stream);
  if (e != hipSuccess) fprintf(stderr, "cooperative launch failed: %s (grid %d)\n", hipGetErrorString(e), grid_blocks);
#else
  const dim3 g(grid_blocks), b(256);
  kphase0<<<g, b, 0, stream>>>(P);
  for (int l = 0; l < 2; ++l) {
    kphase<0><<<g, b, 0, stream>>>(P, l);
    kphase<1><<<g, b, 0, stream>>>(P, l);
    kphase<2><<<g, b, 0, stream>>>(P, l);
    kphase<3><<<g, b, 0, stream>>>(P, l);
    kphase<4><<<g, b, 0, stream>>>(P, l);
    kphase<5><<<g, b, 0, stream>>>(P, l);
    kphase<6><<<g, b, 0, stream>>>(P, l);
    kphase<7><<<g, b, 0, stream>>>(P, l);
    kphase<8><<<g, b, 0, stream>>>(P, l);
    kphase<9><<<g, b, 0, stream>>>(P, l);
    kphase<10><<<g, b, 0, stream>>>(P, l);
    kphase<11><<<g, b, 0, stream>>>(P, l);
  }
#endif
}
```

```cpp
#include <hip/hip_runtime.h>
#include <hip/hip_cooperative_groups.h>
#include <stdint.h>
#include <cstdio>
namespace cg = cooperative_groups;

#ifndef ONE_LAUNCH
#define ONE_LAUNCH 1
#endif

#define DI __device__ __forceinline__
typedef unsigned short bf16_t;
using bf16x8 = __attribute__((ext_vector_type(8))) short;
using s16x4 = __attribute__((ext_vector_type(4))) short;
using u32x4 = __attribute__((ext_vector_type(4))) unsigned;
using f32x16 = __attribute__((ext_vector_type(16))) float;
typedef __bf16 bf2_t __attribute__((ext_vector_type(2)));
typedef float f2_t __attribute__((ext_vector_type(2)));
#define MFMA32(a, b, c) __builtin_amdgcn_mfma_f32_32x32x16_bf16((a), (b), (c), 0, 0, 0)

constexpr int D = 1024;
constexpr int T = 16384;
constexpr int CTXL = 256;
constexpr int PB = T + CTXL;
constexpr int R = 2 * PB;
constexpr int INC = 6144;
constexpr int NE = 16;
constexpr int FF = 1408;
constexpr int SLOTS = 4224;
constexpr float EPS = 1e-6f;
constexpr float LOG2E = 1.4426950408889634f;
constexpr float TWO_PI_UNUSED = 6.283185307179586f;

constexpr size_t AL(size_t x) { return (x + 255) & ~(size_t)255; }
constexpr size_t O_WT_IN = 0;
constexpr size_t O_WT_BR = O_WT_IN + (size_t)INC * D * 2;
constexpr size_t O_WT_OUT = O_WT_BR + (size_t)4 * D * 256 * 2;
constexpr size_t O_WT_FN = O_WT_OUT + (size_t)D * D * 2;
constexpr size_t O_WT_13 = O_WT_FN + (size_t)256 * 256 * 2;
constexpr size_t O_WT_2 = O_WT_13 + (size_t)NE * 2 * FF * D * 2;
constexpr size_t O_WC = O_WT_2 + (size_t)NE * D * FF * 2;
constexpr size_t O_D1 = O_WC + (size_t)512 * 256 * 2;
constexpr size_t O_D2 = O_D1 + (size_t)256 * 256 * 2;
constexpr size_t O_DC = O_D2 + (size_t)128 * 256 * 2;
constexpr size_t O_ROPE = O_DC + (size_t)256 * 512 * 2;
constexpr size_t O_MOD = O_ROPE + (size_t)256 * 8 * 2 * 4;
constexpr size_t O_CONST = O_MOD + (size_t)2 * 3 * INC * 4;
constexpr size_t O_H = AL(O_CONST + 256);
constexpr size_t O_Z1 = O_H;
constexpr size_t O_Z2 = O_H + (size_t)2 * T * 512 * 2;
constexpr size_t O_Z1C = O_Z2 + (size_t)2 * T * 512 * 2;
constexpr size_t O_QPF = O_H + (size_t)R * D * 2;
constexpr size_t SZ256 = (size_t)R * 256 * 2;
constexpr size_t O_ACCM = O_QPF;
constexpr size_t O_GATES = O_QPF + 4 * SZ256;
constexpr size_t O_HID = O_GATES;
constexpr size_t O_KV = O_GATES + (size_t)R * 4096 * 2;
constexpr size_t O_Y = O_KV + 4 * SZ256;
constexpr size_t O_XCTX = O_Y + 4 * SZ256;
constexpr size_t O_AFF = O_XCTX + (size_t)512 * D * 4;
constexpr size_t O_ROWS = O_AFF + (size_t)4 * NE * T * 4;
constexpr size_t O_GL = O_ROWS + (size_t)NE * SLOTS * 4;
constexpr size_t O_BAR = AL(O_GL + (size_t)NE * SLOTS * 4);
constexpr size_t O_SMALLW1 = O_BAR + 16384;
constexpr size_t SMALLW = O_WT_13;
constexpr size_t WS_TOTAL = O_SMALLW1 + SMALLW;
static_assert(O_Z1C + (size_t)2 * 256 * 512 * 2 <= O_QPF, "fft scratch must fit in h");
static_assert((size_t)NE * SLOTS * FF * 2 <= (size_t)R * 4096 * 2, "hid must fit in gates");

struct Params {
  const float *x, *c, *ctx, *c_ctx, *w_ada, *b_ada, *g_mix, *g_ffn, *w_in, *na_q_g, *na_k_g, *na_rpb, *df_q_g,
      *df_k_g, *df_lambda, *df_subln_g, *pool_w, *pool_scale, *fnet_w, *w_branch, *w_out, *w_router, *w_gate_e,
      *w_up_e, *w_down_e;
  float* out;
  char* ws;
};

constexpr int SMEM_BYTES = 73728;
constexpr int LROW = 72;
constexpr int TILEB = 128 * LROW * 2;

DI int opaque_tid() { int t = threadIdx.x; asm volatile("" : "+v"(t)); return t; }
DI int opaque_bid() { int t = blockIdx.x; asm volatile("" : "+s"(t)); return t; }
DI size_t oq(size_t x) { asm volatile("" : "+s"(x)); return x; }
#define TIDX opaque_tid()
DI float bf2f(bf16_t b) { return __uint_as_float(((unsigned)b) << 16); }
DI unsigned pack2(float a, float b) {
  f2_t v = {a, b};
  bf2_t r = __builtin_convertvector(v, bf2_t);
  return __builtin_bit_cast(unsigned, r);
}
DI bf16_t f2bf(float a) { return (bf16_t)(pack2(a, 0.f) & 0xffffu); }
DI bf16x8 pack8(float a0, float a1, float a2, float a3, float a4, float a5, float a6, float a7) {
  uint4 u = {pack2(a0, a1), pack2(a2, a3), pack2(a4, a5), pack2(a6, a7)};
  return __builtin_bit_cast(bf16x8, u);
}
DI float wave_sum(float v) {
#pragma unroll
  for (int o = 32; o >= 1; o >>= 1) v += __shfl_xor(v, o, 64);
  return v;
}
DI int crow(int i, int hh) { return (i & 3) + 8 * (i >> 2) + 4 * hh; }
DI f32x16 fzero() {
  f32x16 z;
#pragma unroll
  for (int i = 0; i < 16; ++i) z[i] = 0.f;
  return z;
}
DI void row_info(int r, int& b, int& p) { b = r >= PB ? 1 : 0; p = r - b * PB; }
DI const float* x_in_row(const Params& P, int r) {
  int b, p; row_info(r, b, p);
  return p < T ? P.x + ((size_t)b * T + p) * D : P.ctx + ((size_t)b * CTXL + (p - T)) * D;
}
DI float* x_buf_row(const Params& P, int r) {
  int b, p; row_info(r, b, p);
  return p < T ? P.out + ((size_t)b * T + p) * D : (float*)(P.ws + oq(O_XCTX)) + ((size_t)b * CTXL + (p - T)) * D;
}
DI int row_modsel(int r) { int b, p; row_info(r, b, p); return p < T ? b : 2; }

template <class ARow>
DI void gemm_main(ARow arow, const bf16_t* __restrict__ Bt, long ldb, int K, char* smem, f32x16 (&acc)[2][2]) {
  const int tid = TIDX, lane = tid & 63, w = tid >> 6, wm = w >> 1, wn = w & 1;
  const int r = lane & 31, hh = lane >> 5;
  const int lrow = tid >> 3, lcc = (tid & 7) * 8;
  const bf16_t* pa[4];
#pragma unroll
  for (int i = 0; i < 4; ++i) pa[i] = arow(lrow + 32 * i) + lcc;
  const bf16_t* pb0 = Bt + (long)lrow * ldb + lcc;
  const long ldb32 = 32 * ldb;
  u32x4 ra0[4], rb0[4], ra1[4], rb1[4];
  const int nk = K >> 6;
#define G_LOAD1(RA, RB, kt, i) RA[i] = *(const u32x4*)(pa[i] + (kt) * 64); RB[i] = *(const u32x4*)(pb0 + i * ldb32 + (kt) * 64);
#define G_LOAD(RA, RB, kt) { G_LOAD1(RA, RB, kt, 0) G_LOAD1(RA, RB, kt, 1) G_LOAD1(RA, RB, kt, 2) G_LOAD1(RA, RB, kt, 3) }
#define G_STORE1(RA, RB, i) *(u32x4*)(base_ + ((lrow + 32 * i) * LROW + lcc) * 2) = RA[i]; *(u32x4*)(base_ + TILEB + ((lrow + 32 * i) * LROW + lcc) * 2) = RB[i];
#define G_STORE(RA, RB, buf) { char* base_ = smem + (buf) * 2 * TILEB; G_STORE1(RA, RB, 0) G_STORE1(RA, RB, 1) G_STORE1(RA, RB, 2) G_STORE1(RA, RB, 3) }
#define G_STEP(ks) { \
      bf16x8 a0 = *(const bf16x8*)(bA_ + ks * 32); \
      bf16x8 a1 = *(const bf16x8*)(bA_ + 32 * LROW * 2 + ks * 32); \
      bf16x8 b0 = *(const bf16x8*)(bB_ + ks * 32); \
      bf16x8 b1 = *(const bf16x8*)(bB_ + 32 * LROW * 2 + ks * 32); \
      acc[0][0] = MFMA32(a0, b0, acc[0][0]); \
      acc[0][1] = MFMA32(a0, b1, acc[0][1]); \
      acc[1][0] = MFMA32(a1, b0, acc[1][0]); \
      acc[1][1] = MFMA32(a1, b1, acc[1][1]); }
#define G_COMPUTE(buf) { \
    const char* bA_ = smem + (buf) * 2 * TILEB + ((wm * 64 + r) * LROW + hh * 8) * 2; \
    const char* bB_ = smem + (buf) * 2 * TILEB + TILEB + ((wn * 64 + r) * LROW + hh * 8) * 2; \
    G_STEP(0) G_STEP(1) G_STEP(2) G_STEP(3) }
  G_LOAD(ra0, rb0, 0);
  if (nk > 1) G_LOAD(ra1, rb1, 1);
  G_STORE(ra0, rb0, 0);
  if (nk > 2) G_LOAD(ra0, rb0, 2);
  for (int kt = 0; kt < nk; kt += 2) {
    __syncthreads();
    if (kt + 1 < nk) {
      G_STORE(ra1, rb1, 1);
      if (kt + 3 < nk) G_LOAD(ra1, rb1, kt + 3);
    }
    G_COMPUTE(0);
    if (kt + 1 < nk) {
      __syncthreads();
      if (kt + 2 < nk) {
        G_STORE(ra0, rb0, 0);
        if (kt + 4 < nk) G_LOAD(ra0, rb0, kt + 4);
      }
      G_COMPUTE(1);
    }
  }
  __syncthreads();
#undef G_LOAD
#undef G_STORE
#undef G_COMPUTE
#undef G_LOAD1
#undef G_STORE1
#undef G_STEP
}
struct PlainRows {
  const bf16_t* base; long ld;
  DI const bf16_t* operator()(int m) const { return base + (long)m * ld; }
};

constexpr int T2_B_OFF = 128 * LROW * 2;
template <class ARow>
DI void gemm_main2(ARow arow, const bf16_t* __restrict__ Bt, long ldb, int K, char* smem, f32x16 (&acc)[2][4]) {
  const int tid = TIDX, lane = tid & 63, w = tid >> 6, wm = w >> 1, wn = w & 1;
  const int r = lane & 31, hh = lane >> 5;
  const int lrow = tid >> 3, lcc = (tid & 7) * 8;
  const bf16_t* pa[4];
#pragma unroll
  for (int i = 0; i < 4; ++i) pa[i] = arow(lrow + 32 * i) + lcc;
  const bf16_t* pb0 = Bt + (long)lrow * ldb + lcc;
  const long ldb32 = 32 * ldb;
  u32x4 ra[4], rb[8];
  const int nk = K >> 6;
#define H_LA(i, kt) ra[i] = *(const u32x4*)(pa[i] + (kt) * 64);
#define H_LB(i, kt) rb[i] = *(const u32x4*)(pb0 + i * ldb32 + (kt) * 64);
#define H_LOAD(kt) { H_LA(0, kt) H_LA(1, kt) H_LA(2, kt) H_LA(3, kt) H_LB(0, kt) H_LB(1, kt) H_LB(2, kt) H_LB(3, kt) H_LB(4, kt) H_LB(5, kt) H_LB(6, kt) H_LB(7, kt) }
#define H_SA(i) *(u32x4*)(smem + ((lrow + 32 * i) * LROW + lcc) * 2) = ra[i];
#define H_SB(i) *(u32x4*)(smem + T2_B_OFF + ((lrow + 32 * i) * LROW + lcc) * 2) = rb[i];
#define H_STORE() { H_SA(0) H_SA(1) H_SA(2) H_SA(3) H_SB(0) H_SB(1) H_SB(2) H_SB(3) H_SB(4) H_SB(5) H_SB(6) H_SB(7) }
#define H_STEP(ks) { \
      bf16x8 a0 = *(const bf16x8*)(bA_ + ks * 32); \
      bf16x8 a1 = *(const bf16x8*)(bA_ + 32 * LROW * 2 + ks * 32); \
      bf16x8 b0 = *(const bf16x8*)(bB_ + ks * 32); \
      bf16x8 b1 = *(const bf16x8*)(bB_ + 32 * LROW * 2 + ks * 32); \
      bf16x8 b2 = *(const bf16x8*)(bB_ + 64 * LROW * 2 + ks * 32); \
      bf16x8 b3 = *(const bf16x8*)(bB_ + 96 * LROW * 2 + ks * 32); \
      acc[0][0] = MFMA32(a0, b0, acc[0][0]); \
      acc[1][0] = MFMA32(a1, b0, acc[1][0]); \
      acc[0][1] = MFMA32(a0, b1, acc[0][1]); \
      acc[1][1] = MFMA32(a1, b1, acc[1][1]); \
      acc[0][2] = MFMA32(a0, b2, acc[0][2]); \
      acc[1][2] = MFMA32(a1, b2, acc[1][2]); \
      acc[0][3] = MFMA32(a0, b3, acc[0][3]); \
      acc[1][3] = MFMA32(a1, b3, acc[1][3]); }
  const char* bA_ = smem + ((wm * 64 + r) * LROW + hh * 8) * 2;
  const char* bB_ = smem + T2_B_OFF + ((wn * 128 + r) * LROW + hh * 8) * 2;
  H_LOAD(0);
  for (int kt = 0; kt < nk; ++kt) {
    __syncthreads();
    H_STORE();
    __syncthreads();
    if (kt + 1 < nk) H_LOAD(kt + 1);
    H_STEP(0) H_STEP(1) H_STEP(2) H_STEP(3)
  }
  __syncthreads();
#undef H_LA
#undef H_LB
#undef H_LOAD
#undef H_SA
#undef H_SB
#undef H_STORE
#undef H_STEP
}
DI void zero_acc8(f32x16 (&acc)[2][4]) {
#pragma unroll
  for (int a = 0; a < 2; ++a)
#pragma unroll
    for (int b = 0; b < 4; ++b) acc[a][b] = fzero();
}

DI void transpose_tile(const float* __restrict__ src, long ld_src, bf16_t* __restrict__ dst, long ld_dst, int k0,
                       int n0, int rs, int off, char* smem) {
  float* Tt = (float*)smem;
  const int tid = TIDX;
#pragma unroll
  for (int i = 0; i < 4; ++i) {
    int k = (tid >> 4) + 16 * i, c4 = (tid & 15) * 4;
    float4 v = *(const float4*)(src + (long)(k0 + k) * ld_src + n0 + c4);
    Tt[k * 65 + c4 + 0] = v.x; Tt[k * 65 + c4 + 1] = v.y; Tt[k * 65 + c4 + 2] = v.z; Tt[k * 65 + c4 + 3] = v.w;
  }
  __syncthreads();
  const int n = tid >> 2, kq = (tid & 3) * 16;
  unsigned pk[8];
#pragma unroll
  for (int j = 0; j < 8; ++j) pk[j] = pack2(Tt[(kq + 2 * j) * 65 + n], Tt[(kq + 2 * j + 1) * 65 + n]);
  const int nn = n0 + n;
  const long drow = (long)(nn >> 5) * rs + off + (nn & 31);
  uint4* d = (uint4*)(dst + drow * ld_dst + k0 + kq);
  d[0] = make_uint4(pk[0], pk[1], pk[2], pk[3]);
  d[1] = make_uint4(pk[4], pk[5], pk[6], pk[7]);
  __syncthreads();
}

constexpr int WT_SMALL = 1536 + 256 + 256 + 16;
constexpr int WT_TILES = WT_SMALL + 5632 + 5632 + 5632;
DI size_t smallw(int l) { return l ? oq(O_SMALLW1) : (size_t)0; }
DI void convert_weight_tile(const Params& P, int l, int t, char* smem) {
  char* ws = P.ws;
  const size_t sw = smallw(l);
  if (t < 1536) {
    int kt = t / 96, nt = t % 96;
    transpose_tile(P.w_in + (size_t)l * D * INC, INC, (bf16_t*)(ws + sw + oq(O_WT_IN)), D, kt * 64, nt * 64, 32, 0, smem);
    return;
  }
  t -= 1536;
  if (t < 256) {
    int i = t >> 6, tt = t & 63, kt = tt >> 4, nt = tt & 15;
    transpose_tile(P.w_branch + ((size_t)l * 4 + i) * 256 * D, D, (bf16_t*)(ws + sw + oq(O_WT_BR)) + (size_t)i * D * 256, 256,
                   kt * 64, nt * 64, 32, 0, smem);
    return;
  }
  t -= 256;
  if (t < 256) {
    int kt = t >> 4, nt = t & 15;
    transpose_tile(P.w_out + (size_t)l * D * D, D, (bf16_t*)(ws + sw + oq(O_WT_OUT)), D, kt * 64, nt * 64, 32, 0, smem);
    return;
  }
  t -= 256;
  if (t < 16) {
    int kt = t >> 2, nt = t & 3;
    transpose_tile(P.fnet_w + (size_t)l * 256 * 256, 256, (bf16_t*)(ws + sw + oq(O_WT_FN)), 256, kt * 64, nt * 64, 32, 0, smem);
    return;
  }
  t -= 16;
  if (t < 11264) {
    int which = t >= 5632; if (which) t -= 5632;
    int e = t / 352, tt = t % 352, kt = tt / 22, nt = tt % 22;
    const float* src = (which ? P.w_up_e : P.w_gate_e) + ((size_t)l * NE + e) * D * FF;
    transpose_tile(src, FF, (bf16_t*)(ws + oq(O_WT_13)) + (size_t)e * 2 * FF * D, D, kt * 64, nt * 64, 64, which * 32, smem);
    return;
  }
  t -= 11264;
  {
    int e = t / 352, tt = t % 352, kt = tt / 16, nt = tt % 16;
    transpose_tile(P.w_down_e + ((size_t)l * NE + e) * FF * D, D, (bf16_t*)(ws + oq(O_WT_2)) + (size_t)e * D * FF, FF,
                   kt * 64, nt * 64, 32, 0, smem);
  }
}

DI void ada_task(const Params& P, int t, char* smem) {
  const int l = t / 96, n0 = (t % 96) * 64;
  float* sv = (float*)smem;
  float* red = sv + 3 * 1024;
  const int tid = TIDX;
  for (int i = tid; i < 3 * 1024; i += 256) {
    int s = i >> 10, k = i & 1023;
    float v = s < 2 ? P.c[s * D + k] : P.c_ctx[k];
    sv[i] = v / (1.f + __expf(-v));
  }
  __syncthreads();
  const int col = tid & 63, kg = tid >> 6;
  const float* wp = P.w_ada + (size_t)l * D * INC + n0 + col;
  float a0 = 0.f, a1 = 0.f, a2 = 0.f;
  for (int k = kg * 256; k < kg * 256 + 256; ++k) {
    float wv = wp[(size_t)k * INC];
    a0 += sv[k] * wv; a1 += sv[1024 + k] * wv; a2 += sv[2048 + k] * wv;
  }
  red[(kg * 3 + 0) * 64 + col] = a0; red[(kg * 3 + 1) * 64 + col] = a1; red[(kg * 3 + 2) * 64 + col] = a2;
  __syncthreads();
  if (tid < 192) {
    int s = tid >> 6, cc = tid & 63;
    float v = P.b_ada[(size_t)l * INC + n0 + cc];
    for (int g = 0; g < 4; ++g) v += red[(g * 3 + s) * 64 + cc];
    ((float*)(P.ws + oq(O_MOD)))[((size_t)l * 3 + s) * INC + n0 + cc] = v;
  }
  __syncthreads();
}

DI void tables_task(const Params& P, int t) {
  char* ws = P.ws;
  const int gtid = t * 256 + TIDX, gstride = 64 * 256;
  bf16_t* Wc = (bf16_t*)(ws + oq(O_WC));
  for (int i = gtid; i < 512 * 256; i += gstride) {
    int jj = i >> 8, c = i & 255, part = jj >> 8, j = jj & 255;
    float sn, cs; sincospif(2.f * (float)((j * c) & 255) / 256.f, &sn, &cs);
    Wc[i] = f2bf(part == 0 ? cs : -sn);
  }
  bf16_t* D1 = (bf16_t*)(ws + oq(O_D1));
  for (int i = gtid; i < 256 * 256; i += gstride) {
    int n = i >> 8, k = i & 255;
    int k1 = (n >> 6) * 32 + (n & 31), po = (n >> 5) & 1, pi = k >> 7, n1 = k & 127;
    float sn, cs; sincospif(2.f * (float)((k1 * n1) & 127) / 128.f, &sn, &cs);
    float v = po == 0 ? (pi == 0 ? cs : sn) : (pi == 0 ? -sn : cs);
    D1[i] = f2bf(v);
  }
  bf16_t* D2 = (bf16_t*)(ws + oq(O_D2));
  for (int i = gtid; i < 128 * 256; i += gstride) {
    int k2 = i >> 8, k = i & 255, pi = k >> 7, n2 = k & 127;
    float sn, cs; sincospif(2.f * (float)((k2 * n2) & 127) / 128.f, &sn, &cs);
    D2[i] = f2bf(pi == 0 ? cs : sn);
  }
  bf16_t* Dc = (bf16_t*)(ws + oq(O_DC));
  for (int i = gtid; i < 256 * 512; i += gstride) {
    int kk = i >> 9, k = i & 511, pi = k >> 8, n = k & 255;
    float sn, cs; sincospif(2.f * (float)((kk * n) & 255) / 256.f, &sn, &cs);
    Dc[i] = f2bf(pi == 0 ? cs : sn);
  }
  float* rope = (float*)(ws + oq(O_ROPE));
  for (int i = gtid; i < 256 * 8; i += gstride) {
    int pos = i >> 3, f = i & 7;
    float inv = powf(10000.f, -(float)f / 8.f);
    float ang = (float)pos * inv;
    rope[i * 2 + 0] = cosf(ang);
    rope[i * 2 + 1] = sinf(ang);
  }
  if (t == 0 && TIDX < 2) {
    const int l = TIDX;
    float* cst = (float*)(ws + oq(O_CONST)) + l * 8;
    const float* lv = P.df_lambda + l * 128;
    float d01 = 0.f, d23 = 0.f;
    for (int i = 0; i < 32; ++i) { d01 += lv[i] * lv[32 + i]; d23 += lv[64 + i] * lv[96 + i]; }
    float lam_init = 0.8f - 0.6f * expf(-0.3f * (float)l);
    cst[0] = expf(d01) - expf(d23) + lam_init;
    cst[1] = lam_init;
    float gq = 0.f, gk = 0.f;
    for (int i = 0; i < 32; ++i) { gq = fmaxf(gq, fabsf(P.df_q_g[l * 32 + i])); gk = fmaxf(gk, fabsf(P.df_k_g[l * 32 + i])); }
    cst[2] = sqrtf(32.f) * gq * gk * LOG2E;
    gq = 0.f; gk = 0.f;
    for (int i = 0; i < 64; ++i) { gq = fmaxf(gq, fabsf(P.na_q_g[l * 64 + i])); gk = fmaxf(gk, fabsf(P.na_k_g[l * 64 + i])); }
    float bm = 0.f;
    for (int i = 0; i < 4 * 15 * 31; ++i) bm = fmaxf(bm, fabsf(P.na_rpb[l * 4 * 15 * 31 + i]));
    cst[3] = (8.f * gq * gk + bm) * LOG2E;
  }
}

DI void modnorm_phase(const Params& P, int l, bool second, int bid, int nb, char* smem) {
  const int lane = TIDX & 63, w = TIDX >> 6;
  const int nw = nb * 4;
  bf16_t* h = (bf16_t*)(P.ws + oq(O_H));
  const float* g = (second ? P.g_ffn : P.g_mix) + (size_t)l * D;
  float* wt = (float*)smem;
  if (second) {
    const float* wr = P.w_router + (size_t)l * D * NE;
    for (int idx = TIDX; idx < D * NE; idx += 256) wt[(idx & 15) * D + (idx >> 4)] = wr[idx];
    __syncthreads();
  }
  for (int r = bid * 4 + w; r < R; r += nw) {
    int b, p; row_info(r, b, p);
    const bool isctx = p >= T;
    if (l == 1 && second && isctx) continue;
    const float* src = (l == 0 && !second) ? x_in_row(P, r) : x_buf_row(P, r);
    const int s = isctx ? 2 : b;
    const float* mb = (const float*)(P.ws + oq(O_MOD)) + ((size_t)l * 3 + s) * INC + (second ? 3 * D : 0);
    float4 v[4];
    float ss = 0.f;
#pragma unroll
    for (int i = 0; i < 4; ++i) {
      v[i] = *(const float4*)(src + lane * 4 + 256 * i);
      ss += v[i].x * v[i].x + v[i].y * v[i].y + v[i].z * v[i].z + v[i].w * v[i].w;
    }
    ss = wave_sum(ss);
    const float rstd = rsqrtf(ss * (1.f / D) + EPS);
    float hv[16];
#pragma unroll
    for (int i = 0; i < 4; ++i) {
      const int c = lane * 4 + 256 * i;
      float4 gg = *(const float4*)(g + c), sh = *(const float4*)(mb + c), sc = *(const float4*)(mb + D + c);
      hv[i * 4 + 0] = v[i].x * rstd * gg.x * (1.f + sc.x) + sh.x;
      hv[i * 4 + 1] = v[i].y * rstd * gg.y * (1.f + sc.y) + sh.y;
      hv[i * 4 + 2] = v[i].z * rstd * gg.z * (1.f + sc.z) + sh.z;
      hv[i * 4 + 3] = v[i].w * rstd * gg.w * (1.f + sc.w) + sh.w;
      uint2 o = {pack2(hv[i * 4 + 0], hv[i * 4 + 1]), pack2(hv[i * 4 + 2], hv[i * 4 + 3])};
      *(uint2*)(h + (size_t)r * D + c) = o;
    }
    if (second) {
      float lg[16];
#pragma unroll
      for (int e = 0; e < 16; ++e) lg[e] = 0.f;
#pragma unroll
      for (int i = 0; i < 4; ++i) {
#pragma unroll
        for (int e = 0; e < 16; ++e) {
          const float4 w4 = *(const float4*)(wt + e * D + 256 * i + lane * 4);
          lg[e] += hv[i * 4 + 0] * w4.x + hv[i * 4 + 1] * w4.y + hv[i * 4 + 2] * w4.z + hv[i * 4 + 3] * w4.w;
          if ((e & 3) == 3) __builtin_amdgcn_sched_barrier(0);
        }
      }
      float mx = -1e30f;
#pragma unroll
      for (int e = 0; e < 16; ++e) { lg[e] = wave_sum(lg[e]); mx = fmaxf(mx, lg[e]); }
      float sum = 0.f, mine = 0.f;
#pragma unroll
      for (int e = 0; e < 16; ++e) { float ex = __expf(lg[e] - mx); sum += ex; if (lane == e) mine = ex; }
      if (lane < 16) {
        const int smp = isctx ? 2 + b : b, n = isctx ? p - T : p;
        ((float*)(P.ws + oq(O_AFF)))[((size_t)smp * NE + lane) * T + n] = mine / sum;
      }
    }
  }
  __syncthreads();
}

template <int G>
DI void epi_rms(const float* Tt, const float* __restrict__ gain, bool rope, const float* __restrict__ ropetab,
                float scale, bf16_t* __restrict__ dst, int dcol0, int r0) {
  constexpr int NG = 128 / G;
  for (int it = TIDX; it < 128 * NG; it += 256) {
    const int row = it / NG, grp = it % NG;
    const float* tp = Tt + row * 132 + grp * G;
    float ss = 0.f;
#pragma unroll
    for (int d = 0; d < G; d += 4) {
      float4 q = *(const float4*)(tp + d);
      ss += q.x * q.x + q.y * q.y + q.z * q.z + q.w * q.w;
    }
    const float rstd = rsqrtf(ss * (1.f / G) + EPS);
    const float* gp = gain;
    asm volatile("" : "+s"(gp));
    int b, p; row_info(r0 + row, b, p);
    const bool dorope = (G == 32) && rope && (p < T);
    uint4* dp = (uint4*)(dst + (size_t)(r0 + row) * 256 + dcol0 + grp * G);
#pragma unroll 1
    for (int sub = 0; sub < G / 16; ++sub) {
      float v[16];
#pragma unroll
      for (int d = 0; d < 16; d += 4) {
        float4 q = *(const float4*)(tp + sub * 16 + d);
        float4 g4 = *(const float4*)(gp + sub * 16 + d);
        v[d] = q.x * rstd * g4.x; v[d + 1] = q.y * rstd * g4.y; v[d + 2] = q.z * rstd * g4.z; v[d + 3] = q.w * rstd * g4.w;
      }
      if (dorope) {
        const int pos = sub ? (p & 63) : (p >> 6);
#pragma unroll
        for (int i = 0; i < 8; ++i) {
          const float2 cssn = *(const float2*)(ropetab + (pos * 8 + i) * 2);
          const float x1 = v[i], x2 = v[8 + i];
          v[i] = x1 * cssn.x - x2 * cssn.y;
          v[8 + i] = x1 * cssn.y + x2 * cssn.x;
        }
      }
      dp[sub * 2] = make_uint4(pack2(v[0] * scale, v[1] * scale), pack2(v[2] * scale, v[3] * scale),
                               pack2(v[4] * scale, v[5] * scale), pack2(v[6] * scale, v[7] * scale));
      dp[sub * 2 + 1] = make_uint4(pack2(v[8] * scale, v[9] * scale), pack2(v[10] * scale, v[11] * scale),
                                   pack2(v[12] * scale, v[13] * scale), pack2(v[14] * scale, v[15] * scale));
    }
  }
}
DI void epi_plain(const float* Tt, bf16_t* __restrict__ dst, int dcol0, int r0) {
  const int row = TIDX >> 1, c0 = (TIDX & 1) * 64;
  uint4* dp = (uint4*)(dst + (size_t)(r0 + row) * 256 + dcol0 + c0);
#pragma unroll
  for (int d = 0; d < 64; d += 8) {
    float4 a = *(const float4*)(Tt + row * 132 + c0 + d), b = *(const float4*)(Tt + row * 132 + c0 + d + 4);
    dp[d >> 3] = make_uint4(pack2(a.x, a.y), pack2(a.z, a.w), pack2(b.x, b.y), pack2(b.z, b.w));
  }
}
DI void epi_transposed(const float* Tt, bf16_t* __restrict__ vt, int hd0, int bb, int p0) {
  const int c = TIDX >> 1, half = TIDX & 1;
  const int hd = hd0 + c;
  uint4* dp = (uint4*)(vt + ((size_t)bb * 256 + hd) * PB + p0 + half * 64);
#pragma unroll
  for (int q = 0; q < 8; ++q) {
    float f[8];
#pragma unroll
    for (int j = 0; j < 8; ++j) {
      const int tk = (q >> 1) * 16 + ((q & 1) ? (j < 4 ? j + 4 : j + 8) : (j < 4 ? j : j + 4));
      f[j] = Tt[(half * 64 + tk) * 132 + c];
    }
    dp[q] = make_uint4(pack2(f[0], f[1]), pack2(f[2], f[3]), pack2(f[4], f[5]), pack2(f[6], f[7]));
  }
}

DI void inproj_tile(const Params& P, int l, int mt, int nt, char* smem) {
  char* ws = P.ws;
  const int r0 = mt * 128;
  f32x16 acc[2][4];
  zero_acc8(acc);
  PlainRows ar{(const bf16_t*)(ws + oq(O_H)) + (size_t)r0 * D, D};
  gemm_main2(ar, (const bf16_t*)(ws + smallw(l) + oq(O_WT_IN)) + (size_t)nt * 256 * D, D, D, smem, acc);
  const int tid = TIDX, lane = tid & 63, w = tid >> 6, wm = w >> 1, wn = w & 1, r = lane & 31, hh = lane >> 5;
  if (nt >= 4 && nt < 20) {
    bf16_t* gates = (bf16_t*)(ws + oq(O_GATES));
#pragma unroll
    for (int mb = 0; mb < 2; ++mb)
#pragma unroll
      for (int nb2 = 0; nb2 < 4; ++nb2) {
        const int mt32 = mt * 4 + wm * 2 + mb, nt32 = (nt - 4) * 8 + wn * 4 + nb2;
        float sg[16];
#pragma unroll
        for (int i = 0; i < 16; ++i) sg[i] = 1.f / (1.f + __expf(-acc[mb][nb2][i]));
        uint4* gp = (uint4*)(gates + (((size_t)mt32 * 128 + nt32) * 64 + lane) * 16);
        gp[0] = make_uint4(pack2(sg[0], sg[1]), pack2(sg[2], sg[3]), pack2(sg[4], sg[5]), pack2(sg[6], sg[7]));
        gp[1] = make_uint4(pack2(sg[8], sg[9]), pack2(sg[10], sg[11]), pack2(sg[12], sg[13]), pack2(sg[14], sg[15]));
      }
    return;
  }
  float* Tt = (float*)smem;
  bf16_t* qpf = (bf16_t*)(ws + oq(O_QPF));
  bf16_t* kv = (bf16_t*)(ws + oq(O_KV));
  const float* ropetab = (const float*)(ws + oq(O_ROPE));
  const size_t S = (size_t)R * 256;
  int bb, p0; row_info(r0, bb, p0);
#pragma unroll 1
  for (int half = 0; half < 2; ++half) {
    if (wn == half) {
#pragma unroll
      for (int mb = 0; mb < 2; ++mb)
#pragma unroll
        for (int nb2 = 0; nb2 < 4; ++nb2)
#pragma unroll
          for (int i = 0; i < 16; ++i) {
            const int m = wm * 64 + mb * 32 + crow(i, hh), n = nb2 * 32 + r;
            Tt[m * 132 + n] = acc[mb][nb2][i];
          }
    }
    __syncthreads();
    const int dc = half * 128;
    if (nt == 0) epi_rms<64>(Tt, P.na_q_g + l * 64, false, ropetab, 0.125f * LOG2E, qpf, dc, r0);
    else if (nt == 1) epi_rms<32>(Tt, P.df_q_g + l * 32, true, ropetab, 0.17677669529663687f * LOG2E, qpf + S, dc, r0);
    else if (nt == 2) epi_plain(Tt, qpf + 2 * S, dc, r0);
    else if (nt == 3) epi_plain(Tt, qpf + 3 * S, dc, r0);
    else if (nt == 20) epi_rms<64>(Tt, P.na_k_g + l * 64, false, ropetab, 1.f, kv, dc, r0);
    else if (nt == 21) epi_transposed(Tt, kv + 2 * S, dc, bb, p0);
    else if (nt == 22) epi_rms<32>(Tt, P.df_k_g + l * 32, true, ropetab, 1.f, kv + S, dc, r0);
    else epi_transposed(Tt, kv + 3 * S, dc, bb, p0);
    __syncthreads();
  }
}

DI void diffattn_task(const Params& P, int l, int b, int hd, int q0, int key_lo, int nkeys, char* smem) {
  char* ws = P.ws;
  const int tid = TIDX, lane = tid & 63, w = tid >> 6, r = lane & 31, hh = lane >> 5;
  const bf16_t* qd = (const bf16_t*)(ws + oq(O_QPF)) + (size_t)R * 256;
  const bf16_t* kd = (const bf16_t*)(ws + oq(O_KV)) + (size_t)R * 256;
  const bf16_t* vt = (const bf16_t*)(ws + oq(O_KV)) + (size_t)3 * R * 256;
  bf16_t* yd = (bf16_t*)(ws + oq(O_Y)) + (size_t)R * 256;
  const float* cst = (const float*)(ws + oq(O_CONST)) + l * 8;
  const float lam = cst[0], lam_init = cst[1], negC = -cst[2];
  const int qrow = b * PB + q0 + w * 32 + r;
  bf16x8 qf[2][2];
#pragma unroll
  for (int m = 0; m < 2; ++m)
#pragma unroll
    for (int ks = 0; ks < 2; ++ks)
      qf[m][ks] = *(const bf16x8*)(qd + (size_t)qrow * 256 + hd * 64 + m * 32 + ks * 16 + hh * 8);
  f32x16 O[2][2];
  O[0][0] = O[0][1] = O[1][0] = O[1][1] = fzero();
  float ls0 = 0.f, ls1 = 0.f;
  constexpr int KT = 64 * LROW * 2;
  const bf16_t* kbase = kd + ((size_t)b * PB + key_lo) * 256 + hd * 64;
  const bf16_t* vbase = vt + ((size_t)(b * 4 + hd) * 64) * PB + key_lo;
  const int c0 = tid, c1 = tid + 256;
  u32x4 rk0, rk1, rv0, rv1;
#define DA_LOAD(t)                                                                       \
  {                                                                                      \
    rk0 = *(const u32x4*)(kbase + ((size_t)((t) * 64 + (c0 >> 3))) * 256 + (c0 & 7) * 8); \
    rk1 = *(const u32x4*)(kbase + ((size_t)((t) * 64 + (c1 >> 3))) * 256 + (c1 & 7) * 8); \
    rv0 = *(const u32x4*)(vbase + (size_t)(c0 >> 3) * PB + (t) * 64 + (c0 & 7) * 8);      \
    rv1 = *(const u32x4*)(vbase + (size_t)(c1 >> 3) * PB + (t) * 64 + (c1 & 7) * 8);      \
  }
#define DA_STORE(buf)                                                          \
  {                                                                            \
    char* kb_ = smem + (buf) * 2 * KT;                                         \
    *(u32x4*)(kb_ + ((c0 >> 3) * LROW + (c0 & 7) * 8) * 2) = rk0;              \
    *(u32x4*)(kb_ + ((c1 >> 3) * LROW + (c1 & 7) * 8) * 2) = rk1;              \
    *(u32x4*)(kb_ + KT + ((c0 >> 3) * LROW + (c0 & 7) * 8) * 2) = rv0;         \
    *(u32x4*)(kb_ + KT + ((c1 >> 3) * LROW + (c1 & 7) * 8) * 2) = rv1;         \
  }
  const int nt = nkeys >> 6;
  DA_LOAD(0);
  DA_STORE(0);
  if (nt > 1) DA_LOAD(1);
  for (int t = 0; t < nt; ++t) {
    __syncthreads();
    if (t + 1 < nt) {
      DA_STORE((t + 1) & 1);
      if (t + 2 < nt) DA_LOAD(t + 2);
    }
    const char* Ks = smem + (t & 1) * 2 * KT;
    const char* Vs = Ks + KT;
#pragma unroll
    for (int kb = 0; kb < 2; ++kb) {
      f32x16 S0, S1;
#pragma unroll
      for (int i = 0; i < 16; ++i) { S0[i] = negC; S1[i] = negC; }
#pragma unroll
      for (int ks = 0; ks < 2; ++ks) {
        bf16x8 k0 = *(const bf16x8*)(Ks + ((kb * 32 + r) * LROW + ks * 16 + hh * 8) * 2);
        bf16x8 k1 = *(const bf16x8*)(Ks + ((kb * 32 + r) * LROW + 32 + ks * 16 + hh * 8) * 2);
        S0 = MFMA32(k0, qf[0][ks], S0);
        S1 = MFMA32(k1, qf[1][ks], S1);
      }
#pragma unroll
      for (int i = 0; i < 16; ++i) {
        S0[i] = __builtin_amdgcn_exp2f(S0[i]); ls0 += S0[i];
        S1[i] = __builtin_amdgcn_exp2f(S1[i]); ls1 += S1[i];
      }
#pragma unroll
      for (int s = 0; s < 2; ++s) {
        bf16x8 p0 = pack8(S0[8 * s], S0[8 * s + 1], S0[8 * s + 2], S0[8 * s + 3], S0[8 * s + 4], S0[8 * s + 5], S0[8 * s + 6], S0[8 * s + 7]);
        bf16x8 p1 = pack8(S1[8 * s], S1[8 * s + 1], S1[8 * s + 2], S1[8 * s + 3], S1[8 * s + 4], S1[8 * s + 5], S1[8 * s + 6], S1[8 * s + 7]);
#pragma unroll
        for (int vb = 0; vb < 2; ++vb) {
          const bf16x8 vf = *(const bf16x8*)(Vs + ((vb * 32 + r) * LROW + kb * 32 + 16 * s + 8 * hh) * 2);
          O[0][vb] = MFMA32(vf, p0, O[0][vb]);
          O[1][vb] = MFMA32(vf, p1, O[1][vb]);
        }
      }
    }
  }
  __syncthreads();
#undef DA_LOAD
#undef DA_STORE
  ls0 += __shfl_xor(ls0, 32, 64);
  ls1 += __shfl_xor(ls1, 32, 64);
  const float i0 = 1.f / ls0, i1 = lam / ls1;
  float ssq = 0.f;
#pragma unroll
  for (int vb = 0; vb < 2; ++vb)
#pragma unroll
    for (int i = 0; i < 16; ++i) {
      float o = O[0][vb][i] * i0 - O[1][vb][i] * i1;
      O[0][vb][i] = o;
      ssq += o * o;
    }
  ssq += __shfl_xor(ssq, 32, 64);
  const float rstd = rsqrtf(ssq * (1.f / 64.f) + EPS) * (1.f - lam_init);
  const float* sg = P.df_subln_g + l * 64;
#pragma unroll
  for (int vb = 0; vb < 2; ++vb)
#pragma unroll
    for (int g4 = 0; g4 < 4; ++g4) {
      const int vd = vb * 32 + 8 * g4 + 4 * hh;
      float o0 = O[0][vb][4 * g4] * rstd * sg[vd], o1 = O[0][vb][4 * g4 + 1] * rstd * sg[vd + 1];
      float o2 = O[0][vb][4 * g4 + 2] * rstd * sg[vd + 2], o3 = O[0][vb][4 * g4 + 3] * rstd * sg[vd + 3];
      uint2 pk = {pack2(o0, o1), pack2(o2, o3)};
      *(uint2*)(yd + (size_t)qrow * 256 + hd * 64 + vd) = pk;
    }
}

DI void na_task(const Params& P, int l, int b, bool ctxq, int rr, int qsel, char* smem) {
  char* ws = P.ws;
  const int tid = TIDX, lane = tid & 63, hd = tid >> 6, r = lane & 31, hh = lane >> 5;
  float* rp = (float*)smem;
  if (!ctxq) {
    for (int i = tid; i < 4 * 15 * 31; i += 256) rp[i] = P.na_rpb[(size_t)l * 4 * 15 * 31 + i] * LOG2E;
  }
  __syncthreads();
  const bf16_t* qn = (const bf16_t*)(ws + oq(O_QPF));
  const bf16_t* kn = (const bf16_t*)(ws + oq(O_KV));
  const bf16_t* vt = (const bf16_t*)(ws + oq(O_KV)) + (size_t)2 * R * 256;
  bf16_t* yn = (bf16_t*)(ws + oq(O_Y));
  const float negC = -((const float*)(ws + oq(O_CONST)))[l * 8 + 3];
  int cq[2], qrow[2], cs[2];
  bf16x8 qf[2][4];
  f32x16 O[2][2];
  float ls[2];
#pragma unroll
  for (int a = 0; a < 2; ++a) {
    cq[a] = (qsel + a) * 32 + r;
    const int qp = ctxq ? T + cq[a] : rr * 64 + cq[a];
    qrow[a] = b * PB + qp;
    cs[a] = min(max(cq[a] - 8, 0), 48);
#pragma unroll
    for (int ks = 0; ks < 4; ++ks) qf[a][ks] = *(const bf16x8*)(qn + (size_t)qrow[a] * 256 + hd * 64 + ks * 16 + hh * 8);
    O[a][0] = O[a][1] = fzero();
    ls[a] = 0.f;
  }
  const int rs = min(max(rr - 4, 0), 248);
  const int nblk = ctxq ? 8 : 24;
  const bf16_t* vtb = vt + ((size_t)(b * 4 + hd) * 64) * PB;
  for (int kbi = 0; kbi < nblk; ++kbi) {
    const bool loc = !ctxq && kbi < 16;
    const int ir = kbi >> 1, kb = kbi & 1;
    const int pk0 = loc ? (rs + ir) * 64 + kb * 32 : T + (kbi - (ctxq ? 0 : 16)) * 32;
    const bf16_t* kp = kn + ((size_t)b * PB + pk0 + r) * 256 + hd * 64 + hh * 8;
    bf16x8 kf[4];
#pragma unroll
    for (int ks = 0; ks < 4; ++ks) kf[ks] = *(const bf16x8*)(kp + ks * 16);
    bf16x8 vf[2][2];
#pragma unroll
    for (int s = 0; s < 2; ++s)
#pragma unroll
      for (int vb = 0; vb < 2; ++vb) vf[s][vb] = *(const bf16x8*)(vtb + (size_t)(vb * 32 + r) * PB + pk0 + 16 * s + 8 * hh);
    const float* rpr = rp + (hd * 15 + (rs + ir - rr + 7)) * 31;
#pragma unroll
    for (int a = 0; a < 2; ++a) {
      f32x16 S;
#pragma unroll
      for (int i = 0; i < 16; ++i) S[i] = negC;
#pragma unroll
      for (int ks = 0; ks < 4; ++ks) S = MFMA32(kf[ks], qf[a][ks], S);
      if (loc) {
#pragma unroll
        for (int i = 0; i < 16; ++i) {
          const int kc = kb * 32 + crow(i, hh);
          const bool valid = (kc >= cs[a]) && (kc < cs[a] + 16);
          const int ci = min(max(kc - cq[a] + 15, 0), 30);
          const float pv = __builtin_amdgcn_exp2f(S[i] + rpr[ci]);
          S[i] = valid ? pv : 0.f;
          ls[a] += S[i];
        }
      } else {
#pragma unroll
        for (int i = 0; i < 16; ++i) { S[i] = __builtin_amdgcn_exp2f(S[i]); ls[a] += S[i]; }
      }
#pragma unroll
      for (int s = 0; s < 2; ++s) {
        bf16x8 pf = pack8(S[8 * s], S[8 * s + 1], S[8 * s + 2], S[8 * s + 3], S[8 * s + 4], S[8 * s + 5], S[8 * s + 6], S[8 * s + 7]);
#pragma unroll
        for (int vb = 0; vb < 2; ++vb) O[a][vb] = MFMA32(vf[s][vb], pf, O[a][vb]);
      }
    }
  }
#pragma unroll
  for (int a = 0; a < 2; ++a) {
    float lsa = ls[a];
    lsa += __shfl_xor(lsa, 32, 64);
    const float inv = 1.f / lsa;
#pragma unroll
    for (int vb = 0; vb < 2; ++vb)
#pragma unroll
      for (int g4 = 0; g4 < 4; ++g4) {
        const int vd = vb * 32 + 8 * g4 + 4 * hh;
        uint2 pk = {pack2(O[a][vb][4 * g4] * inv, O[a][vb][4 * g4 + 1] * inv), pack2(O[a][vb][4 * g4 + 2] * inv, O[a][vb][4 * g4 + 3] * inv)};
        *(uint2*)(yn + (size_t)qrow[a] * 256 + hd * 64 + vd) = pk;
      }
  }
  __syncthreads();
}

DI void pool_task(const Params& P, int l, int tile, char* smem) {
  char* ws = P.ws;
  const int tid = TIDX;
  const int r0 = tile * 32;
  int b, p0; row_info(r0, b, p0);
  const bool isctx = p0 >= T;
  const int seq0 = isctx ? T : 0, N = isctx ? CTXL : T;
  const int t0 = p0 - seq0;
  const bf16_t* pin = (const bf16_t*)(ws + oq(O_QPF)) + (size_t)2 * R * 256;
  bf16_t* yp = (bf16_t*)(ws + oq(O_Y)) + (size_t)2 * R * 256;
  bf16_t* us = (bf16_t*)smem;
  float* ds = (float*)(smem + 48 * 256 * 2);
  for (int i = tid; i < 48 * 32; i += 256) {
    const int rowi = i >> 5, ch = (i & 31) * 8;
    const int tk = t0 - 8 + rowi;
    uint4 v = make_uint4(0, 0, 0, 0);
    if (tk >= 0 && tk < N) v = *(const uint4*)(pin + ((size_t)b * PB + seq0 + tk) * 256 + ch);
    *(uint4*)(us + rowi * 256 + ch) = v;
  }
  __syncthreads();
  {
    const int ch = tid, gi = ch >> 6, wv = 2 << gi;
    for (int t = 0; t < 32; ++t) {
      const int tk = t0 + t;
      const int lo = max(tk - wv / 2, 0), hi = min(tk + wv / 2, N);
      float s = 0.f;
      for (int q = lo; q < hi; ++q) s += bf2f(us[(q - t0 + 8) * 256 + ch]);
      ds[t * 256 + ch] = s / (float)(hi - lo) - bf2f(us[(t + 8) * 256 + ch]);
    }
  }
  __syncthreads();
  {
    const int o = tid, gi = o >> 6;
    const float* wp = P.pool_w + ((size_t)l * 4 + gi) * 64 * 64 + (o & 63);
    float acc[32];
#pragma unroll
    for (int t = 0; t < 32; ++t) acc[t] = 0.f;
    for (int k = 0; k < 64; ++k) {
      const float wv = wp[k * 64];
#pragma unroll
      for (int t = 0; t < 32; ++t) acc[t] += ds[t * 256 + gi * 64 + k] * wv;
    }
    const float sc = P.pool_scale[l * 256 + o];
#pragma unroll
    for (int t = 0; t < 32; ++t) yp[(size_t)(r0 + t) * 256 + o] = f2bf(acc[t] * sc);
  }
  __syncthreads();
}

struct StridedRows {
  const bf16_t* base; long ld;
  DI const bf16_t* operator()(int m) const { return base + (long)m * ld; }
};
DI void fft_stage0_lat(const Params& P, int task, char* smem) {
  char* ws = P.ws;
  const int ntile = task & 3, n2 = (task >> 2) & 127, b = task >> 9;
  const bf16_t* fin = (const bf16_t*)(ws + oq(O_QPF)) + (size_t)3 * R * 256;
  f32x16 acc[2][2];
  acc[0][0] = acc[0][1] = acc[1][0] = acc[1][1] = fzero();
  StridedRows ar{fin + ((size_t)b * PB + n2) * 256, 128 * 256};
  gemm_main(ar, (const bf16_t*)(ws + oq(O_WC)) + (size_t)ntile * 128 * 256, 256, 256, smem, acc);
  bf16_t* Z1 = (bf16_t*)(ws + oq(O_Z1));
  const int lane = TIDX & 63, w = TIDX >> 6, wm = w >> 1, wn = w & 1, r = lane & 31, hh = lane >> 5;
#pragma unroll
  for (int mb = 0; mb < 2; ++mb)
#pragma unroll
    for (int nb2 = 0; nb2 < 2; ++nb2) {
      const int jj = ntile * 128 + wn * 64 + nb2 * 32 + r, part = jj >> 8, j = jj & 255;
#pragma unroll
      for (int g4 = 0; g4 < 4; ++g4) {
        const int n1 = wm * 64 + mb * 32 + 8 * g4 + 4 * hh;
        uint2 pk = {pack2(acc[mb][nb2][4 * g4], acc[mb][nb2][4 * g4 + 1]), pack2(acc[mb][nb2][4 * g4 + 2], acc[mb][nb2][4 * g4 + 3])};
        *(uint2*)(Z1 + (((size_t)(b * 128 + n2) * 256 + j) * 256 + part * 128 + n1)) = pk;
      }
    }
}
DI void fft_stage0_ctx(const Params& P, int task, char* smem) {
  char* ws = P.ws;
  const int ntile = task & 3, mtile = (task >> 2) & 1, b = task >> 3;
  const bf16_t* fin = (const bf16_t*)(ws + oq(O_QPF)) + (size_t)3 * R * 256;
  f32x16 acc[2][2];
  acc[0][0] = acc[0][1] = acc[1][0] = acc[1][1] = fzero();
  PlainRows ar{fin + ((size_t)b * PB + T + mtile * 128) * 256, 256};
  gemm_main(ar, (const bf16_t*)(ws + oq(O_WC)) + (size_t)ntile * 128 * 256, 256, 256, smem, acc);
  bf16_t* Z1c = (bf16_t*)(ws + oq(O_Z1C));
  const int lane = TIDX & 63, w = TIDX >> 6, wm = w >> 1, wn = w & 1, r = lane & 31, hh = lane >> 5;
#pragma unroll
  for (int mb = 0; mb < 2; ++mb)
#pragma unroll
    for (int nb2 = 0; nb2 < 2; ++nb2) {
      const int jj = ntile * 128 + wn * 64 + nb2 * 32 + r, part = jj >> 8, j = jj & 255;
#pragma unroll
      for (int g4 = 0; g4 < 4; ++g4) {
        const int n = mtile * 128 + wm * 64 + mb * 32 + 8 * g4 + 4 * hh;
        uint2 pk = {pack2(acc[mb][nb2][4 * g4], acc[mb][nb2][4 * g4 + 1]), pack2(acc[mb][nb2][4 * g4 + 2], acc[mb][nb2][4 * g4 + 3])};
        *(uint2*)(Z1c + (((size_t)(b * 256 + j)) * 512 + part * 256 + n)) = pk;
      }
    }
}
DI void fft_stage1_lat(const Params& P, int task, char* smem) {
  char* ws = P.ws;
  const int ntile = task & 1, j = (task >> 1) & 255, b = task >> 9;
  f32x16 acc[2][2];
  acc[0][0] = acc[0][1] = acc[1][0] = acc[1][1] = fzero();
  StridedRows ar{(const bf16_t*)(ws + oq(O_Z1)) + ((size_t)(b * 128) * 256 + j) * 256, 256 * 256};
  gemm_main(ar, (const bf16_t*)(ws + oq(O_D1)) + (size_t)ntile * 128 * 256, 256, 256, smem, acc);
  bf16_t* Z2 = (bf16_t*)(ws + oq(O_Z2));
  const int lane = TIDX & 63, w = TIDX >> 6, wm = w >> 1, wn = w & 1, r = lane & 31, hh = lane >> 5;
  const int k1 = (ntile * 2 + wn) * 32 + r;
#pragma unroll
  for (int mb = 0; mb < 2; ++mb)
#pragma unroll
    for (int g4 = 0; g4 < 4; ++g4) {
      const int n2 = wm * 64 + mb * 32 + 8 * g4 + 4 * hh;
      float yr[4], yi[4];
#pragma unroll
      for (int q = 0; q < 4; ++q) {
        const float re = acc[mb][0][4 * g4 + q], im = acc[mb][1][4 * g4 + q];
        float sn, cs; sincospif(2.f * (float)((k1 * (n2 + q)) & 16383) / 16384.f, &sn, &cs);
        yr[q] = re * cs + im * sn;
        yi[q] = im * cs - re * sn;
      }
      bf16_t* zp = Z2 + (((size_t)(b * 128 + k1) * 256 + j) * 256 + n2);
      uint2 pr = {pack2(yr[0], yr[1]), pack2(yr[2], yr[3])}, pi = {pack2(yi[0], yi[1]), pack2(yi[2], yi[3])};
      *(uint2*)zp = pr;
      *(uint2*)(zp + 128) = pi;
    }
}
DI void fft_stage1_ctx(const Params& P, int task, char* smem) {
  char* ws = P.ws;
  const int ntile = task & 1, mtile = (task >> 1) & 1, b = task >> 2;
  f32x16 acc[2][2];
  acc[0][0] = acc[0][1] = acc[1][0] = acc[1][1] = fzero();
  PlainRows ar{(const bf16_t*)(ws + oq(O_Z1C)) + ((size_t)(b * 256 + mtile * 128)) * 512, 512};
  gemm_main(ar, (const bf16_t*)(ws + oq(O_DC)) + (size_t)ntile * 128 * 512, 512, 512, smem, acc);
  bf16_t* f = (bf16_t*)(ws + oq(O_QPF)) + (size_t)3 * R * 256;
  const int lane = TIDX & 63, w = TIDX >> 6, wm = w >> 1, wn = w & 1, r = lane & 31, hh = lane >> 5;
#pragma unroll
  for (int mb = 0; mb < 2; ++mb)
#pragma unroll
    for (int nb2 = 0; nb2 < 2; ++nb2) {
      const int k = ntile * 128 + wn * 64 + nb2 * 32 + r;
#pragma unroll
      for (int g4 = 0; g4 < 4; ++g4) {
        const int j = mtile * 128 + wm * 64 + mb * 32 + 8 * g4 + 4 * hh;
        const float sc = 1.f / 256.f;
        uint2 pk = {pack2(acc[mb][nb2][4 * g4] * sc, acc[mb][nb2][4 * g4 + 1] * sc),
                    pack2(acc[mb][nb2][4 * g4 + 2] * sc, acc[mb][nb2][4 * g4 + 3] * sc)};
        *(uint2*)(f + ((size_t)b * PB + T + k) * 256 + j) = pk;
      }
    }
}
DI void fft_stage2_lat(const Params& P, int task, char* smem) {
  char* ws = P.ws;
  const int jt = task & 1, k1 = (task >> 1) & 127, b = task >> 8;
  f32x16 acc[2][2];
  acc[0][0] = acc[0][1] = acc[1][0] = acc[1][1] = fzero();
  PlainRows ar{(const bf16_t*)(ws + oq(O_Z2)) + ((size_t)(b * 128 + k1) * 256 + jt * 128) * 256, 256};
  gemm_main(ar, (const bf16_t*)(ws + oq(O_D2)), 256, 256, smem, acc);
  bf16_t* f = (bf16_t*)(ws + oq(O_QPF)) + (size_t)3 * R * 256;
  const int lane = TIDX & 63, w = TIDX >> 6, wm = w >> 1, wn = w & 1, r = lane & 31, hh = lane >> 5;
#pragma unroll
  for (int mb = 0; mb < 2; ++mb)
#pragma unroll
    for (int nb2 = 0; nb2 < 2; ++nb2) {
      const int k2 = wn * 64 + nb2 * 32 + r;
#pragma unroll
      for (int g4 = 0; g4 < 4; ++g4) {
        const int j = jt * 128 + wm * 64 + mb * 32 + 8 * g4 + 4 * hh;
        const float sc = 1.f / 2048.f;
        uint2 pk = {pack2(acc[mb][nb2][4 * g4] * sc, acc[mb][nb2][4 * g4 + 1] * sc),
                    pack2(acc[mb][nb2][4 * g4 + 2] * sc, acc[mb][nb2][4 * g4 + 3] * sc)};
        *(uint2*)(f + ((size_t)b * PB + k1 + 128 * k2) * 256 + j) = pk;
      }
    }
}
DI void fnet_final_tile(const Params& P, int l, int mt, int nt, char* smem) {
  char* ws = P.ws;
  const int r0 = mt * 128;
  f32x16 acc[2][2];
  acc[0][0] = acc[0][1] = acc[1][0] = acc[1][1] = fzero();
  PlainRows ar{(const bf16_t*)(ws + oq(O_QPF)) + (size_t)3 * R * 256 + (size_t)r0 * 256, 256};
  gemm_main(ar, (const bf16_t*)(ws + smallw(l) + oq(O_WT_FN)) + (size_t)nt * 128 * 256, 256, 256, smem, acc);
  bf16_t* yf = (bf16_t*)(ws + oq(O_Y)) + (size_t)3 * R * 256;
  const int lane = TIDX & 63, w = TIDX >> 6, wm = w >> 1, wn = w & 1, r = lane & 31, hh = lane >> 5;
#pragma unroll
  for (int mb = 0; mb < 2; ++mb)
#pragma unroll
    for (int nb2 = 0; nb2 < 2; ++nb2)
#pragma unroll
      for (int i = 0; i < 16; ++i) {
        const int m = wm * 64 + mb * 32 + crow(i, hh), n = nt * 128 + wn * 64 + nb2 * 32 + r;
        yf[(size_t)(r0 + m) * 256 + n] = f2bf(acc[mb][nb2][i]);
      }
}

DI void merge_tile(const Params& P, int l, int mt, int nt, char* smem) {
  char* ws = P.ws;
  const int r0 = mt * 128;
  const int tid = TIDX, lane = tid & 63, w = tid >> 6, wm = w >> 1, wn = w & 1, r = lane & 31, hh = lane >> 5;
  const bf16_t* gates = (const bf16_t*)(ws + oq(O_GATES));
  f32x16 tot[2][2], acc[2][2];
  tot[0][0] = tot[0][1] = tot[1][0] = tot[1][1] = fzero();
  acc[0][0] = acc[0][1] = acc[1][0] = acc[1][1] = fzero();
  const int lrow = tid >> 3, lcc = (tid & 7) * 8;
  const bf16_t* pa0 = (const bf16_t*)(ws + oq(O_Y)) + (size_t)(r0 + lrow) * 256 + lcc;
  const bf16_t* pb0 = (const bf16_t*)(ws + smallw(l) + oq(O_WT_BR)) + (size_t)(nt * 128 + lrow) * 256 + lcc;
  constexpr long SA = (long)R * 256, SB = (long)D * 256;
  u32x4 ra0[4], rb0[4];
  u32x4 gq[2][2][2];
#define M_OFFA(kt) (((kt) >> 2) * SA + ((kt) & 3) * 64)
#define M_OFFB(kt) (((kt) >> 2) * SB + ((kt) & 3) * 64)
#define M_LOAD1(RA, RB, kt, i) RA[i] = *(const u32x4*)(pa0 + M_OFFA(kt) + i * 32 * 256); RB[i] = *(const u32x4*)(pb0 + M_OFFB(kt) + i * 32 * 256);
#define M_LOAD(RA, RB, kt) { M_LOAD1(RA, RB, kt, 0) M_LOAD1(RA, RB, kt, 1) M_LOAD1(RA, RB, kt, 2) M_LOAD1(RA, RB, kt, 3) }
#define M_STORE1(RA, RB, i) *(u32x4*)(base_ + ((lrow + 32 * i) * LROW + lcc) * 2) = RA[i]; *(u32x4*)(base_ + TILEB + ((lrow + 32 * i) * LROW + lcc) * 2) = RB[i];
#define M_STORE(RA, RB, buf) { char* base_ = smem + (buf) * 2 * TILEB; M_STORE1(RA, RB, 0) M_STORE1(RA, RB, 1) M_STORE1(RA, RB, 2) M_STORE1(RA, RB, 3) }
#define M_STEP(ks) { \
      bf16x8 a0 = *(const bf16x8*)(bA_ + ks * 32); \
      bf16x8 a1 = *(const bf16x8*)(bA_ + 32 * LROW * 2 + ks * 32); \
      bf16x8 b0 = *(const bf16x8*)(bB_ + ks * 32); \
      bf16x8 b1 = *(const bf16x8*)(bB_ + 32 * LROW * 2 + ks * 32); \
      acc[0][0] = MFMA32(a0, b0, acc[0][0]); \
      acc[0][1] = MFMA32(a0, b1, acc[0][1]); \
      acc[1][0] = MFMA32(a1, b0, acc[1][0]); \
      acc[1][1] = MFMA32(a1, b1, acc[1][1]); }
#define M_COMPUTE(buf) { \
    const char* bA_ = smem + (buf) * 2 * TILEB + ((wm * 64 + r) * LROW + hh * 8) * 2; \
    const char* bB_ = smem + (buf) * 2 * TILEB + TILEB + ((wn * 64 + r) * LROW + hh * 8) * 2; \
    M_STEP(0) M_STEP(1) M_STEP(2) M_STEP(3) }
#define M_GLOAD(i) { \
    _Pragma("unroll") for (int mb = 0; mb < 2; ++mb) \
      _Pragma("unroll") for (int nb2 = 0; nb2 < 2; ++nb2) { \
        const int mt32 = mt * 4 + wm * 2 + mb, nt32 = (i) * 32 + nt * 4 + wn * 2 + nb2; \
        const u32x4* gp = (const u32x4*)(gates + (((size_t)mt32 * 128 + nt32) * 64 + lane) * 16); \
        gq[mb][nb2][0] = gp[0]; gq[mb][nb2][1] = gp[1]; } }
#define M_APPLY() { \
    _Pragma("unroll") for (int mb = 0; mb < 2; ++mb) \
      _Pragma("unroll") for (int nb2 = 0; nb2 < 2; ++nb2) { \
        _Pragma("unroll") for (int q = 0; q < 16; ++q) { \
          const unsigned wv = gq[mb][nb2][q >> 3][(q >> 1) & 3]; \
          const float gv = __uint_as_float((q & 1) ? (wv & 0xffff0000u) : (wv << 16)); \
          tot[mb][nb2][q] += gv * acc[mb][nb2][q]; } \
        acc[mb][nb2] = fzero(); } }
  M_GLOAD(0);
  M_LOAD(ra0, rb0, 0);
  M_STORE(ra0, rb0, 0);
  M_LOAD(ra0, rb0, 1);
#pragma unroll 1
  for (int kt = 0; kt < 16; kt += 2) {
    __syncthreads();
    M_STORE(ra0, rb0, 1);
    if (kt + 2 < 16) M_LOAD(ra0, rb0, kt + 2);
    M_COMPUTE(0);
    __syncthreads();
    if (kt + 2 < 16) {
      M_STORE(ra0, rb0, 0);
      if (kt + 3 < 16) M_LOAD(ra0, rb0, kt + 3);
    }
    M_COMPUTE(1);
    if ((kt & 3) == 2) {
      M_APPLY();
      if (kt + 2 < 16) M_GLOAD((kt + 2) >> 2);
    }
  }
  __syncthreads();
#undef M_OFFA
#undef M_OFFB
#undef M_LOAD1
#undef M_LOAD
#undef M_STORE1
#undef M_STORE
#undef M_STEP
#undef M_COMPUTE
#undef M_GLOAD
#undef M_APPLY
  bf16_t* am = (bf16_t*)(ws + oq(O_ACCM));
#pragma unroll
  for (int mb = 0; mb < 2; ++mb)
#pragma unroll
    for (int nb2 = 0; nb2 < 2; ++nb2)
#pragma unroll
      for (int q = 0; q < 16; ++q) {
        const int m = wm * 64 + mb * 32 + crow(q, hh), n = nt * 128 + wn * 64 + nb2 * 32 + r;
        am[(size_t)(r0 + m) * D + n] = f2bf(tot[mb][nb2][q]);
      }
}
DI void outproj_tile(const Params& P, int l, int mt, int nt, char* smem) {
  char* ws = P.ws;
  const int r0 = mt * 128;
  f32x16 acc[2][4];
  zero_acc8(acc);
  PlainRows ar{(const bf16_t*)(ws + oq(O_ACCM)) + (size_t)r0 * D, D};
  gemm_main2(ar, (const bf16_t*)(ws + smallw(l) + oq(O_WT_OUT)) + (size_t)nt * 256 * D, D, D, smem, acc);
  const int lane = TIDX & 63, w = TIDX >> 6, wm = w >> 1, wn = w & 1, r = lane & 31, hh = lane >> 5;
  const int s = row_modsel(r0);
  const float* gt1 = (const float*)(ws + oq(O_MOD)) + ((size_t)l * 3 + s) * INC + 2 * D;
#pragma unroll
  for (int mb = 0; mb < 2; ++mb)
#pragma unroll
    for (int q = 0; q < 16; ++q) {
      const int m = wm * 64 + mb * 32 + crow(q, hh);
      const float* xi = (l == 0) ? x_in_row(P, r0 + m) : x_buf_row(P, r0 + m);
      float* xo = x_buf_row(P, r0 + m);
#pragma unroll
      for (int nb2 = 0; nb2 < 4; ++nb2) {
        const int n = nt * 256 + wn * 128 + nb2 * 32 + r;
        xo[n] = xi[n] + gt1[n] * acc[mb][nb2][q];
      }
    }
}

template <int NPT>
DI void topk_task(const Params& P, int smp, int e, char* smem) {
  char* ws = P.ws;
  constexpr int N = NPT * 256;
  constexpr int cap = N / 8;
  const int tid = TIDX, lane = tid & 63, w = tid >> 6;
  float* sv = (float*)smem;
  int* red = (int*)(smem + 65536);
  int* cg_ = (int*)(smem + 65536 + 64);
  int* ce_ = cg_ + 256;
  const float* aff = (const float*)(ws + oq(O_AFF)) + ((size_t)smp * NE + e) * T;
  for (int i = tid; i < N; i += 256) sv[i] = aff[i];
  __syncthreads();
  unsigned u[NPT];
#pragma unroll
  for (int j = 0; j < NPT; ++j) u[j] = __float_as_uint(sv[tid * NPT + j]);
  unsigned thr = 0;
  for (int bit = 30; bit >= 0; --bit) {
    const unsigned cand = thr | (1u << bit);
    int cnt = 0;
#pragma unroll
    for (int j = 0; j < NPT; ++j) cnt += (u[j] >= cand) ? 1 : 0;
#pragma unroll
    for (int o = 32; o >= 1; o >>= 1) cnt += __shfl_xor(cnt, o, 64);
    if (lane == 0) red[w] = cnt;
    __syncthreads();
    const int total = red[0] + red[1] + red[2] + red[3];
    __syncthreads();
    if (total >= cap) thr = cand;
  }
  int ng = 0, neq = 0;
#pragma unroll
  for (int j = 0; j < NPT; ++j) { ng += (u[j] > thr) ? 1 : 0; neq += (u[j] == thr) ? 1 : 0; }
  cg_[tid] = ng; ce_[tid] = neq;
  __syncthreads();
  int pg = 0, pe = 0, totg = 0;
  for (int i = 0; i < 256; ++i) {
    const int a = cg_[i], bq = ce_[i];
    if (i < tid) { pg += a; pe += bq; }
    totg += a;
  }
  const int need_eq = cap - totg;
  int* rows = (int*)(ws + oq(O_ROWS)) + (size_t)e * SLOTS;
  float* gl = (float*)(ws + oq(O_GL)) + (size_t)e * SLOTS;
  const int slot_base = smp < 2 ? smp * 2048 : 4096 + (smp - 2) * 32;
  const int row_base = smp < 2 ? smp * PB : (smp - 2) * PB + T;
#pragma unroll
  for (int j = 0; j < NPT; ++j) {
    const int idx = tid * NPT + j;
    int slot = -1;
    if (u[j] > thr) { slot = pg; ++pg; }
    else if (u[j] == thr) { if (pe < need_eq) slot = totg + pe; ++pe; }
    if (slot >= 0) { rows[slot_base + slot] = row_base + idx; gl[slot_base + slot] = __uint_as_float(u[j]); }
  }
  if (smp == 0 && tid < 64) rows[4160 + tid] = -1;
  __syncthreads();
}

struct GatherRows {
  const bf16_t* base; const int* rows;
  DI const bf16_t* operator()(int m) const { int rr = rows[m]; return base + (size_t)(rr < 0 ? 0 : rr) * D; }
};
DI void expert1_tile(const Params& P, int e, int mt, int nt, char* smem) {
  char* ws = P.ws;
  f32x16 acc[2][4];
  zero_acc8(acc);
  GatherRows ar{(const bf16_t*)(ws + oq(O_H)), (const int*)(ws + oq(O_ROWS)) + (size_t)e * SLOTS + mt * 128};
  gemm_main2(ar, (const bf16_t*)(ws + oq(O_WT_13)) + ((size_t)e * 2 * FF + nt * 256) * D, D, D, smem, acc);
  bf16_t* hid = (bf16_t*)(ws + oq(O_HID)) + ((size_t)e * SLOTS + mt * 128) * FF;
  const int lane = TIDX & 63, w = TIDX >> 6, wm = w >> 1, wn = w & 1, r = lane & 31, hh = lane >> 5;
#pragma unroll
  for (int pr = 0; pr < 2; ++pr) {
    const int f = nt * 128 + wn * 64 + pr * 32 + r;
#pragma unroll
    for (int mb = 0; mb < 2; ++mb)
#pragma unroll
      for (int q = 0; q < 16; ++q) {
        const int m = wm * 64 + mb * 32 + crow(q, hh);
        const float gv = acc[mb][2 * pr][q], uv = acc[mb][2 * pr + 1][q];
        hid[(size_t)m * FF + f] = f2bf(gv / (1.f + __expf(-gv)) * uv);
      }
  }
}
DI void expert2_tile(const Params& P, int l, int e, int mt, int nt, char* smem) {
  char* ws = P.ws;
  f32x16 acc[2][4];
  zero_acc8(acc);
  PlainRows ar{(const bf16_t*)(ws + oq(O_HID)) + ((size_t)e * SLOTS + mt * 128) * FF, FF};
  gemm_main2(ar, (const bf16_t*)(ws + oq(O_WT_2)) + ((size_t)e * D + nt * 256) * FF, FF, FF, smem, acc);
  const int* rows = (const int*)(ws + oq(O_ROWS)) + (size_t)e * SLOTS + mt * 128;
  const float* gl = (const float*)(ws + oq(O_GL)) + (size_t)e * SLOTS + mt * 128;
  const int lane = TIDX & 63, w = TIDX >> 6, wm = w >> 1, wn = w & 1, r = lane & 31, hh = lane >> 5;
#pragma unroll
  for (int mb = 0; mb < 2; ++mb)
#pragma unroll
    for (int q = 0; q < 16; ++q) {
      const int m = wm * 64 + mb * 32 + crow(q, hh);
      const int row = rows[m];
      if (row < 0) continue;
      const float gv = gl[m];
      const float* gt2 = (const float*)(ws + oq(O_MOD)) + ((size_t)l * 3 + row_modsel(row)) * INC + 5 * D;
      float* xo = x_buf_row(P, row);
#pragma unroll
      for (int nb2 = 0; nb2 < 4; ++nb2) {
        const int n = nt * 256 + wn * 128 + nb2 * 32 + r;
        unsafeAtomicAdd(xo + n, gt2[n] * gv * acc[mb][nb2][q]);
      }
    }
}

#define XB_TMO      128
#define XB_XCNT(j)  (256  + 64 * (j))
#define XB_XSUB(j)  (1280 + 64 * (j))
#define XB_XGEN(j)  (2304 + 64 * (j))
#define XB_TOP      3328
#define XB_TOPGEN   3392
#define XCD_BAR_WORDS 3456
#define XB_SPIN_CAP (1u << 18)
#define LAS __attribute__((address_space(3)))

__device__ __forceinline__ unsigned xb_ld(unsigned* p)              { return __hip_atomic_load(p, __ATOMIC_RELAXED, __HIP_MEMORY_SCOPE_AGENT); }
__device__ __forceinline__ unsigned xb_add(unsigned* p, unsigned v) { return __hip_atomic_fetch_add(p, v, __ATOMIC_RELAXED, __HIP_MEMORY_SCOPE_AGENT); }
__device__ __forceinline__ unsigned xb_xcc_id() { return (unsigned)__builtin_amdgcn_s_getreg((3 << 11) | 20) & 0xFu; }
#define XB_SPIN(cond, bar) do { unsigned _sp = 0; while (cond) { __builtin_amdgcn_s_sleep(1); \
    if ((++_sp & 255u) == 0u) { if (xb_ld(&(bar)[XB_TMO])) break; if (_sp > XB_SPIN_CAP) { atomicAdd(&(bar)[XB_TMO], 1u); break; } } } } while (0)

struct XcdBarrier {
    unsigned* bar; unsigned x;
    volatile LAS unsigned* st;
};

__device__ __forceinline__ XcdBarrier xcd_barrier_post(unsigned* bar, volatile LAS unsigned* st) {
    XcdBarrier b; b.bar = bar; b.x = xb_xcc_id(); b.st = st;
    if (threadIdx.x == 0) (void)xb_add(&bar[XB_XCNT(b.x)], 1u);
    return b;
}
__device__ __forceinline__ void xcd_barrier_complete(unsigned* bar, unsigned x, unsigned& nloc, unsigned& nx) {
    const unsigned G = gridDim.x * gridDim.y * gridDim.z;
    unsigned sum, cnt, mine, sp = 0u;
    for (;;) {
        sum = 0u; cnt = 0u; mine = 0u;
#pragma unroll
        for (unsigned j = 0; j < 16; ++j) { const unsigned c = xb_ld(&bar[XB_XCNT(j)]); sum += c; cnt += (c > 0u) ? 1u : 0u; mine = (j == x) ? c : mine; }
        if (sum == G) break;
        __builtin_amdgcn_s_sleep(1);
        if ((++sp & 255u) == 0u) { if (xb_ld(&bar[XB_TMO])) break; if (sp > XB_SPIN_CAP) { atomicAdd(&bar[XB_TMO], 1u); break; } }
    }
    nloc = mine > 0u ? mine : 1u; nx = cnt > 0u ? cnt : 1u;
}

__device__ __forceinline__ void xcd_barrier(const XcdBarrier& b) {
    asm volatile("s_waitcnt vmcnt(0)" ::: "memory");
    __syncthreads();
    if (threadIdx.x == 0) {
        unsigned* bar = b.bar;
        __builtin_amdgcn_s_waitcnt(0);
        unsigned nloc = b.st[0], nx = b.st[1];
        if (nloc == 0u) { xcd_barrier_complete(bar, b.x, nloc, nx); b.st[0] = nloc; b.st[1] = nx; }
        const unsigned old = xb_add(&bar[XB_XSUB(b.x)], 1u);
        const unsigned gen = old / nloc;
        if (old + 1u == (gen + 1u) * nloc) {
            __builtin_amdgcn_fence(__ATOMIC_RELEASE, "agent");
            asm volatile("s_waitcnt vmcnt(0)" ::: "memory");
            const unsigned og = xb_add(&bar[XB_TOP], 1u);
            const unsigned tg = og / nx;
            if (og + 1u == (tg + 1u) * nx) xb_add(&bar[XB_TOPGEN], 1u);
            else XB_SPIN(xb_ld(&bar[XB_TOPGEN]) == tg, bar);
            __builtin_amdgcn_fence(__ATOMIC_ACQUIRE, "agent");
            xb_add(&bar[XB_XGEN(b.x)], 1u);
            asm volatile("s_waitcnt vmcnt(0)" ::: "memory");
        } else {
            XB_SPIN(xb_ld(&bar[XB_XGEN(b.x)]) == gen, bar);
            __builtin_amdgcn_fence(__ATOMIC_ACQUIRE, "agent");
            asm volatile("s_waitcnt vmcnt(0)" ::: "memory");
        }
    }
    __syncthreads();
}


constexpr int NPL = 12;
constexpr int NPHASE = 1 + 2 * NPL;

DI void run_phase0(const Params& P, char* smem) {
  const int bid = opaque_bid(), nb = gridDim.x;
  {
    for (int t = bid; t < 192 + 64 + 2 * WT_SMALL; t += nb) {
      if (t < 192) ada_task(P, t, smem);
      else if (t < 256) tables_task(P, t - 192);
      else if (t < 256 + WT_SMALL) convert_weight_tile(P, 0, t - 256, smem);
      else convert_weight_tile(P, 1, t - 256 - WT_SMALL, smem);
    }
  }
}
template <int SP>
DI void run_sub(const Params& P, int l, char* smem) {
  const int bid = opaque_bid(), nb = gridDim.x;
  const bool last = l == 1;
  if constexpr (SP == 0) {
      modnorm_phase(P, l, false, bid, nb, smem);
  }
  if constexpr (SP == 1) {
      const int x = bid & 7, j = bid >> 3, nbx = nb >> 3;
      if (bid < nbx * 8)
        for (int lt = j; lt < 130 * 6; lt += nbx) {
          const int g = x & 3, ci = lt % 6;
          const int mt = (x >> 2) * 130 + lt / 6, nt = ci == 0 ? g : (ci == 1 ? 20 + g : 4 * g + 2 + ci);
          if (last && (mt % 130) >= 128 && nt < 20) continue;
          inproj_tile(P, l, mt, nt, smem);
        }
  }
  if constexpr (SP == 2) {
      const bool conv_first = (bid >= (nb >> 1));
      if (conv_first)
        for (int t = bid - (nb >> 1); t < WT_TILES - WT_SMALL; t += nb) convert_weight_tile(P, l, WT_SMALL + t, smem);
      {
        const int x = bid & 7, j = bid >> 3, nbx = nb >> 3;
        if (bid < nbx * 8) {
          for (int q = j; q < 128; q += nbx) diffattn_task(P, l, x >> 2, x & 3, q * 128, 0, PB, smem);
          if (!last && j < 2) diffattn_task(P, l, x >> 2, x & 3, T + j * 128, T, CTXL, smem);
        }
      }
#ifndef PROBE_PART
#define PROBE_PART 0
#endif
#pragma unroll 1
      for (int rep = 0; rep < 1 + PROBE_PART; ++rep) {
      {
        const int x = bid & 7, j = bid >> 3, nbx = nb >> 3;
        if (bid < nbx * 8) {
          for (int q = j; q < 64; q += nbx) na_task(P, l, x >> 2, false, (x & 3) * 64 + q, 0, smem);
          if (!last && j == 0) na_task(P, l, x >> 2, true, 0, (x & 3) * 2, smem);
        }
      }
      for (int tile = bid; tile < 1040; tile += nb) {
        const bool isctx = (tile % 520) >= 512;
        if (!(last && isctx)) pool_task(P, l, tile, smem);
      }
      for (int t = bid; t < 1024; t += nb) fft_stage0_lat(P, t, smem);
      if (!last) for (int t = bid; t < 16; t += nb) fft_stage0_ctx(P, t, smem);      }
      if (!conv_first)
        for (int t = bid + (nb >> 1); t < WT_TILES - WT_SMALL; t += nb) convert_weight_tile(P, l, WT_SMALL + t, smem);

  }
  if constexpr (SP == 3) {
      const int n = 1024 + (last ? 0 : 8);
      for (int t = bid; t < n; t += nb) { if (t < 1024) fft_stage1_lat(P, t, smem); else fft_stage1_ctx(P, t - 1024, smem); }
  }
  if constexpr (SP == 4) {
      for (int t = bid; t < 512; t += nb) fft_stage2_lat(P, t, smem);
  }
  if constexpr (SP == 5) {
      for (int t = bid; t < 520; t += nb) { const int mt = t >> 1; if (last && (mt % 130) >= 128) continue; fnet_final_tile(P, l, mt, t & 1, smem); }
  }
  if constexpr (SP == 6) {
      const int x = bid & 7, j = bid >> 3, nbx = nb >> 3;
      if (bid < nbx * 8)
        for (int lt = j; lt < 33 * 8; lt += nbx) {
          const int mt = x + 8 * (lt >> 3);
          if (mt >= 260 || (last && (mt % 130) >= 128)) continue;
          merge_tile(P, l, mt, lt & 7, smem);
        }
  }
  if constexpr (SP == 7) {
      const int x = bid & 7, j = bid >> 3, nbx = nb >> 3;
      if (bid < nbx * 8)
        for (int lt = j; lt < 33 * 4; lt += nbx) {
          const int mt = x + 8 * (lt >> 2);
          if (mt >= 260 || (last && (mt % 130) >= 128)) continue;
          outproj_tile(P, l, mt, lt & 3, smem);
        }
  }
  if constexpr (SP == 8) { modnorm_phase(P, l, true, bid, nb, smem); }
  if constexpr (SP == 9) {
      const int n = last ? 32 : 64;
      for (int t = bid; t < n; t += nb) {
        const int smp = t >> 4, e = t & 15;
        if (smp < 2) topk_task<64>(P, smp, e, smem); else topk_task<1>(P, smp, e, smem);
      }
  }
  if constexpr (SP == 10) {
      const int nmt = last ? 32 : 33;
      const int x = bid & 7, j = bid >> 3, nbx = nb >> 3, npairs = NE * nmt;
      if (bid < nbx * 8)
        for (int lt = j; lt < ((npairs + 7) >> 3) * 11; lt += nbx) {
          const int p = x + 8 * (lt / 11);
          if (p >= npairs) continue;
          expert1_tile(P, p / nmt, p % nmt, lt % 11, smem);
        }
  }
  if constexpr (SP == 11) {
      const int nmt = last ? 32 : 33;
      const int x = bid & 7, j = bid >> 3, nbx = nb >> 3, npairs = NE * nmt;
      if (bid < nbx * 8)
        for (int lt = j; lt < ((npairs + 7) >> 3) * 4; lt += nbx) {
          const int p = x + 8 * (lt >> 2);
          if (p >= npairs) continue;
          expert2_tile(P, l, p / nmt, p % nmt, lt & 3, smem);
        }
  }
}

__shared__ __attribute__((aligned(16))) char g_smem[SMEM_BYTES];

#if ONE_LAUNCH
#ifndef PROBE_DUP
#define PROBE_DUP -1
#endif
#ifndef PROBE_MASK
#define PROBE_MASK 0
#endif
#define PH_STEP(SPV, L)                                \
  xcd_barrier(xb);                                     \
  run_sub<SPV>(P, L, g_smem);                          \
  if (SPV == PROBE_DUP || ((PROBE_MASK >> SPV) & 1)) { xcd_barrier(xb); run_sub<SPV>(P, L, g_smem); }
#define PH_LAYER(L)                                                                      \
  PH_STEP(0, L) PH_STEP(1, L) PH_STEP(2, L) PH_STEP(3, L) PH_STEP(4, L) PH_STEP(5, L)    \
  PH_STEP(6, L) PH_STEP(7, L) PH_STEP(8, L) PH_STEP(9, L) PH_STEP(10, L) PH_STEP(11, L)
#define PH_LAYER0_NOSYNC                                                                 \
  run_sub<0>(P, 0, g_smem);                                                              \
  PH_STEP(1, 0) PH_STEP(2, 0) PH_STEP(3, 0) PH_STEP(4, 0) PH_STEP(5, 0)                  \
  PH_STEP(6, 0) PH_STEP(7, 0) PH_STEP(8, 0) PH_STEP(9, 0) PH_STEP(10, 0) PH_STEP(11, 0)
__shared__ uint4 xb_words;
__global__ void __launch_bounds__(256, 2) mega(Params P) {
  cg::grid_group grid = cg::this_grid();
  if (threadIdx.x == 0) xb_words = make_uint4(0u, 0u, 0u, 0u);
  __syncthreads();
  XcdBarrier xb = xcd_barrier_post((unsigned*)(P.ws + O_BAR), (volatile LAS unsigned*)&xb_words);
  run_phase0(P, g_smem);
  if (xb_ld((unsigned*)(P.ws + O_BAR) + XB_TMO) == 0xFFFFFFFFu) grid.sync();
  xcd_barrier(xb);
  PH_LAYER0_NOSYNC
  PH_LAYER(1)
}
#else
__global__ void __launch_bounds__(256, 2) kphase0(Params P) { run_phase0(P, g_smem); }
template <int SP>
__global__ void __launch_bounds__(256, 2) kphase(Params P, int l) { run_sub<SP>(P, l, g_smem); }
#endif

extern "C" void kernel_launch(void* const* d_in, const int* in_sizes, int n_in, void* d_out, int out_size, void* d_ws,
                              size_t ws_size, hipStream_t stream) {
  static int grid_blocks = 0;
  if (!grid_blocks) {
    int dev = 0, cus = 0, per_cu = 0;
    (void)hipGetDevice(&dev);
    (void)hipDeviceGetAttribute(&cus, hipDeviceAttributeMultiprocessorCount, dev);
#if ONE_LAUNCH
    (void)hipOccupancyMaxActiveBlocksPerMultiprocessor(&per_cu, mega, 256, 0);
#else
    per_cu = 2;
#endif
    if (per_cu < 1) per_cu = 1;
    if (per_cu > 2) per_cu = 2;
    grid_blocks = cus * per_cu;
  }
  if (ws_size < WS_TOTAL) { fprintf(stderr, "workspace too small: %zu < %zu\n", ws_size, (size_t)WS_TOTAL); }
  Params P{};
  const float** pp = (const float**)&P;
  for (int i = 0; i < 25; ++i) pp[i] = (const float*)d_in[i];
  P.out = (float*)d_out;
  P.ws = (char*)d_ws;
#if ONE_LAUNCH
  (void)hipMemsetAsync((char*)d_ws + O_BAR, 0, 16384, stream);
  void* args[] = {&P};
  hipError_t e = hipLaunchCooperativeKernel((void*)mega, dim3(grid_blocks), dim3(256), args, 0, stream);
  if (e != hipSuccess) fprintf(stderr, "cooperative launch failed: %s (grid %d)\n", hipGetErrorString(e), grid_blocks);
#else
  const dim3 g(grid_blocks), b(256);
  kphase0<<<g, b, 0, stream>>>(P);
  for (int l = 0; l < 2; ++l) {
    kphase<0><<<g, b, 0, stream>>>(P, l);
    kphase<1><<<g, b, 0, stream>>>(P, l);
    kphase<2><<<g, b, 0, stream>>>(P, l);
    kphase<3><<<g, b, 0, stream>>>(P, l);
    kphase<4><<<g, b, 0, stream>>>(P, l);
    kphase<5><<<g, b, 0, stream>>>(P, l);
    kphase<6><<<g, b, 0, stream>>>(P, l);
    kphase<7><<<g, b, 0, stream>>>(P, l);
    kphase<8><<<g, b, 0, stream>>>(P, l);
    kphase<9><<<g, b, 0, stream>>>(P, l);
    kphase<10><<<g, b, 0, stream>>>(P, l);
    kphase<11><<<g, b, 0, stream>>>(P, l);
  }
#endif
}
```

```cpp
#include <hip/hip_runtime.h>
#include <hip/hip_cooperative_groups.h>
#include <stdint.h>
#include <cstdio>
namespace cg = cooperative_groups;

#ifndef ONE_LAUNCH
#define ONE_LAUNCH 1
#endif

#define DI __device__ __forceinline__
typedef unsigned short bf16_t;
using bf16x8 = __attribute__((ext_vector_type(8))) short;
using s16x4 = __attribute__((ext_vector_type(4))) short;
using u32x4 = __attribute__((ext_vector_type(4))) unsigned;
using f32x16 = __attribute__((ext_vector_type(16))) float;
typedef __bf16 bf2_t __attribute__((ext_vector_type(2)));
typedef float f2_t __attribute__((ext_vector_type(2)));
#define MFMA32(a, b, c) __builtin_amdgcn_mfma_f32_32x32x16_bf16((a), (b), (c), 0, 0, 0)

constexpr int D = 1024;
constexpr int T = 16384;
constexpr int CTXL = 256;
constexpr int PB = T + CTXL;
constexpr int R = 2 * PB;
constexpr int INC = 6144;
constexpr int NE = 16;
constexpr int FF = 1408;
constexpr int SLOTS = 4224;
constexpr float EPS = 1e-6f;
constexpr float LOG2E = 1.4426950408889634f;
constexpr float TWO_PI_UNUSED = 6.283185307179586f;

constexpr size_t AL(size_t x) { return (x + 255) & ~(size_t)255; }
constexpr size_t O_WT_IN = 0;
constexpr size_t O_WT_BR = O_WT_IN + (size_t)INC * D * 2;
constexpr size_t O_WT_OUT = O_WT_BR + (size_t)4 * D * 256 * 2;
constexpr size_t O_WT_FN = O_WT_OUT + (size_t)D * D * 2;
constexpr size_t O_WT_13 = O_WT_FN + (size_t)256 * 256 * 2;
constexpr size_t O_WT_2 = O_WT_13 + (size_t)NE * 2 * FF * D * 2;
constexpr size_t O_WC = O_WT_2 + (size_t)NE * D * FF * 2;
constexpr size_t O_D1 = O_WC + (size_t)512 * 256 * 2;
constexpr size_t O_D2 = O_D1 + (size_t)256 * 256 * 2;
constexpr size_t O_DC = O_D2 + (size_t)128 * 256 * 2;
constexpr size_t O_ROPE = O_DC + (size_t)256 * 512 * 2;
constexpr size_t O_MOD = O_ROPE + (size_t)256 * 8 * 2 * 4;
constexpr size_t O_CONST = O_MOD + (size_t)2 * 3 * INC * 4;
constexpr size_t O_H = AL(O_CONST + 256);
constexpr size_t O_Z1 = O_H;
constexpr size_t O_Z2 = O_H + (size_t)2 * T * 512 * 2;
constexpr size_t O_Z1C = O_Z2 + (size_t)2 * T * 512 * 2;
constexpr size_t O_QPF = O_H + (size_t)R * D * 2;
constexpr size_t SZ256 = (size_t)R * 256 * 2;
constexpr size_t O_ACCM = O_QPF;
constexpr size_t O_GATES = O_QPF + 4 * SZ256;
constexpr size_t O_HID = O_GATES;
constexpr size_t O_KV = O_GATES + (size_t)R * 4096 * 2;
constexpr size_t O_Y = O_KV + 4 * SZ256;
constexpr size_t O_XCTX = O_Y + 4 * SZ256;
constexpr size_t O_AFF = O_XCTX + (size_t)512 * D * 4;
constexpr size_t O_ROWS = O_AFF + (size_t)4 * NE * T * 4;
constexpr size_t O_GL = O_ROWS + (size_t)NE * SLOTS * 4;
constexpr size_t O_BAR = AL(O_GL + (size_t)NE * SLOTS * 4);
constexpr size_t O_SMALLW1 = O_BAR + 16384;
constexpr size_t SMALLW = O_WT_13;
constexpr size_t WS_TOTAL = O_SMALLW1 + SMALLW;
static_assert(O_Z1C + (size_t)2 * 256 * 512 * 2 <= O_QPF, "fft scratch must fit in h");
static_assert((size_t)NE * SLOTS * FF * 2 <= (size_t)R * 4096 * 2, "hid must fit in gates");

struct Params {
  const float *x, *c, *ctx, *c_ctx, *w_ada, *b_ada, *g_mix, *g_ffn, *w_in, *na_q_g, *na_k_g, *na_rpb, *df_q_g,
      *df_k_g, *df_lambda, *df_subln_g, *pool_w, *pool_scale, *fnet_w, *w_branch, *w_out, *w_router, *w_gate_e,
      *w_up_e, *w_down_e;
  float* out;
  char* ws;
};

constexpr int SMEM_BYTES = 73728;
constexpr int LROW = 72;
constexpr int TILEB = 128 * LROW * 2;

DI int opaque_tid() { int t = threadIdx.x; asm volatile("" : "+v"(t)); return t; }
DI int opaque_bid() { int t = blockIdx.x; asm volatile("" : "+s"(t)); return t; }
DI size_t oq(size_t x) { asm volatile("" : "+s"(x)); return x; }
#define TIDX opaque_tid()
DI float bf2f(bf16_t b) { return __uint_as_float(((unsigned)b) << 16); }
DI unsigned pack2(float a, float b) {
  f2_t v = {a, b};
  bf2_t r = __builtin_convertvector(v, bf2_t);
  return __builtin_bit_cast(unsigned, r);
}
DI bf16_t f2bf(float a) { return (bf16_t)(pack2(a, 0.f) & 0xffffu); }
DI bf16x8 pack8(float a0, float a1, float a2, float a3, float a4, float a5, float a6, float a7) {
  uint4 u = {pack2(a0, a1), pack2(a2, a3), pack2(a4, a5), pack2(a6, a7)};
  return __builtin_bit_cast(bf16x8, u);
}
DI float wave_sum(float v) {
#pragma unroll
  for (int o = 32; o >= 1; o >>= 1) v += __shfl_xor(v, o, 64);
  return v;
}
DI int crow(int i, int hh) { return (i & 3) + 8 * (i >> 2) + 4 * hh; }
DI f32x16 fzero() {
  f32x16 z;
#pragma unroll
  for (int i = 0; i < 16; ++i) z[i] = 0.f;
  return z;
}
DI void row_info(int r, int& b, int& p) { b = r >= PB ? 1 : 0; p = r - b * PB; }
DI const float* x_in_row(const Params& P, int r) {
  int b, p; row_info(r, b, p);
  return p < T ? P.x + ((size_t)b * T + p) * D : P.ctx + ((size_t)b * CTXL + (p - T)) * D;
}
DI float* x_buf_row(const Params& P, int r) {
  int b, p; row_info(r, b, p);
  return p < T ? P.out + ((size_t)b * T + p) * D : (float*)(P.ws + oq(O_XCTX)) + ((size_t)b * CTXL + (p - T)) * D;
}
DI int row_modsel(int r) { int b, p; row_info(r, b, p); return p < T ? b : 2; }

template <class ARow>
DI void gemm_main(ARow arow, const bf16_t* __restrict__ Bt, long ldb, int K, char* smem, f32x16 (&acc)[2][2]) {
  const int tid = TIDX, lane = tid & 63, w = tid >> 6, wm = w >> 1, wn = w & 1;
  const int r = lane & 31, hh = lane >> 5;
  const int lrow = tid >> 3, lcc = (tid & 7) * 8;
  const bf16_t* pa[4];
#pragma unroll
  for (int i = 0; i < 4; ++i) pa[i] = arow(lrow + 32 * i) + lcc;
  const bf16_t* pb0 = Bt + (long)lrow * ldb + lcc;
  const long ldb32 = 32 * ldb;
  u32x4 ra0[4], rb0[4], ra1[4], rb1[4];
  const int nk = K >> 6;
#define G_LOAD1(RA, RB, kt, i) RA[i] = *(const u32x4*)(pa[i] + (kt) * 64); RB[i] = *(const u32x4*)(pb0 + i * ldb32 + (kt) * 64);
#define G_LOAD(RA, RB, kt) { G_LOAD1(RA, RB, kt, 0) G_LOAD1(RA, RB, kt, 1) G_LOAD1(RA, RB, kt, 2) G_LOAD1(RA, RB, kt, 3) }
#define G_STORE1(RA, RB, i) *(u32x4*)(base_ + ((lrow + 32 * i) * LROW + lcc) * 2) = RA[i]; *(u32x4*)(base_ + TILEB + ((lrow + 32 * i) * LROW + lcc) * 2) = RB[i];
#define G_STORE(RA, RB, buf) { char* base_ = smem + (buf) * 2 * TILEB; G_STORE1(RA, RB, 0) G_STORE1(RA, RB, 1) G_STORE1(RA, RB, 2) G_STORE1(RA, RB, 3) }
#define G_STEP(ks) { \
      bf16x8 a0 = *(const bf16x8*)(bA_ + ks * 32); \
      bf16x8 a1 = *(const bf16x8*)(bA_ + 32 * LROW * 2 + ks * 32); \
      bf16x8 b0 = *(const bf16x8*)(bB_ + ks * 32); \
      bf16x8 b1 = *(const bf16x8*)(bB_ + 32 * LROW * 2 + ks * 32); \
      acc[0][0] = MFMA32(a0, b0, acc[0][0]); \
      acc[0][1] = MFMA32(a0, b1, acc[0][1]); \
      acc[1][0] = MFMA32(a1, b0, acc[1][0]); \
      acc[1][1] = MFMA32(a1, b1, acc[1][1]); }
#define G_COMPUTE(buf) { \
    const char* bA_ = smem + (buf) * 2 * TILEB + ((wm * 64 + r) * LROW + hh * 8) * 2; \
    const char* bB_ = smem + (buf) * 2 * TILEB + TILEB + ((wn * 64 + r) * LROW + hh * 8) * 2; \
    G_STEP(0) G_STEP(1) G_STEP(2) G_STEP(3) }
  G_LOAD(ra0, rb0, 0);
  if (nk > 1) G_LOAD(ra1, rb1, 1);
  G_STORE(ra0, rb0, 0);
  if (nk > 2) G_LOAD(ra0, rb0, 2);
  for (int kt = 0; kt < nk; kt += 2) {
    __syncthreads();
    if (kt + 1 < nk) {
      G_STORE(ra1, rb1, 1);
      if (kt + 3 < nk) G_LOAD(ra1, rb1, kt + 3);
    }
    G_COMPUTE(0);
    if (kt + 1 < nk) {
      __syncthreads();
      if (kt + 2 < nk) {
        G_STORE(ra0, rb0, 0);
        if (kt + 4 < nk) G_LOAD(ra0, rb0, kt + 4);
      }
      G_COMPUTE(1);
    }
  }
  __syncthreads();
#undef G_LOAD
#undef G_STORE
#undef G_COMPUTE
#undef G_LOAD1
#undef G_STORE1
#undef G_STEP
}
struct PlainRows {
  const bf16_t* base; long ld;
  DI const bf16_t* operator()(int m) const { return base + (long)m * ld; }
};

constexpr int T2_B_OFF = 128 * LROW * 2;
template <class ARow>
DI void gemm_main2(ARow arow, const bf16_t* __restrict__ Bt, long ldb, int K, char* smem, f32x16 (&acc)[2][4]) {
  const int tid = TIDX, lane = tid & 63, w = tid >> 6, wm = w >> 1, wn = w & 1;
  const int r = lane & 31, hh = lane >> 5;
  const int lrow = tid >> 3, lcc = (tid & 7) * 8;
  const bf16_t* pa[4];
#pragma unroll
  for (int i = 0; i < 4; ++i) pa[i] = arow(lrow + 32 * i) + lcc;
  const bf16_t* pb0 = Bt + (long)lrow * ldb + lcc;
  const long ldb32 = 32 * ldb;
  u32x4 ra[4], rb[8];
  const int nk = K >> 6;
#define H_LA(i, kt) ra[i] = *(const u32x4*)(pa[i] + (kt) * 64);
#define H_LB(i, kt) rb[i] = *(const u32x4*)(pb0 + i * ldb32 + (kt) * 64);
#define H_LOAD(kt) { H_LA(0, kt) H_LA(1, kt) H_LA(2, kt) H_LA(3, kt) H_LB(0, kt) H_LB(1, kt) H_LB(2, kt) H_LB(3, kt) H_LB(4, kt) H_LB(5, kt) H_LB(6, kt) H_LB(7, kt) }
#define H_SA(i) *(u32x4*)(smem + ((lrow + 32 * i) * LROW + lcc) * 2) = ra[i];
#define H_SB(i) *(u32x4*)(smem + T2_B_OFF + ((lrow + 32 * i) * LROW + lcc) * 2) = rb[i];
#define H_STORE() { H_SA(0) H_SA(1) H_SA(2) H_SA(3) H_SB(0) H_SB(1) H_SB(2) H_SB(3) H_SB(4) H_SB(5) H_SB(6) H_SB(7) }
#define H_STEP(ks) { \
      bf16x8 a0 = *(const bf16x8*)(bA_ + ks * 32); \
      bf16x8 a1 = *(const bf16x8*)(bA_ + 32 * LROW * 2 + ks * 32); \
      bf16x8 b0 = *(const bf16x8*)(bB_ + ks * 32); \
      bf16x8 b1 = *(const bf16x8*)(bB_ + 32 * LROW * 2 + ks * 32); \
      bf16x8 b2 = *(const bf16x8*)(bB_ + 64 * LROW * 2 + ks * 32); \
      bf16x8 b3 = *(const bf16x8*)(bB_ + 96 * LROW * 2 + ks * 32); \
      acc[0][0] = MFMA32(a0, b0, acc[0][0]); \
      acc[1][0] = MFMA32(a1, b0, acc[1][0]); \
      acc[0][1] = MFMA32(a0, b1, acc[0][1]); \
      acc[1][1] = MFMA32(a1, b1, acc[1][1]); \
      acc[0][2] = MFMA32(a0, b2, acc[0][2]); \
      acc[1][2] = MFMA32(a1, b2, acc[1][2]); \
      acc[0][3] = MFMA32(a0, b3, acc[0][3]); \
      acc[1][3] = MFMA32(a1, b3, acc[1][3]); }
  const char* bA_ = smem + ((wm * 64 + r) * LROW + hh * 8) * 2;
  const char* bB_ = smem + T2_B_OFF + ((wn * 128 + r) * LROW + hh * 8) * 2;
  H_LOAD(0);
  for (int kt = 0; kt < nk; ++kt) {
    __syncthreads();
    H_STORE();
    __syncthreads();
    if (kt + 1 < nk) H_LOAD(kt + 1);
    H_STEP(0) H_STEP(1) H_STEP(2) H_STEP(3)
  }
  __syncthreads();
#undef H_LA
#undef H_LB
#undef H_LOAD
#undef H_SA
#undef H_SB
#undef H_STORE
#undef H_STEP
}
DI void zero_acc8(f32x16 (&acc)[2][4]) {
#pragma unroll
  for (int a = 0; a < 2; ++a)
#pragma unroll
    for (int b = 0; b < 4; ++b) acc[a][b] = fzero();
}

DI void transpose_tile(const float* __restrict__ src, long ld_src, bf16_t* __restrict__ dst, long ld_dst, int k0,
                       int n0, int rs, int off, char* smem) {
  float* Tt = (float*)smem;
  const int tid = TIDX;
#pragma unroll
  for (int i = 0; i < 4; ++i) {
    int k = (tid >> 4) + 16 * i, c4 = (tid & 15) * 4;
    float4 v = *(const float4*)(src + (long)(k0 + k) * ld_src + n0 + c4);
    Tt[k * 65 + c4 + 0] = v.x; Tt[k * 65 + c4 + 1] = v.y; Tt[k * 65 + c4 + 2] = v.z; Tt[k * 65 + c4 + 3] = v.w;
  }
  __syncthreads();
  const int n = tid >> 2, kq = (tid & 3) * 16;
  unsigned pk[8];
#pragma unroll
  for (int j = 0; j < 8; ++j) pk[j] = pack2(Tt[(kq + 2 * j) * 65 + n], Tt[(kq + 2 * j + 1) * 65 + n]);
  const int nn = n0 + n;
  const long drow = (long)(nn >> 5) * rs + off + (nn & 31);
  uint4* d = (uint4*)(dst + drow * ld_dst + k0 + kq);
  d[0] = make_uint4(pk[0], pk[1], pk[2], pk[3]);
  d[1] = make_uint4(pk[4], pk[5], pk[6], pk[7]);
  __syncthreads();
}

constexpr int WT_SMALL = 1536 + 256 + 256 + 16;
constexpr int WT_TILES = WT_SMALL + 5632 + 5632 + 5632;
DI size_t smallw(int l) { return l ? oq(O_SMALLW1) : (size_t)0; }
DI void convert_weight_tile(const Params& P, int l, int t, char* smem) {
  char* ws = P.ws;
  const size_t sw = smallw(l);
  if (t < 1536) {
    int kt = t / 96, nt = t % 96;
    transpose_tile(P.w_in + (size_t)l * D * INC, INC, (bf16_t*)(ws + sw + oq(O_WT_IN)), D, kt * 64, nt * 64, 32, 0, smem);
    return;
  }
  t -= 1536;
  if (t < 256) {
    int i = t >> 6, tt = t & 63, kt = tt >> 4, nt = tt & 15;
    transpose_tile(P.w_branch + ((size_t)l * 4 + i) * 256 * D, D, (bf16_t*)(ws + sw + oq(O_WT_BR)) + (size_t)i * D * 256, 256,
                   kt * 64, nt * 64, 32, 0, smem);
    return;
  }
  t -= 256;
  if (t < 256) {
    int kt = t >> 4, nt = t & 15;
    transpose_tile(P.w_out + (size_t)l * D * D, D, (bf16_t*)(ws + sw + oq(O_WT_OUT)), D, kt * 64, nt * 64, 32, 0, smem);
    return;
  }
  t -= 256;
  if (t < 16) {
    int kt = t >> 2, nt = t & 3;
    transpose_tile(P.fnet_w + (size_t)l * 256 * 256, 256, (bf16_t*)(ws + sw + oq(O_WT_FN)), 256, kt * 64, nt * 64, 32, 0, smem);
    return;
  }
  t -= 16;
  if (t < 11264) {
    int which = t >= 5632; if (which) t -= 5632;
    int e = t / 352, tt = t % 352, kt = tt / 22, nt = tt % 22;
    const float* src = (which ? P.w_up_e : P.w_gate_e) + ((size_t)l * NE + e) * D * FF;
    transpose_tile(src, FF, (bf16_t*)(ws + oq(O_WT_13)) + (size_t)e * 2 * FF * D, D, kt * 64, nt * 64, 64, which * 32, smem);
    return;
  }
  t -= 11264;
  {
    int e = t / 352, tt = t % 352, kt = tt / 16, nt = tt % 16;
    transpose_tile(P.w_down_e + ((size_t)l * NE + e) * FF * D, D, (bf16_t*)(ws + oq(O_WT_2)) + (size_t)e * D * FF, FF,
                   kt * 64, nt * 64, 32, 0, smem);
  }
}

DI void ada_task(const Params& P, int t, char* smem) {
  const int l = t / 96, n0 = (t % 96) * 64;
  float* sv = (float*)smem;
  float* red = sv + 3 * 1024;
  const int tid = TIDX;
  for (int i = tid; i < 3 * 1024; i += 256) {
    int s = i >> 10, k = i & 1023;
    float v = s < 2 ? P.c[s * D + k] : P.c_ctx[k];
    sv[i] = v / (1.f + __expf(-v));
  }
  __syncthreads();
  const int col = tid & 63, kg = tid >> 6;
  const float* wp = P.w_ada + (size_t)l * D * INC + n0 + col;
  float a0 = 0.f, a1 = 0.f, a2 = 0.f;
  for (int k = kg * 256; k < kg * 256 + 256; ++k) {
    float wv = wp[(size_t)k * INC];
    a0 += sv[k] * wv; a1 += sv[1024 + k] * wv; a2 += sv[2048 + k] * wv;
  }
  red[(kg * 3 + 0) * 64 + col] = a0; red[(kg * 3 + 1) * 64 + col] = a1; red[(kg * 3 + 2) * 64 + col] = a2;
  __syncthreads();
  if (tid < 192) {
    int s = tid >> 6, cc = tid & 63;
    float v = P.b_ada[(size_t)l * INC + n0 + cc];
    for (int g = 0; g < 4; ++g) v += red[(g * 3 + s) * 64 + cc];
    ((float*)(P.ws + oq(O_MOD)))[((size_t)l * 3 + s) * INC + n0 + cc] = v;
  }
  __syncthreads();
}

DI void tables_task(const Params& P, int t) {
  char* ws = P.ws;
  const int gtid = t * 256 + TIDX, gstride = 64 * 256;
  bf16_t* Wc = (bf16_t*)(ws + oq(O_WC));
  for (int i = gtid; i < 512 * 256; i += gstride) {
    int jj = i >> 8, c = i & 255, part = jj >> 8, j = jj & 255;
    float sn, cs; sincospif(2.f * (float)((j * c) & 255) / 256.f, &sn, &cs);
    Wc[i] = f2bf(part == 0 ? cs : -sn);
  }
  bf16_t* D1 = (bf16_t*)(ws + oq(O_D1));
  for (int i = gtid; i < 256 * 256; i += gstride) {
    int n = i >> 8, k = i & 255;
    int k1 = (n >> 6) * 32 + (n & 31), po = (n >> 5) & 1, pi = k >> 7, n1 = k & 127;
    float sn, cs; sincospif(2.f * (float)((k1 * n1) & 127) / 128.f, &sn, &cs);
    float v = po == 0 ? (pi == 0 ? cs : sn) : (pi == 0 ? -sn : cs);
    D1[i] = f2bf(v);
  }
  bf16_t* D2 = (bf16_t*)(ws + oq(O_D2));
  for (int i = gtid; i < 128 * 256; i += gstride) {
    int k2 = i >> 8, k = i & 255, pi = k >> 7, n2 = k & 127;
    float sn, cs; sincospif(2.f * (float)((k2 * n2) & 127) / 128.f, &sn, &cs);
    D2[i] = f2bf(pi == 0 ? cs : sn);
  }
  bf16_t* Dc = (bf16_t*)(ws + oq(O_DC));
  for (int i = gtid; i < 256 * 512; i += gstride) {
    int kk = i >> 9, k = i & 511, pi = k >> 8, n = k & 255;
    float sn, cs; sincospif(2.f * (float)((kk * n) & 255) / 256.f, &sn, &cs);
    Dc[i] = f2bf(pi == 0 ? cs : sn);
  }
  float* rope = (float*)(ws + oq(O_ROPE));
  for (int i = gtid; i < 256 * 8; i += gstride) {
    int pos = i >> 3, f = i & 7;
    float inv = powf(10000.f, -(float)f / 8.f);
    float ang = (float)pos * inv;
    rope[i * 2 + 0] = cosf(ang);
    rope[i * 2 + 1] = sinf(ang);
  }
  if (t == 0 && TIDX < 2) {
    const int l = TIDX;
    float* cst = (float*)(ws + oq(O_CONST)) + l * 8;
    const float* lv = P.df_lambda + l * 128;
    float d01 = 0.f, d23 = 0.f;
    for (int i = 0; i < 32; ++i) { d01 += lv[i] * lv[32 + i]; d23 += lv[64 + i] * lv[96 + i]; }
    float lam_init = 0.8f - 0.6f * expf(-0.3f * (float)l);
    cst[0] = expf(d01) - expf(d23) + lam_init;
    cst[1] = lam_init;
    float gq = 0.f, gk = 0.f;
    for (int i = 0; i < 32; ++i) { gq = fmaxf(gq, fabsf(P.df_q_g[l * 32 + i])); gk = fmaxf(gk, fabsf(P.df_k_g[l * 32 + i])); }
    cst[2] = sqrtf(32.f) * gq * gk * LOG2E;
    gq = 0.f; gk = 0.f;
    for (int i = 0; i < 64; ++i) { gq = fmaxf(gq, fabsf(P.na_q_g[l * 64 + i])); gk = fmaxf(gk, fabsf(P.na_k_g[l * 64 + i])); }
    float bm = 0.f;
    for (int i = 0; i < 4 * 15 * 31; ++i) bm = fmaxf(bm, fabsf(P.na_rpb[l * 4 * 15 * 31 + i]));
    cst[3] = (8.f * gq * gk + bm) * LOG2E;
  }
}

DI void modnorm_phase(const Params& P, int l, bool second, int bid, int nb, char* smem) {
  const int lane = TIDX & 63, w = TIDX >> 6;
  const int nw = nb * 4;
  bf16_t* h = (bf16_t*)(P.ws + oq(O_H));
  const float* g = (second ? P.g_ffn : P.g_mix) + (size_t)l * D;
  float* wt = (float*)smem;
  if (second) {
    const float* wr = P.w_router + (size_t)l * D * NE;
    for (int idx = TIDX; idx < D * NE; idx += 256) wt[(idx & 15) * D + (idx >> 4)] = wr[idx];
    __syncthreads();
  }
  for (int r = bid * 4 + w; r < R; r += nw) {
    int b, p; row_info(r, b, p);
    const bool isctx = p >= T;
    if (l == 1 && second && isctx) continue;
    const float* src = (l == 0 && !second) ? x_in_row(P, r) : x_buf_row(P, r);
    const int s = isctx ? 2 : b;
    const float* mb = (const float*)(P.ws + oq(O_MOD)) + ((size_t)l * 3 + s) * INC + (second ? 3 * D : 0);
    float4 v[4];
    float ss = 0.f;
#pragma unroll
    for (int i = 0; i < 4; ++i) {
      v[i] = *(const float4*)(src + lane * 4 + 256 * i);
      ss += v[i].x * v[i].x + v[i].y * v[i].y + v[i].z * v[i].z + v[i].w * v[i].w;
    }
    ss = wave_sum(ss);
    const float rstd = rsqrtf(ss * (1.f / D) + EPS);
    float hv[16];
#pragma unroll
    for (int i = 0; i < 4; ++i) {
      const int c = lane * 4 + 256 * i;
      float4 gg = *(const float4*)(g + c), sh = *(const float4*)(mb + c), sc = *(const float4*)(mb + D + c);
      hv[i * 4 + 0] = v[i].x * rstd * gg.x * (1.f + sc.x) + sh.x;
      hv[i * 4 + 1] = v[i].y * rstd * gg.y * (1.f + sc.y) + sh.y;
      hv[i * 4 + 2] = v[i].z * rstd * gg.z * (1.f + sc.z) + sh.z;
      hv[i * 4 + 3] = v[i].w * rstd * gg.w * (1.f + sc.w) + sh.w;
      uint2 o = {pack2(hv[i * 4 + 0], hv[i * 4 + 1]), pack2(hv[i * 4 + 2], hv[i * 4 + 3])};
      *(uint2*)(h + (size_t)r * D + c) = o;
    }
    if (second) {
      float lg[16];
#pragma unroll
      for (int e = 0; e < 16; ++e) lg[e] = 0.f;
#pragma unroll
      for (int i = 0; i < 4; ++i) {
#pragma unroll
        for (int e = 0; e < 16; ++e) {
          const float4 w4 = *(const float4*)(wt + e * D + 256 * i + lane * 4);
          lg[e] += hv[i * 4 + 0] * w4.x + hv[i * 4 + 1] * w4.y + hv[i * 4 + 2] * w4.z + hv[i * 4 + 3] * w4.w;
          if ((e & 3) == 3) __builtin_amdgcn_sched_barrier(0);
        }
      }
      float mx = -1e30f;
#pragma unroll
      for (int e = 0; e < 16; ++e) { lg[e] = wave_sum(lg[e]); mx = fmaxf(mx, lg[e]); }
      float sum = 0.f, mine = 0.f;
#pragma unroll
      for (int e = 0; e < 16; ++e) { float ex = __expf(lg[e] - mx); sum += ex; if (lane == e) mine = ex; }
      if (lane < 16) {
        const int smp = isctx ? 2 + b : b, n = isctx ? p - T : p;
        ((float*)(P.ws + oq(O_AFF)))[((size_t)smp * NE + lane) * T + n] = mine / sum;
      }
    }
  }
  __syncthreads();
}

template <int G>
DI void epi_rms(const float* Tt, const float* __restrict__ gain, bool rope, const float* __restrict__ ropetab,
                float scale, bf16_t* __restrict__ dst, int dcol0, int r0) {
  constexpr int NG = 128 / G;
  for (int it = TIDX; it < 128 * NG; it += 256) {
    const int row = it / NG, grp = it % NG;
    const float* tp = Tt + row * 132 + grp * G;
    float ss = 0.f;
#pragma unroll
    for (int d = 0; d < G; d += 4) {
      float4 q = *(const float4*)(tp + d);
      ss += q.x * q.x + q.y * q.y + q.z * q.z + q.w * q.w;
    }
    const float rstd = rsqrtf(ss * (1.f / G) + EPS);
    const float* gp = gain;
    asm volatile("" : "+s"(gp));
    int b, p; row_info(r0 + row, b, p);
    const bool dorope = (G == 32) && rope && (p < T);
    uint4* dp = (uint4*)(dst + (size_t)(r0 + row) * 256 + dcol0 + grp * G);
#pragma unroll 1
    for (int sub = 0; sub < G / 16; ++sub) {
      float v[16];
#pragma unroll
      for (int d = 0; d < 16; d += 4) {
        float4 q = *(const float4*)(tp + sub * 16 + d);
        float4 g4 = *(const float4*)(gp + sub * 16 + d);
        v[d] = q.x * rstd * g4.x; v[d + 1] = q.y * rstd * g4.y; v[d + 2] = q.z * rstd * g4.z; v[d + 3] = q.w * rstd * g4.w;
      }
      if (dorope) {
        const int pos = sub ? (p & 63) : (p >> 6);
#pragma unroll
        for (int i = 0; i < 8; ++i) {
          const float2 cssn = *(const float2*)(ropetab + (pos * 8 + i) * 2);
          const float x1 = v[i], x2 = v[8 + i];
          v[i] = x1 * cssn.x - x2 * cssn.y;
          v[8 + i] = x1 * cssn.y + x2 * cssn.x;
        }
      }
      dp[sub * 2] = make_uint4(pack2(v[0] * scale, v[1] * scale), pack2(v[2] * scale, v[3] * scale),
                               pack2(v[4] * scale, v[5] * scale), pack2(v[6] * scale, v[7] * scale));
      dp[sub * 2 + 1] = make_uint4(pack2(v[8] * scale, v[9] * scale), pack2(v[10] * scale, v[11] * scale),
                                   pack2(v[12] * scale, v[13] * scale), pack2(v[14] * scale, v[15] * scale));
    }
  }
}
DI void epi_plain(const float* Tt, bf16_t* __restrict__ dst, int dcol0, int r0) {
  const int row = TIDX >> 1, c0 = (TIDX & 1) * 64;
  uint4* dp = (uint4*)(dst + (size_t)(r0 + row) * 256 + dcol0 + c0);
#pragma unroll
  for (int d = 0; d < 64; d += 8) {
    float4 a = *(const float4*)(Tt + row * 132 + c0 + d), b = *(const float4*)(Tt + row * 132 + c0 + d + 4);
    dp[d >> 3] = make_uint4(pack2(a.x, a.y), pack2(a.z, a.w), pack2(b.x, b.y), pack2(b.z, b.w));
  }
}
DI void epi_transposed(const float* Tt, bf16_t* __restrict__ vt, int hd0, int bb, int p0) {
  const int c = TIDX >> 1, half = TIDX & 1;
  const int hd = hd0 + c;
  uint4* dp = (uint4*)(vt + ((size_t)bb * 256 + hd) * PB + p0 + half * 64);
#pragma unroll
  for (int q = 0; q < 8; ++q) {
    float f[8];
#pragma unroll
    for (int j = 0; j < 8; ++j) {
      const int tk = (q >> 1) * 16 + ((q & 1) ? (j < 4 ? j + 4 : j + 8) : (j < 4 ? j : j + 4));
      f[j] = Tt[(half * 64 + tk) * 132 + c];
    }
    dp[q] = make_uint4(pack2(f[0], f[1]), pack2(f[2], f[3]), pack2(f[4], f[5]), pack2(f[6], f[7]));
  }
}

DI void inproj_tile(const Params& P, int l, int mt, int nt, char* smem) {
  char* ws = P.ws;
  const int r0 = mt * 128;
  f32x16 acc[2][4];
  zero_acc8(acc);
  PlainRows ar{(const bf16_t*)(ws + oq(O_H)) + (size_t)r0 * D, D};
  gemm_main2(ar, (const bf16_t*)(ws + smallw(l) + oq(O_WT_IN)) + (size_t)nt * 256 * D, D, D, smem, acc);
  const int tid = TIDX, lane = tid & 63, w = tid >> 6, wm = w >> 1, wn = w & 1, r = lane & 31, hh = lane >> 5;
  if (nt >= 4 && nt < 20) {
    bf16_t* gates = (bf16_t*)(ws + oq(O_GATES));
#pragma unroll
    for (int mb = 0; mb < 2; ++mb)
#pragma unroll
      for (int nb2 = 0; nb2 < 4; ++nb2) {
        const int mt32 = mt * 4 + wm * 2 + mb, nt32 = (nt - 4) * 8 + wn * 4 + nb2;
        float sg[16];
#pragma unroll
        for (int i = 0; i < 16; ++i) sg[i] = 1.f / (1.f + __expf(-acc[mb][nb2][i]));
        uint4* gp = (uint4*)(gates + (((size_t)mt32 * 128 + nt32) * 64 + lane) * 16);
        gp[0] = make_uint4(pack2(sg[0], sg[1]), pack2(sg[2], sg[3]), pack2(sg[4], sg[5]), pack2(sg[6], sg[7]));
        gp[1] = make_uint4(pack2(sg[8], sg[9]), pack2(sg[10], sg[11]), pack2(sg[12], sg[13]), pack2(sg[14], sg[15]));
      }
    return;
  }
  float* Tt = (float*)smem;
  bf16_t* qpf = (bf16_t*)(ws + oq(O_QPF));
  bf16_t* kv = (bf16_t*)(ws + oq(O_KV));
  const float* ropetab = (const float*)(ws + oq(O_ROPE));
  const size_t S = (size_t)R * 256;
  int bb, p0; row_info(r0, bb, p0);
#pragma unroll 1
  for (int half = 0; half < 2; ++half) {
    if (wn == half) {
#pragma unroll
      for (int mb = 0; mb < 2; ++mb)
#pragma unroll
        for (int nb2 = 0; nb2 < 4; ++nb2)
#pragma unroll
          for (int i = 0; i < 16; ++i) {
            const int m = wm * 64 + mb * 32 + crow(i, hh), n = nb2 * 32 + r;
            Tt[m * 132 + n] = acc[mb][nb2][i];
          }
    }
    __syncthreads();
    const int dc = half * 128;
    if (nt == 0) epi_rms<64>(Tt, P.na_q_g + l * 64, false, ropetab, 0.125f * LOG2E, qpf, dc, r0);
    else if (nt == 1) epi_rms<32>(Tt, P.df_q_g + l * 32, true, ropetab, 0.17677669529663687f * LOG2E, qpf + S, dc, r0);
    else if (nt == 2) epi_plain(Tt, qpf + 2 * S, dc, r0);
    else if (nt == 3) epi_plain(Tt, qpf + 3 * S, dc, r0);
    else if (nt == 20) epi_rms<64>(Tt, P.na_k_g + l * 64, false, ropetab, 1.f, kv, dc, r0);
    else if (nt == 21) epi_transposed(Tt, kv + 2 * S, dc, bb, p0);
    else if (nt == 22) epi_rms<32>(Tt, P.df_k_g + l * 32, true, ropetab, 1.f, kv + S, dc, r0);
    else epi_transposed(Tt, kv + 3 * S, dc, bb, p0);
    __syncthreads();
  }
}

DI void diffattn_task(const Params& P, int l, int b, int hd, int q0, int key_lo, int nkeys, char* smem) {
  char* ws = P.ws;
  const int tid = TIDX, lane = tid & 63, w = tid >> 6, r = lane & 31, hh = lane >> 5;
  const bf16_t* qd = (const bf16_t*)(ws + oq(O_QPF)) + (size_t)R * 256;
  const bf16_t* kd = (const bf16_t*)(ws + oq(O_KV)) + (size_t)R * 256;
  const bf16_t* vt = (const bf16_t*)(ws + oq(O_KV)) + (size_t)3 * R * 256;
  bf16_t* yd = (bf16_t*)(ws + oq(O_Y)) + (size_t)R * 256;
  const float* cst = (const float*)(ws + oq(O_CONST)) + l * 8;
  const float lam = cst[0], lam_init = cst[1];
  const int qrow = b * PB + q0 + w * 32 + r;
  bf16x8 qf[2][2];
#pragma unroll
  for (int m = 0; m < 2; ++m)
#pragma unroll
    for (int ks = 0; ks < 2; ++ks)
      qf[m][ks] = *(const bf16x8*)(qd + (size_t)qrow * 256 + hd * 64 + m * 32 + ks * 16 + hh * 8);
  f32x16 O[2][2];
  O[0][0] = O[0][1] = O[1][0] = O[1][1] = fzero();
  float ls0 = 0.f, ls1 = 0.f;
  const f32x16 zero16 = fzero();
  constexpr int KT = 64 * LROW * 2;
  const bf16_t* kbase = kd + ((size_t)b * PB + key_lo) * 256 + hd * 64;
  const bf16_t* vbase = vt + ((size_t)(b * 4 + hd) * 64) * PB + key_lo;
  const int c0 = tid, c1 = tid + 256;
  u32x4 rk0, rk1, rv0, rv1;
#define DA_LOAD(t)                                                                       \
  {                                                                                      \
    rk0 = *(const u32x4*)(kbase + ((size_t)((t) * 64 + (c0 >> 3))) * 256 + (c0 & 7) * 8); \
    rk1 = *(const u32x4*)(kbase + ((size_t)((t) * 64 + (c1 >> 3))) * 256 + (c1 & 7) * 8); \
    rv0 = *(const u32x4*)(vbase + (size_t)(c0 >> 3) * PB + (t) * 64 + (c0 & 7) * 8);      \
    rv1 = *(const u32x4*)(vbase + (size_t)(c1 >> 3) * PB + (t) * 64 + (c1 & 7) * 8);      \
  }
#define DA_STORE(buf)                                                          \
  {                                                                            \
    char* kb_ = smem + (buf) * 2 * KT;                                         \
    *(u32x4*)(kb_ + ((c0 >> 3) * LROW + (c0 & 7) * 8) * 2) = rk0;              \
    *(u32x4*)(kb_ + ((c1 >> 3) * LROW + (c1 & 7) * 8) * 2) = rk1;              \
    *(u32x4*)(kb_ + KT + ((c0 >> 3) * LROW + (c0 & 7) * 8) * 2) = rv0;         \
    *(u32x4*)(kb_ + KT + ((c1 >> 3) * LROW + (c1 & 7) * 8) * 2) = rv1;         \
  }
  const int nt = nkeys >> 6;
  DA_LOAD(0);
  DA_STORE(0);
  if (nt > 1) DA_LOAD(1);
  for (int t = 0; t < nt; ++t) {
    __syncthreads();
    if (t + 1 < nt) {
      DA_STORE((t + 1) & 1);
      if (t + 2 < nt) DA_LOAD(t + 2);
    }
    const char* Ks = smem + (t & 1) * 2 * KT;
    const char* Vs = Ks + KT;
#pragma unroll
    for (int kb = 0; kb < 2; ++kb) {
      f32x16 S0, S1;
      {
        bf16x8 k00 = *(const bf16x8*)(Ks + ((kb * 32 + r) * LROW + hh * 8) * 2);
        bf16x8 k10 = *(const bf16x8*)(Ks + ((kb * 32 + r) * LROW + 32 + hh * 8) * 2);
        bf16x8 k01 = *(const bf16x8*)(Ks + ((kb * 32 + r) * LROW + 16 + hh * 8) * 2);
        bf16x8 k11 = *(const bf16x8*)(Ks + ((kb * 32 + r) * LROW + 48 + hh * 8) * 2);
        S0 = MFMA32(k00, qf[0][0], zero16);
        S1 = MFMA32(k10, qf[1][0], zero16);
        S0 = MFMA32(k01, qf[0][1], S0);
        S1 = MFMA32(k11, qf[1][1], S1);
      }
#pragma unroll
      for (int i = 0; i < 16; ++i) {
        S0[i] = __builtin_amdgcn_exp2f(S0[i]); ls0 += S0[i];
        S1[i] = __builtin_amdgcn_exp2f(S1[i]); ls1 += S1[i];
      }
#pragma unroll
      for (int s = 0; s < 2; ++s) {
        bf16x8 p0 = pack8(S0[8 * s], S0[8 * s + 1], S0[8 * s + 2], S0[8 * s + 3], S0[8 * s + 4], S0[8 * s + 5], S0[8 * s + 6], S0[8 * s + 7]);
        bf16x8 p1 = pack8(S1[8 * s], S1[8 * s + 1], S1[8 * s + 2], S1[8 * s + 3], S1[8 * s + 4], S1[8 * s + 5], S1[8 * s + 6], S1[8 * s + 7]);
#pragma unroll
        for (int vb = 0; vb < 2; ++vb) {
          const bf16x8 vf = *(const bf16x8*)(Vs + ((vb * 32 + r) * LROW + kb * 32 + 16 * s + 8 * hh) * 2);
          O[0][vb] = MFMA32(vf, p0, O[0][vb]);
          O[1][vb] = MFMA32(vf, p1, O[1][vb]);
        }
      }
    }
  }
  __syncthreads();
#undef DA_LOAD
#undef DA_STORE
  ls0 += __shfl_xor(ls0, 32, 64);
  ls1 += __shfl_xor(ls1, 32, 64);
  const float i0 = 1.f / ls0, i1 = lam / ls1;
  float ssq = 0.f;
#pragma unroll
  for (int vb = 0; vb < 2; ++vb)
#pragma unroll
    for (int i = 0; i < 16; ++i) {
      float o = O[0][vb][i] * i0 - O[1][vb][i] * i1;
      O[0][vb][i] = o;
      ssq += o * o;
    }
  ssq += __shfl_xor(ssq, 32, 64);
  const float rstd = rsqrtf(ssq * (1.f / 64.f) + EPS) * (1.f - lam_init);
  const float* sg = P.df_subln_g + l * 64;
#pragma unroll
  for (int vb = 0; vb < 2; ++vb)
#pragma unroll
    for (int g4 = 0; g4 < 4; ++g4) {
      const int vd = vb * 32 + 8 * g4 + 4 * hh;
      float o0 = O[0][vb][4 * g4] * rstd * sg[vd], o1 = O[0][vb][4 * g4 + 1] * rstd * sg[vd + 1];
      float o2 = O[0][vb][4 * g4 + 2] * rstd * sg[vd + 2], o3 = O[0][vb][4 * g4 + 3] * rstd * sg[vd + 3];
      uint2 pk = {pack2(o0, o1), pack2(o2, o3)};
      *(uint2*)(yd + (size_t)qrow * 256 + hd * 64 + vd) = pk;
    }
}

DI void na_task(const Params& P, int l, int b, bool ctxq, int rr, int qsel, char* smem) {
  char* ws = P.ws;
  const int tid = TIDX, lane = tid & 63, hd = tid >> 6, r = lane & 31, hh = lane >> 5;
  float* rp = (float*)smem;
  if (!ctxq) {
    for (int i = tid; i < 4 * 15 * 31; i += 256) rp[i] = P.na_rpb[(size_t)l * 4 * 15 * 31 + i] * LOG2E;
  }
  __syncthreads();
  const bf16_t* qn = (const bf16_t*)(ws + oq(O_QPF));
  const bf16_t* kn = (const bf16_t*)(ws + oq(O_KV));
  const bf16_t* vt = (const bf16_t*)(ws + oq(O_KV)) + (size_t)2 * R * 256;
  bf16_t* yn = (bf16_t*)(ws + oq(O_Y));
  const float negC = -((const float*)(ws + oq(O_CONST)))[l * 8 + 3];
  int cq[2], qrow[2], cs[2];
  bf16x8 qf[2][4];
  f32x16 O[2][2];
  float ls[2];
#pragma unroll
  for (int a = 0; a < 2; ++a) {
    cq[a] = (qsel + a) * 32 + r;
    const int qp = ctxq ? T + cq[a] : rr * 64 + cq[a];
    qrow[a] = b * PB + qp;
    cs[a] = min(max(cq[a] - 8, 0), 48);
#pragma unroll
    for (int ks = 0; ks < 4; ++ks) qf[a][ks] = *(const bf16x8*)(qn + (size_t)qrow[a] * 256 + hd * 64 + ks * 16 + hh * 8);
    O[a][0] = O[a][1] = fzero();
    ls[a] = 0.f;
  }
  const int rs = min(max(rr - 4, 0), 248);
  const int nblk = ctxq ? 8 : 24;
  const bf16_t* vtb = vt + ((size_t)(b * 4 + hd) * 64) * PB;
  for (int kbi = 0; kbi < nblk; ++kbi) {
    const bool loc = !ctxq && kbi < 16;
    const int ir = kbi >> 1, kb = kbi & 1;
    const int pk0 = loc ? (rs + ir) * 64 + kb * 32 : T + (kbi - (ctxq ? 0 : 16)) * 32;
    const bf16_t* kp = kn + ((size_t)b * PB + pk0 + r) * 256 + hd * 64 + hh * 8;
    bf16x8 kf[4];
#pragma unroll
    for (int ks = 0; ks < 4; ++ks) kf[ks] = *(const bf16x8*)(kp + ks * 16);
    bf16x8 vf[2][2];
#pragma unroll
    for (int s = 0; s < 2; ++s)
#pragma unroll
      for (int vb = 0; vb < 2; ++vb) vf[s][vb] = *(const bf16x8*)(vtb + (size_t)(vb * 32 + r) * PB + pk0 + 16 * s + 8 * hh);
    const float* rpr = rp + (hd * 15 + (rs + ir - rr + 7)) * 31;
#pragma unroll
    for (int a = 0; a < 2; ++a) {
      f32x16 S;
#pragma unroll
      for (int i = 0; i < 16; ++i) S[i] = negC;
#pragma unroll
      for (int ks = 0; ks < 4; ++ks) S = MFMA32(kf[ks], qf[a][ks], S);
      if (loc) {
#pragma unroll
        for (int i = 0; i < 16; ++i) {
          const int kc = kb * 32 + crow(i, hh);
          const bool valid = (kc >= cs[a]) && (kc < cs[a] + 16);
          const int ci = min(max(kc - cq[a] + 15, 0), 30);
          const float pv = __builtin_amdgcn_exp2f(S[i] + rpr[ci]);
          S[i] = valid ? pv : 0.f;
          ls[a] += S[i];
        }
      } else {
#pragma unroll
        for (int i = 0; i < 16; ++i) { S[i] = __builtin_amdgcn_exp2f(S[i]); ls[a] += S[i]; }
      }
#pragma unroll
      for (int s = 0; s < 2; ++s) {
        bf16x8 pf = pack8(S[8 * s], S[8 * s + 1], S[8 * s + 2], S[8 * s + 3], S[8 * s + 4], S[8 * s + 5], S[8 * s + 6], S[8 * s + 7]);
#pragma unroll
        for (int vb = 0; vb < 2; ++vb) O[a][vb] = MFMA32(vf[s][vb], pf, O[a][vb]);
      }
    }
  }
#pragma unroll
  for (int a = 0; a < 2; ++a) {
    float lsa = ls[a];
    lsa += __shfl_xor(lsa, 32, 64);
    const float inv = 1.f / lsa;
#pragma unroll
    for (int vb = 0; vb < 2; ++vb)
#pragma unroll
      for (int g4 = 0; g4 < 4; ++g4) {
        const int vd = vb * 32 + 8 * g4 + 4 * hh;
        uint2 pk = {pack2(O[a][vb][4 * g4] * inv, O[a][vb][4 * g4 + 1] * inv), pack2(O[a][vb][4 * g4 + 2] * inv, O[a][vb][4 * g4 + 3] * inv)};
        *(uint2*)(yn + (size_t)qrow[a] * 256 + hd * 64 + vd) = pk;
      }
  }
  __syncthreads();
}

DI void pool_task(const Params& P, int l, int tile, char* smem) {
  char* ws = P.ws;
  const int tid = TIDX;
  const int r0 = tile * 32;
  int b, p0; row_info(r0, b, p0);
  const bool isctx = p0 >= T;
  const int seq0 = isctx ? T : 0, N = isctx ? CTXL : T;
  const int t0 = p0 - seq0;
  const bf16_t* pin = (const bf16_t*)(ws + oq(O_QPF)) + (size_t)2 * R * 256;
  bf16_t* yp = (bf16_t*)(ws + oq(O_Y)) + (size_t)2 * R * 256;
  bf16_t* us = (bf16_t*)smem;
  float* ds = (float*)(smem + 48 * 256 * 2);
  for (int i = tid; i < 48 * 32; i += 256) {
    const int rowi = i >> 5, ch = (i & 31) * 8;
    const int tk = t0 - 8 + rowi;
    uint4 v = make_uint4(0, 0, 0, 0);
    if (tk >= 0 && tk < N) v = *(const uint4*)(pin + ((size_t)b * PB + seq0 + tk) * 256 + ch);
    *(uint4*)(us + rowi * 256 + ch) = v;
  }
  __syncthreads();
  {
    const int ch = tid, gi = ch >> 6, wv = 2 << gi;
    for (int t = 0; t < 32; ++t) {
      const int tk = t0 + t;
      const int lo = max(tk - wv / 2, 0), hi = min(tk + wv / 2, N);
      float s = 0.f;
      for (int q = lo; q < hi; ++q) s += bf2f(us[(q - t0 + 8) * 256 + ch]);
      ds[t * 256 + ch] = s / (float)(hi - lo) - bf2f(us[(t + 8) * 256 + ch]);
    }
  }
  __syncthreads();
  {
    const int o = tid, gi = o >> 6;
    const float* wp = P.pool_w + ((size_t)l * 4 + gi) * 64 * 64 + (o & 63);
    float acc[32];
#pragma unroll
    for (int t = 0; t < 32; ++t) acc[t] = 0.f;
    for (int k = 0; k < 64; ++k) {
      const float wv = wp[k * 64];
#pragma unroll
      for (int t = 0; t < 32; ++t) acc[t] += ds[t * 256 + gi * 64 + k] * wv;
    }
    const float sc = P.pool_scale[l * 256 + o];
#pragma unroll
    for (int t = 0; t < 32; ++t) yp[(size_t)(r0 + t) * 256 + o] = f2bf(acc[t] * sc);
  }
  __syncthreads();
}

struct StridedRows {
  const bf16_t* base; long ld;
  DI const bf16_t* operator()(int m) const { return base + (long)m * ld; }
};
DI void fft_stage0_lat(const Params& P, int task, char* smem) {
  char* ws = P.ws;
  const int ntile = task & 3, n2 = (task >> 2) & 127, b = task >> 9;
  const bf16_t* fin = (const bf16_t*)(ws + oq(O_QPF)) + (size_t)3 * R * 256;
  f32x16 acc[2][2];
  acc[0][0] = acc[0][1] = acc[1][0] = acc[1][1] = fzero();
  StridedRows ar{fin + ((size_t)b * PB + n2) * 256, 128 * 256};
  gemm_main(ar, (const bf16_t*)(ws + oq(O_WC)) + (size_t)ntile * 128 * 256, 256, 256, smem, acc);
  bf16_t* Z1 = (bf16_t*)(ws + oq(O_Z1));
  const int lane = TIDX & 63, w = TIDX >> 6, wm = w >> 1, wn = w & 1, r = lane & 31, hh = lane >> 5;
#pragma unroll
  for (int mb = 0; mb < 2; ++mb)
#pragma unroll
    for (int nb2 = 0; nb2 < 2; ++nb2) {
      const int jj = ntile * 128 + wn * 64 + nb2 * 32 + r, part = jj >> 8, j = jj & 255;
#pragma unroll
      for (int g4 = 0; g4 < 4; ++g4) {
        const int n1 = wm * 64 + mb * 32 + 8 * g4 + 4 * hh;
        uint2 pk = {pack2(acc[mb][nb2][4 * g4], acc[mb][nb2][4 * g4 + 1]), pack2(acc[mb][nb2][4 * g4 + 2], acc[mb][nb2][4 * g4 + 3])};
        *(uint2*)(Z1 + (((size_t)(b * 128 + n2) * 256 + j) * 256 + part * 128 + n1)) = pk;
      }
    }
}
DI void fft_stage0_ctx(const Params& P, int task, char* smem) {
  char* ws = P.ws;
  const int ntile = task & 3, mtile = (task >> 2) & 1, b = task >> 3;
  const bf16_t* fin = (const bf16_t*)(ws + oq(O_QPF)) + (size_t)3 * R * 256;
  f32x16 acc[2][2];
  acc[0][0] = acc[0][1] = acc[1][0] = acc[1][1] = fzero();
  PlainRows ar{fin + ((size_t)b * PB + T + mtile * 128) * 256, 256};
  gemm_main(ar, (const bf16_t*)(ws + oq(O_WC)) + (size_t)ntile * 128 * 256, 256, 256, smem, acc);
  bf16_t* Z1c = (bf16_t*)(ws + oq(O_Z1C));
  const int lane = TIDX & 63, w = TIDX >> 6, wm = w >> 1, wn = w & 1, r = lane & 31, hh = lane >> 5;
#pragma unroll
  for (int mb = 0; mb < 2; ++mb)
#pragma unroll
    for (int nb2 = 0; nb2 < 2; ++nb2) {
      const int jj = ntile * 128 + wn * 64 + nb2 * 32 + r, part = jj >> 8, j = jj & 255;
#pragma unroll
      for (int g4 = 0; g4 < 4; ++g4) {
        const int n = mtile * 128 + wm * 64 + mb * 32 + 8 * g4 + 4 * hh;
        uint2 pk = {pack2(acc[mb][nb2][4 * g4], acc[mb][nb2][4 * g4 + 1]), pack2(acc[mb][nb2][4 * g4 + 2], acc[mb][nb2][4 * g4 + 3])};
        *(uint2*)(Z1c + (((size_t)(b * 256 + j)) * 512 + part * 256 + n)) = pk;
      }
    }
}
DI void fft_stage1_lat(const Params& P, int task, char* smem) {
  char* ws = P.ws;
  const int ntile = task & 1, j = (task >> 1) & 255, b = task >> 9;
  f32x16 acc[2][2];
  acc[0][0] = acc[0][1] = acc[1][0] = acc[1][1] = fzero();
  StridedRows ar{(const bf16_t*)(ws + oq(O_Z1)) + ((size_t)(b * 128) * 256 + j) * 256, 256 * 256};
  gemm_main(ar, (const bf16_t*)(ws + oq(O_D1)) + (size_t)ntile * 128 * 256, 256, 256, smem, acc);
  bf16_t* Z2 = (bf16_t*)(ws + oq(O_Z2));
  const int lane = TIDX & 63, w = TIDX >> 6, wm = w >> 1, wn = w & 1, r = lane & 31, hh = lane >> 5;
  const int k1 = (ntile * 2 + wn) * 32 + r;
#pragma unroll
  for (int mb = 0; mb < 2; ++mb)
#pragma unroll
    for (int g4 = 0; g4 < 4; ++g4) {
      const int n2 = wm * 64 + mb * 32 + 8 * g4 + 4 * hh;
      float yr[4], yi[4];
#pragma unroll
      for (int q = 0; q < 4; ++q) {
        const float re = acc[mb][0][4 * g4 + q], im = acc[mb][1][4 * g4 + q];
        float sn, cs; sincospif(2.f * (float)((k1 * (n2 + q)) & 16383) / 16384.f, &sn, &cs);
        yr[q] = re * cs + im * sn;
        yi[q] = im * cs - re * sn;
      }
      bf16_t* zp = Z2 + (((size_t)(b * 128 + k1) * 256 + j) * 256 + n2);
      uint2 pr = {pack2(yr[0], yr[1]), pack2(yr[2], yr[3])}, pi = {pack2(yi[0], yi[1]), pack2(yi[2], yi[3])};
      *(uint2*)zp = pr;
      *(uint2*)(zp + 128) = pi;
    }
}
DI void fft_stage1_ctx(const Params& P, int task, char* smem) {
  char* ws = P.ws;
  const int ntile = task & 1, mtile = (task >> 1) & 1, b = task >> 2;
  f32x16 acc[2][2];
  acc[0][0] = acc[0][1] = acc[1][0] = acc[1][1] = fzero();
  PlainRows ar{(const bf16_t*)(ws + oq(O_Z1C)) + ((size_t)(b * 256 + mtile * 128)) * 512, 512};
  gemm_main(ar, (const bf16_t*)(ws + oq(O_DC)) + (size_t)ntile * 128 * 512, 512, 512, smem, acc);
  bf16_t* f = (bf16_t*)(ws + oq(O_QPF)) + (size_t)3 * R * 256;
  const int lane = TIDX & 63, w = TIDX >> 6, wm = w >> 1, wn = w & 1, r = lane & 31, hh = lane >> 5;
#pragma unroll
  for (int mb = 0; mb < 2; ++mb)
#pragma unroll
    for (int nb2 = 0; nb2 < 2; ++nb2) {
      const int k = ntile * 128 + wn * 64 + nb2 * 32 + r;
#pragma unroll
      for (int g4 = 0; g4 < 4; ++g4) {
        const int j = mtile * 128 + wm * 64 + mb * 32 + 8 * g4 + 4 * hh;
        const float sc = 1.f / 256.f;
        uint2 pk = {pack2(acc[mb][nb2][4 * g4] * sc, acc[mb][nb2][4 * g4 + 1] * sc),
                    pack2(acc[mb][nb2][4 * g4 + 2] * sc, acc[mb][nb2][4 * g4 + 3] * sc)};
        *(uint2*)(f + ((size_t)b * PB + T + k) * 256 + j) = pk;
      }
    }
}
DI void fft_stage2_lat(const Params& P, int task, char* smem) {
  char* ws = P.ws;
  const int jt = task & 1, k1 = (task >> 1) & 127, b = task >> 8;
  f32x16 acc[2][2];
  acc[0][0] = acc[0][1] = acc[1][0] = acc[1][1] = fzero();
  PlainRows ar{(const bf16_t*)(ws + oq(O_Z2)) + ((size_t)(b * 128 + k1) * 256 + jt * 128) * 256, 256};
  gemm_main(ar, (const bf16_t*)(ws + oq(O_D2)), 256, 256, smem, acc);
  bf16_t* f = (bf16_t*)(ws + oq(O_QPF)) + (size_t)3 * R * 256;
  const int lane = TIDX & 63, w = TIDX >> 6, wm = w >> 1, wn = w & 1, r = lane & 31, hh = lane >> 5;
#pragma unroll
  for (int mb = 0; mb < 2; ++mb)
#pragma unroll
    for (int nb2 = 0; nb2 < 2; ++nb2) {
      const int k2 = wn * 64 + nb2 * 32 + r;
#pragma unroll
      for (int g4 = 0; g4 < 4; ++g4) {
        const int j = jt * 128 + wm * 64 + mb * 32 + 8 * g4 + 4 * hh;
        const float sc = 1.f / 2048.f;
        uint2 pk = {pack2(acc[mb][nb2][4 * g4] * sc, acc[mb][nb2][4 * g4 + 1] * sc),
                    pack2(acc[mb][nb2][4 * g4 + 2] * sc, acc[mb][nb2][4 * g4 + 3] * sc)};
        *(uint2*)(f + ((size_t)b * PB + k1 + 128 * k2) * 256 + j) = pk;
      }
    }
}
DI void fnet_final_tile(const Params& P, int l, int mt, int nt, char* smem) {
  char* ws = P.ws;
  const int r0 = mt * 128;
  f32x16 acc[2][2];
  acc[0][0] = acc[0][1] = acc[1][0] = acc[1][1] = fzero();
  PlainRows ar{(const bf16_t*)(ws + oq(O_QPF)) + (size_t)3 * R * 256 + (size_t)r0 * 256, 256};
  gemm_main(ar, (const bf16_t*)(ws + smallw(l) + oq(O_WT_FN)) + (size_t)nt * 128 * 256, 256, 256, smem, acc);
  bf16_t* yf = (bf16_t*)(ws + oq(O_Y)) + (size_t)3 * R * 256;
  const int lane = TIDX & 63, w = TIDX >> 6, wm = w >> 1, wn = w & 1, r = lane & 31, hh = lane >> 5;
#pragma unroll
  for (int mb = 0; mb < 2; ++mb)
#pragma unroll
    for (int nb2 = 0; nb2 < 2; ++nb2)
#pragma unroll
      for (int i = 0; i < 16; ++i) {
        const int m = wm * 64 + mb * 32 + crow(i, hh), n = nt * 128 + wn * 64 + nb2 * 32 + r;
        yf[(size_t)(r0 + m) * 256 + n] = f2bf(acc[mb][nb2][i]);
      }
}

DI void merge_tile(const Params& P, int l, int mt, int nt, char* smem) {
  char* ws = P.ws;
  const int r0 = mt * 128;
  const int tid = TIDX, lane = tid & 63, w = tid >> 6, wm = w >> 1, wn = w & 1, r = lane & 31, hh = lane >> 5;
  const bf16_t* gates = (const bf16_t*)(ws + oq(O_GATES));
  f32x16 tot[2][2], acc[2][2];
  tot[0][0] = tot[0][1] = tot[1][0] = tot[1][1] = fzero();
  acc[0][0] = acc[0][1] = acc[1][0] = acc[1][1] = fzero();
  const int lrow = tid >> 3, lcc = (tid & 7) * 8;
  const bf16_t* pa0 = (const bf16_t*)(ws + oq(O_Y)) + (size_t)(r0 + lrow) * 256 + lcc;
  const bf16_t* pb0 = (const bf16_t*)(ws + smallw(l) + oq(O_WT_BR)) + (size_t)(nt * 128 + lrow) * 256 + lcc;
  constexpr long SA = (long)R * 256, SB = (long)D * 256;
  u32x4 ra0[4], rb0[4];
  u32x4 gq[2][2][2];
#define M_OFFA(kt) (((kt) >> 2) * SA + ((kt) & 3) * 64)
#define M_OFFB(kt) (((kt) >> 2) * SB + ((kt) & 3) * 64)
#define M_LOAD1(RA, RB, kt, i) RA[i] = *(const u32x4*)(pa0 + M_OFFA(kt) + i * 32 * 256); RB[i] = *(const u32x4*)(pb0 + M_OFFB(kt) + i * 32 * 256);
#define M_LOAD(RA, RB, kt) { M_LOAD1(RA, RB, kt, 0) M_LOAD1(RA, RB, kt, 1) M_LOAD1(RA, RB, kt, 2) M_LOAD1(RA, RB, kt, 3) }
#define M_STORE1(RA, RB, i) *(u32x4*)(base_ + ((lrow + 32 * i) * LROW + lcc) * 2) = RA[i]; *(u32x4*)(base_ + TILEB + ((lrow + 32 * i) * LROW + lcc) * 2) = RB[i];
#define M_STORE(RA, RB, buf) { char* base_ = smem + (buf) * 2 * TILEB; M_STORE1(RA, RB, 0) M_STORE1(RA, RB, 1) M_STORE1(RA, RB, 2) M_STORE1(RA, RB, 3) }
#define M_STEP(ks) { \
      bf16x8 a0 = *(const bf16x8*)(bA_ + ks * 32); \
      bf16x8 a1 = *(const bf16x8*)(bA_ + 32 * LROW * 2 + ks * 32); \
      bf16x8 b0 = *(const bf16x8*)(bB_ + ks * 32); \
      bf16x8 b1 = *(const bf16x8*)(bB_ + 32 * LROW * 2 + ks * 32); \
      acc[0][0] = MFMA32(a0, b0, acc[0][0]); \
      acc[0][1] = MFMA32(a0, b1, acc[0][1]); \
      acc[1][0] = MFMA32(a1, b0, acc[1][0]); \
      acc[1][1] = MFMA32(a1, b1, acc[1][1]); }
#define M_COMPUTE(buf) { \
    const char* bA_ = smem + (buf) * 2 * TILEB + ((wm * 64 + r) * LROW + hh * 8) * 2; \
    const char* bB_ = smem + (buf) * 2 * TILEB + TILEB + ((wn * 64 + r) * LROW + hh * 8) * 2; \
    M_STEP(0) M_STEP(1) M_STEP(2) M_STEP(3) }
#define M_GLOAD(i) { \
    _Pragma("unroll") for (int mb = 0; mb < 2; ++mb) \
      _Pragma("unroll") for (int nb2 = 0; nb2 < 2; ++nb2) { \
        const int mt32 = mt * 4 + wm * 2 + mb, nt32 = (i) * 32 + nt * 4 + wn * 2 + nb2; \
        const u32x4* gp = (const u32x4*)(gates + (((size_t)mt32 * 128 + nt32) * 64 + lane) * 16); \
        gq[mb][nb2][0] = gp[0]; gq[mb][nb2][1] = gp[1]; } }
#define M_APPLY() { \
    _Pragma("unroll") for (int mb = 0; mb < 2; ++mb) \
      _Pragma("unroll") for (int nb2 = 0; nb2 < 2; ++nb2) { \
        _Pragma("unroll") for (int q = 0; q < 16; ++q) { \
          const unsigned wv = gq[mb][nb2][q >> 3][(q >> 1) & 3]; \
          const float gv = __uint_as_float((q & 1) ? (wv & 0xffff0000u) : (wv << 16)); \
          tot[mb][nb2][q] += gv * acc[mb][nb2][q]; } \
        acc[mb][nb2] = fzero(); } }
  M_GLOAD(0);
  M_LOAD(ra0, rb0, 0);
  M_STORE(ra0, rb0, 0);
  M_LOAD(ra0, rb0, 1);
#pragma unroll 1
  for (int kt = 0; kt < 16; kt += 2) {
    __syncthreads();
    M_STORE(ra0, rb0, 1);
    if (kt + 2 < 16) M_LOAD(ra0, rb0, kt + 2);
    M_COMPUTE(0);
    __syncthreads();
    if (kt + 2 < 16) {
      M_STORE(ra0, rb0, 0);
      if (kt + 3 < 16) M_LOAD(ra0, rb0, kt + 3);
    }
    M_COMPUTE(1);
    if ((kt & 3) == 2) {
      M_APPLY();
      if (kt + 2 < 16) M_GLOAD((kt + 2) >> 2);
    }
  }
  __syncthreads();
#undef M_OFFA
#undef M_OFFB
#undef M_LOAD1
#undef M_LOAD
#undef M_STORE1
#undef M_STORE
#undef M_STEP
#undef M_COMPUTE
#undef M_GLOAD
#undef M_APPLY
  bf16_t* am = (bf16_t*)(ws + oq(O_ACCM));
#pragma unroll
  for (int mb = 0; mb < 2; ++mb)
#pragma unroll
    for (int nb2 = 0; nb2 < 2; ++nb2)
#pragma unroll
      for (int q = 0; q < 16; ++q) {
        const int m = wm * 64 + mb * 32 + crow(q, hh), n = nt * 128 + wn * 64 + nb2 * 32 + r;
        am[(size_t)(r0 + m) * D + n] = f2bf(tot[mb][nb2][q]);
      }
}
DI void outproj_tile(const Params& P, int l, int mt, int nt, char* smem) {
  char* ws = P.ws;
  const int r0 = mt * 128;
  f32x16 acc[2][4];
  zero_acc8(acc);
  PlainRows ar{(const bf16_t*)(ws + oq(O_ACCM)) + (size_t)r0 * D, D};
  gemm_main2(ar, (const bf16_t*)(ws + smallw(l) + oq(O_WT_OUT)) + (size_t)nt * 256 * D, D, D, smem, acc);
  const int lane = TIDX & 63, w = TIDX >> 6, wm = w >> 1, wn = w & 1, r = lane & 31, hh = lane >> 5;
  const int s = row_modsel(r0);
  const float* gt1 = (const float*)(ws + oq(O_MOD)) + ((size_t)l * 3 + s) * INC + 2 * D;
#pragma unroll
  for (int mb = 0; mb < 2; ++mb)
#pragma unroll
    for (int q = 0; q < 16; ++q) {
      const int m = wm * 64 + mb * 32 + crow(q, hh);
      const float* xi = (l == 0) ? x_in_row(P, r0 + m) : x_buf_row(P, r0 + m);
      float* xo = x_buf_row(P, r0 + m);
#pragma unroll
      for (int nb2 = 0; nb2 < 4; ++nb2) {
        const int n = nt * 256 + wn * 128 + nb2 * 32 + r;
        xo[n] = xi[n] + gt1[n] * acc[mb][nb2][q];
      }
    }
}

template <int NPT>
DI void topk_task(const Params& P, int smp, int e, char* smem) {
  char* ws = P.ws;
  constexpr int N = NPT * 256;
  constexpr int cap = N / 8;
  const int tid = TIDX, lane = tid & 63, w = tid >> 6;
  float* sv = (float*)smem;
  int* red = (int*)(smem + 65536);
  int* cg_ = (int*)(smem + 65536 + 64);
  int* ce_ = cg_ + 256;
  const float* aff = (const float*)(ws + oq(O_AFF)) + ((size_t)smp * NE + e) * T;
  for (int i = tid; i < N; i += 256) sv[i] = aff[i];
  __syncthreads();
  unsigned u[NPT];
#pragma unroll
  for (int j = 0; j < NPT; ++j) u[j] = __float_as_uint(sv[tid * NPT + j]);
  unsigned thr = 0;
  for (int bit = 30; bit >= 0; --bit) {
    const unsigned cand = thr | (1u << bit);
    int cnt = 0;
#pragma unroll
    for (int j = 0; j < NPT; ++j) cnt += (u[j] >= cand) ? 1 : 0;
#pragma unroll
    for (int o = 32; o >= 1; o >>= 1) cnt += __shfl_xor(cnt, o, 64);
    if (lane == 0) red[w] = cnt;
    __syncthreads();
    const int total = red[0] + red[1] + red[2] + red[3];
    __syncthreads();
    if (total >= cap) thr = cand;
  }
  int ng = 0, neq = 0;
#pragma unroll
  for (int j = 0; j < NPT; ++j) { ng += (u[j] > thr) ? 1 : 0; neq += (u[j] == thr) ? 1 : 0; }
  cg_[tid] = ng; ce_[tid] = neq;
  __syncthreads();
  int pg = 0, pe = 0, totg = 0;
  for (int i = 0; i < 256; ++i) {
    const int a = cg_[i], bq = ce_[i];
    if (i < tid) { pg += a; pe += bq; }
    totg += a;
  }
  const int need_eq = cap - totg;
  int* rows = (int*)(ws + oq(O_ROWS)) + (size_t)e * SLOTS;
  float* gl = (float*)(ws + oq(O_GL)) + (size_t)e * SLOTS;
  const int slot_base = smp < 2 ? smp * 2048 : 4096 + (smp - 2) * 32;
  const int row_base = smp < 2 ? smp * PB : (smp - 2) * PB + T;
#pragma unroll
  for (int j = 0; j < NPT; ++j) {
    const int idx = tid * NPT + j;
    int slot = -1;
    if (u[j] > thr) { slot = pg; ++pg; }
    else if (u[j] == thr) { if (pe < need_eq) slot = totg + pe; ++pe; }
    if (slot >= 0) { rows[slot_base + slot] = row_base + idx; gl[slot_base + slot] = __uint_as_float(u[j]); }
  }
  if (smp == 0 && tid < 64) rows[4160 + tid] = -1;
  __syncthreads();
}

struct GatherRows {
  const bf16_t* base; const int* rows;
  DI const bf16_t* operator()(int m) const { int rr = rows[m]; return base + (size_t)(rr < 0 ? 0 : rr) * D; }
};
DI void expert1_tile(const Params& P, int e, int mt, int nt, char* smem) {
  char* ws = P.ws;
  f32x16 acc[2][4];
  zero_acc8(acc);
  GatherRows ar{(const bf16_t*)(ws + oq(O_H)), (const int*)(ws + oq(O_ROWS)) + (size_t)e * SLOTS + mt * 128};
  gemm_main2(ar, (const bf16_t*)(ws + oq(O_WT_13)) + ((size_t)e * 2 * FF + nt * 256) * D, D, D, smem, acc);
  bf16_t* hid = (bf16_t*)(ws + oq(O_HID)) + ((size_t)e * SLOTS + mt * 128) * FF;
  const int lane = TIDX & 63, w = TIDX >> 6, wm = w >> 1, wn = w & 1, r = lane & 31, hh = lane >> 5;
#pragma unroll
  for (int pr = 0; pr < 2; ++pr) {
    const int f = nt * 128 + wn * 64 + pr * 32 + r;
#pragma unroll
    for (int mb = 0; mb < 2; ++mb)
#pragma unroll
      for (int q = 0; q < 16; ++q) {
        const int m = wm * 64 + mb * 32 + crow(q, hh);
        const float gv = acc[mb][2 * pr][q], uv = acc[mb][2 * pr + 1][q];
        hid[(size_t)m * FF + f] = f2bf(gv / (1.f + __expf(-gv)) * uv);
      }
  }
}
DI void expert2_tile(const Params& P, int l, int e, int mt, int nt, char* smem) {
  char* ws = P.ws;
  f32x16 acc[2][4];
  zero_acc8(acc);
  PlainRows ar{(const bf16_t*)(ws + oq(O_HID)) + ((size_t)e * SLOTS + mt * 128) * FF, FF};
  gemm_main2(ar, (const bf16_t*)(ws + oq(O_WT_2)) + ((size_t)e * D + nt * 256) * FF, FF, FF, smem, acc);
  const int* rows = (const int*)(ws + oq(O_ROWS)) + (size_t)e * SLOTS + mt * 128;
  const float* gl = (const float*)(ws + oq(O_GL)) + (size_t)e * SLOTS + mt * 128;
  const int lane = TIDX & 63, w = TIDX >> 6, wm = w >> 1, wn = w & 1, r = lane & 31, hh = lane >> 5;
#pragma unroll
  for (int mb = 0; mb < 2; ++mb)
#pragma unroll
    for (int q = 0; q < 16; ++q) {
      const int m = wm * 64 + mb * 32 + crow(q, hh);
      const int row = rows[m];
      if (row < 0) continue;
      const float gv = gl[m];
      const float* gt2 = (const float*)(ws + oq(O_MOD)) + ((size_t)l * 3 + row_modsel(row)) * INC + 5 * D;
      float* xo = x_buf_row(P, row);
#pragma unroll
      for (int nb2 = 0; nb2 < 4; ++nb2) {
        const int n = nt * 256 + wn * 128 + nb2 * 32 + r;
        unsafeAtomicAdd(xo + n, gt2[n] * gv * acc[mb][nb2][q]);
      }
    }
}

#define XB_TMO      128
#define XB_XCNT(j)  (256  + 64 * (j))
#define XB_XSUB(j)  (1280 + 64 * (j))
#define XB_XGEN(j)  (2304 + 64 * (j))
#define XB_TOP      3328
#define XB_TOPGEN   3392
#define XCD_BAR_WORDS 3456
#define XB_SPIN_CAP (1u << 18)
#define LAS __attribute__((address_space(3)))

__device__ __forceinline__ unsigned xb_ld(unsigned* p)              { return __hip_atomic_load(p, __ATOMIC_RELAXED, __HIP_MEMORY_SCOPE_AGENT); }
__device__ __forceinline__ unsigned xb_add(unsigned* p, unsigned v) { return __hip_atomic_fetch_add(p, v, __ATOMIC_RELAXED, __HIP_MEMORY_SCOPE_AGENT); }
__device__ __forceinline__ unsigned xb_xcc_id() { return (unsigned)__builtin_amdgcn_s_getreg((3 << 11) | 20) & 0xFu; }
#define XB_SPIN(cond, bar) do { unsigned _sp = 0; while (cond) { __builtin_amdgcn_s_sleep(1); \
    if ((++_sp & 255u) == 0u) { if (xb_ld(&(bar)[XB_TMO])) break; if (_sp > XB_SPIN_CAP) { atomicAdd(&(bar)[XB_TMO], 1u); break; } } } } while (0)

struct XcdBarrier {
    unsigned* bar; unsigned x;
    volatile LAS unsigned* st;
};

__device__ __forceinline__ XcdBarrier xcd_barrier_post(unsigned* bar, volatile LAS unsigned* st) {
    XcdBarrier b; b.bar = bar; b.x = xb_xcc_id(); b.st = st;
    if (threadIdx.x == 0) (void)xb_add(&bar[XB_XCNT(b.x)], 1u);
    return b;
}
__device__ __forceinline__ void xcd_barrier_complete(unsigned* bar, unsigned x, unsigned& nloc, unsigned& nx) {
    const unsigned G = gridDim.x * gridDim.y * gridDim.z;
    unsigned sum, cnt, mine, sp = 0u;
    for (;;) {
        sum = 0u; cnt = 0u; mine = 0u;
#pragma unroll
        for (unsigned j = 0; j < 16; ++j) { const unsigned c = xb_ld(&bar[XB_XCNT(j)]); sum += c; cnt += (c > 0u) ? 1u : 0u; mine = (j == x) ? c : mine; }
        if (sum == G) break;
        __builtin_amdgcn_s_sleep(1);
        if ((++sp & 255u) == 0u) { if (xb_ld(&bar[XB_TMO])) break; if (sp > XB_SPIN_CAP) { atomicAdd(&bar[XB_TMO], 1u); break; } }
    }
    nloc = mine > 0u ? mine : 1u; nx = cnt > 0u ? cnt : 1u;
}

__device__ __forceinline__ void xcd_barrier(const XcdBarrier& b) {
    asm volatile("s_waitcnt vmcnt(0)" ::: "memory");
    __syncthreads();
    if (threadIdx.x == 0) {
        unsigned* bar = b.bar;
        __builtin_amdgcn_s_waitcnt(0);
        unsigned nloc = b.st[0], nx = b.st[1];
        if (nloc == 0u) { xcd_barrier_complete(bar, b.x, nloc, nx); b.st[0] = nloc; b.st[1] = nx; }
        const unsigned old = xb_add(&bar[XB_XSUB(b.x)], 1u);
        const unsigned gen = old / nloc;
        if (old + 1u == (gen + 1u) * nloc) {
            __builtin_amdgcn_fence(__ATOMIC_RELEASE, "agent");
            asm volatile("s_waitcnt vmcnt(0)" ::: "memory");
            const unsigned og = xb_add(&bar[XB_TOP], 1u);
            const unsigned tg = og / nx;
            if (og + 1u == (tg + 1u) * nx) xb_add(&bar[XB_TOPGEN], 1u);
            else XB_SPIN(xb_ld(&bar[XB_TOPGEN]) == tg, bar);
            __builtin_amdgcn_fence(__ATOMIC_ACQUIRE, "agent");
            xb_add(&bar[XB_XGEN(b.x)], 1u);
            asm volatile("s_waitcnt vmcnt(0)" ::: "memory");
        } else {
            XB_SPIN(xb_ld(&bar[XB_XGEN(b.x)]) == gen, bar);
            __builtin_amdgcn_fence(__ATOMIC_ACQUIRE, "agent");
            asm volatile("s_waitcnt vmcnt(0)" ::: "memory");
        }
    }
    __syncthreads();
}


constexpr int NPL = 12;
constexpr int NPHASE = 1 + 2 * NPL;

DI void run_phase0(const Params& P, char* smem) {
  const int bid = opaque_bid(), nb = gridDim.x;
  {
    for (int t = bid; t < 192 + 64 + 2 * WT_SMALL; t += nb) {
      if (t < 192) ada_task(P, t, smem);
      else if (t < 256) tables_task(P, t - 192);
      else if (t < 256 + WT_SMALL) convert_weight_tile(P, 0, t - 256, smem);
      else convert_weight_tile(P, 1, t - 256 - WT_SMALL, smem);
    }
  }
}
template <int SP>
DI void run_sub(const Params& P, int l, char* smem) {
  const int bid = opaque_bid(), nb = gridDim.x;
  const bool last = l == 1;
  if constexpr (SP == 0) {
      modnorm_phase(P, l, false, bid, nb, smem);
  }
  if constexpr (SP == 1) {
      const int x = bid & 7, j = bid >> 3, nbx = nb >> 3;
      if (bid < nbx * 8)
        for (int lt = j; lt < 130 * 6; lt += nbx) {
          const int g = x & 3, ci = lt % 6;
          const int mt = (x >> 2) * 130 + lt / 6, nt = ci == 0 ? g : (ci == 1 ? 20 + g : 4 * g + 2 + ci);
          if (last && (mt % 130) >= 128 && nt < 20) continue;
          inproj_tile(P, l, mt, nt, smem);
        }
  }
  if constexpr (SP == 2) {
      const bool conv_first = (bid >= (nb >> 1));
      if (conv_first)
        for (int t = bid - (nb >> 1); t < WT_TILES - WT_SMALL; t += nb) convert_weight_tile(P, l, WT_SMALL + t, smem);
      {
        const int x = bid & 7, j = bid >> 3, nbx = nb >> 3;
        if (bid < nbx * 8) {
          for (int q = j; q < 128; q += nbx) diffattn_task(P, l, x >> 2, x & 3, q * 128, 0, PB, smem);
          if (!last && j < 2) diffattn_task(P, l, x >> 2, x & 3, T + j * 128, T, CTXL, smem);
        }
      }
#ifndef PROBE_PART
#define PROBE_PART 0
#endif
#pragma unroll 1
      for (int rep = 0; rep < 1 + PROBE_PART; ++rep) {
      {
        const int x = bid & 7, j = bid >> 3, nbx = nb >> 3;
        if (bid < nbx * 8) {
          for (int q = j; q < 64; q += nbx) na_task(P, l, x >> 2, false, (x & 3) * 64 + q, 0, smem);
          if (!last && j == 0) na_task(P, l, x >> 2, true, 0, (x & 3) * 2, smem);
        }
      }
      for (int tile = bid; tile < 1040; tile += nb) {
        const bool isctx = (tile % 520) >= 512;
        if (!(last && isctx)) pool_task(P, l, tile, smem);
      }
      for (int t = bid; t < 1024; t += nb) fft_stage0_lat(P, t, smem);
      if (!last) for (int t = bid; t < 16; t += nb) fft_stage0_ctx(P, t, smem);      }
      if (!conv_first)
        for (int t = bid + (nb >> 1); t < WT_TILES - WT_SMALL; t += nb) convert_weight_tile(P, l, WT_SMALL + t, smem);

  }
  if constexpr (SP == 3) {
      const int n = 1024 + (last ? 0 : 8);
      for (int t = bid; t < n; t += nb) { if (t < 1024) fft_stage1_lat(P, t, smem); else fft_stage1_ctx(P, t - 1024, smem); }
  }
  if constexpr (SP == 4) {
      for (int t = bid; t < 512; t += nb) fft_stage2_lat(P, t, smem);
  }
  if constexpr (SP == 5) {
      for (int t = bid; t < 520; t += nb) { const int mt = t >> 1; if (last && (mt % 130) >= 128) continue; fnet_final_tile(P, l, mt, t & 1, smem); }
  }
  if constexpr (SP == 6) {
      const int x = bid & 7, j = bid >> 3, nbx = nb >> 3;
      if (bid < nbx * 8)
        for (int lt = j; lt < 33 * 8; lt += nbx) {
          const int mt = x + 8 * (lt >> 3);
          if (mt >= 260 || (last && (mt % 130) >= 128)) continue;
          merge_tile(P, l, mt, lt & 7, smem);
        }
  }
  if constexpr (SP == 7) {
      const int x = bid & 7, j = bid >> 3, nbx = nb >> 3;
      if (bid < nbx * 8)
        for (int lt = j; lt < 33 * 4; lt += nbx) {
          const int mt = x + 8 * (lt >> 2);
          if (mt >= 260 || (last && (mt % 130) >= 128)) continue;
          outproj_tile(P, l, mt, lt & 3, smem);
        }
  }
  if constexpr (SP == 8) { modnorm_phase(P, l, true, bid, nb, smem); }
  if constexpr (SP == 9) {
      const int n = last ? 32 : 64;
      for (int t = bid; t < n; t += nb) {
        const int smp = t >> 4, e = t & 15;
        if (smp < 2) topk_task<64>(P, smp, e, smem); else topk_task<1>(P, smp, e, smem);
      }
  }
  if constexpr (SP == 10) {
      const int nmt = last ? 32 : 33;
      const int x = bid & 7, j = bid >> 3, nbx = nb >> 3, npairs = NE * nmt;
      if (bid < nbx * 8)
        for (int lt = j; lt < ((npairs + 7) >> 3) * 11; lt += nbx) {
          const int p = x + 8 * (lt / 11);
          if (p >= npairs) continue;
          expert1_tile(P, p / nmt, p % nmt, lt % 11, smem);
        }
  }
  if constexpr (SP == 11) {
      const int nmt = last ? 32 : 33;
      const int x = bid & 7, j = bid >> 3, nbx = nb >> 3, npairs = NE * nmt;
      if (bid < nbx * 8)
        for (int lt = j; lt < ((npairs + 7) >> 3) * 4; lt += nbx) {
          const int p = x + 8 * (lt >> 2);
          if (p >= npairs) continue;
          expert2_tile(P, l, p / nmt, p % nmt, lt & 3, smem);
        }
  }
}

__shared__ __attribute__((aligned(16))) char g_smem[SMEM_BYTES];

#if ONE_LAUNCH
#ifndef PROBE_DUP
#define PROBE_DUP -1
#endif
#ifndef PROBE_MASK
#define PROBE_MASK 0
#endif
#define PH_STEP(SPV, L)                                \
  xcd_barrier(xb);                                     \
  run_sub<SPV>(P, L, g_smem);                          \
  if (SPV == PROBE_DUP || ((PROBE_MASK >> SPV) & 1)) { xcd_barrier(xb); run_sub<SPV>(P, L, g_smem); }
#define PH_LAYER(L)                                                                      \
  PH_STEP(0, L) PH_STEP(1, L) PH_STEP(2, L) PH_STEP(3, L) PH_STEP(4, L) PH_STEP(5, L)    \
  PH_STEP(6, L) PH_STEP(7, L) PH_STEP(8, L) PH_STEP(9, L) PH_STEP(10, L) PH_STEP(11, L)
#define PH_LAYER0_NOSYNC                                                                 \
  run_sub<0>(P, 0, g_smem);                                                              \
  PH_STEP(1, 0) PH_STEP(2, 0) PH_STEP(3, 0) PH_STEP(4, 0) PH_STEP(5, 0)                  \
  PH_STEP(6, 0) PH_STEP(7, 0) PH_STEP(8, 0) PH_STEP(9, 0) PH_STEP(10, 0) PH_STEP(11, 0)
__shared__ uint4 xb_words;
__global__ void __launch_bounds__(256, 2) mega(Params P) {
  cg::grid_group grid = cg::this_grid();
  if (threadIdx.x == 0) xb_words = make_uint4(0u, 0u, 0u, 0u);
  __syncthreads();
  XcdBarrier xb = xcd_barrier_post((unsigned*)(P.ws + O_BAR), (volatile LAS unsigned*)&xb_words);
  run_phase0(P, g_smem);
  if (xb_ld((unsigned*)(P.ws + O_BAR) + XB_TMO) == 0xFFFFFFFFu) grid.sync();
  xcd_barrier(xb);
  PH_LAYER0_NOSYNC
  PH_LAYER(1)
}
#else
__global__ void __launch_bounds__(256, 2) kphase0(Params P) { run_phase0(P, g_smem); }
template <int SP>
__global__ void __launch_bounds__(256, 2) kphase(Params P, int l) { run_sub<SP>(P, l, g_smem); }
#endif

extern "C" void kernel_launch(void* const* d_in, const int* in_sizes, int n_in, void* d_out, int out_size, void* d_ws,
                              size_t ws_size, hipStream_t stream) {
  static int grid_blocks = 0;
  if (!grid_blocks) {
    int dev = 0, cus = 0, per_cu = 0;
    (void)hipGetDevice(&dev);
    (void)hipDeviceGetAttribute(&cus, hipDeviceAttributeMultiprocessorCount, dev);
#if ONE_LAUNCH
    (void)hipOccupancyMaxActiveBlocksPerMultiprocessor(&per_cu, mega, 256, 0);
#else
    per_cu = 2;
#endif
    if (per_cu < 1) per_cu = 1;
    if (per_cu > 2) per_cu = 2;
    grid_blocks = cus * per_cu;
  }
  if (ws_size < WS_TOTAL) { fprintf(stderr, "workspace too small: %zu < %zu\n", ws_size, (size_t)WS_TOTAL); }
  Params P{};
  const float** pp = (const float**)&P;
  for (int i = 0; i < 25; ++i) pp[i] = (const float*)d_in[i];
  P.out = (float*)d_out;
  P.ws = (char*)d_ws;
#if ONE_LAUNCH
  (void)hipMemsetAsync((char*)d_ws + O_BAR, 0, 16384, stream);
  void* args[] = {&P};
  hipError_t e = hipLaunchCooperativeKernel((void*)mega, dim3(grid_blocks), dim3(256), args, 0, stream);
  if (e != hipSuccess) fprintf(stderr, "cooperative launch failed: %s (grid %d)\n", hipGetErrorString(e), grid_blocks);
#else
  const dim3 g(grid_blocks), b(256);
  kphase0<<<g, b, 0, stream>>>(P);
  for (int l = 0; l < 2; ++l) {
    kphase<0><<<g, b, 0, stream>>>(P, l);
    kphase<1><<<g, b, 0, stream>>>(P, l);
    kphase<2><<<g, b, 0, stream>>>(P, l);
    kphase<3><<<g, b, 0, stream>>>(P, l);
    kphase<4><<<g, b, 0, stream>>>(P, l);
    kphase<5><<<g, b, 0, stream>>>(P, l);
    kphase<6><<<g, b, 0, stream>>>(P, l);
    kphase<7><<<g, b, 0, stream>>>(P, l);
    kphase<8><<<g, b, 0, stream>>>(P, l);
    kphase<9><<<g, b, 0, stream>>>(P, l);
    kphase<10><<<g, b, 0, stream>>>(P, l);
    kphase<11><<<g, b, 0, stream>>>(P, l);
  }
#endif
}
```
